# Optimizing an MI355X kernel written in HIP

```python
import math
import jax
import jax.numpy as jnp
from jax import lax
import numpy as np

D_MODEL = 1024
BATCH = 8
SEQ = 4096
DEPTH = 2

GRID_W = 64
CTX_LEN = 256
N_BRANCH = 4
BRANCH_W = 512
Q_BLOCK = 128
ROPE_THETA = 10000.0
NEG_INF = -1e30
LN_EPS = 1e-5
RMS_EPS = 1e-6

MLA_HEADS = 8
MLA_Q_RANK = 256
MLA_KV_RANK = 128
MLA_NOPE = 64
MLA_ROPE = 32
MLA_V = 64
MLA_SCALE = (MLA_NOPE + MLA_ROPE) ** -0.5

RWKV_HEADS = 8
RWKV_HEAD = 64
RWKV_W = RWKV_HEADS * RWKV_HEAD
RWKV_W_LORA = 64
RWKV_A_LORA = 64
RWKV_G_LORA = 128
RWKV_GN_EPS = 64e-5

GQA_HEADS = 8
GQA_KV_HEADS = 2
GQA_HEAD = 64
GQA_SCALE = GQA_HEAD ** -0.5

WIN_HEADS = 8
WIN_KV_HEADS = 2
WIN_HEAD = 64
WINDOW = 128
WIN_SCALE = WIN_HEAD ** -0.5

PEER_HEADS = 8
PEER_N_KEYS = 128
PEER_EXPERTS = PEER_N_KEYS * PEER_N_KEYS
PEER_TOPK = 16
PEER_DQ = 128
PEER_BLOCK = 128

DEEPNORM_ALPHA = (2 * DEPTH) ** 0.25
DEEPNORM_BETA = (8 * DEPTH) ** -0.25

MLA_IN = MLA_Q_RANK + MLA_KV_RANK + MLA_ROPE
RWKV_IN = 3 * RWKV_W + 2 * RWKV_W_LORA + 2 * RWKV_A_LORA + RWKV_G_LORA
GQA_IN = (GQA_HEADS + 2 * GQA_KV_HEADS) * GQA_HEAD
WIN_IN = (WIN_HEADS + 2 * WIN_KV_HEADS) * WIN_HEAD
GATE_IN = N_BRANCH * D_MODEL
GROUP_WIDTHS = (MLA_IN, RWKV_IN, GQA_IN, WIN_IN, GATE_IN)
IN_WIDTH = MLA_IN + RWKV_IN + GQA_IN + WIN_IN + GATE_IN

kernel_name = "hybrid_mla_rwkv7_gqa_swa_peer_dit"


def split_last(x, widths):
    out, start = [], 0
    for w in widths:
        out.append(x[..., start:start + w])
        start += w
    return out


def rms_norm(x, g):
    xf = x.astype(jnp.float32)
    y = xf * lax.rsqrt(jnp.mean(xf * xf, axis=-1, keepdims=True) + RMS_EPS) * g.astype(jnp.float32)
    return y.astype(x.dtype)


def layer_norm(x, g, b):
    xf = x.astype(jnp.float32)
    mu = jnp.mean(xf, axis=-1, keepdims=True)
    var = jnp.mean(jnp.square(xf - mu), axis=-1, keepdims=True)
    y = (xf - mu) * lax.rsqrt(var + LN_EPS) * g.astype(jnp.float32) + b.astype(jnp.float32)
    return y.astype(x.dtype)


def axial_rope_tables(rows, rot_dim):
    r_idx = jnp.repeat(jnp.arange(rows), GRID_W).astype(jnp.float32)
    c_idx = jnp.tile(jnp.arange(GRID_W), rows).astype(jnp.float32)
    n = rot_dim // 4
    inv = ROPE_THETA ** (-jnp.arange(n, dtype=jnp.float32) / n)
    ang = jnp.concatenate([r_idx[:, None] * inv, c_idx[:, None] * inv], axis=-1)
    return jnp.cos(ang), jnp.sin(ang)


def apply_rope(x, cos, sin):
    xf = x.astype(jnp.float32).reshape(x.shape[:-1] + (x.shape[-1] // 2, 2))
    x1, x2 = xf[..., 0], xf[..., 1]
    cs, sn = cos[None, :, None, :], sin[None, :, None, :]
    out = jnp.stack([x1 * cs - x2 * sn, x1 * sn + x2 * cs], axis=-1).reshape(x.shape)
    return out.astype(x.dtype)


def dense_attention(q, k, v, scale, sink=None):
    B, S, H, dk = q.shape
    Hk = k.shape[2]
    G = H // Hk
    dv = v.shape[-1]
    nb = S // Q_BLOCK
    qb = q.reshape(B, nb, Q_BLOCK, Hk, G, dk).swapaxes(0, 1)

    def one(qi):
        s = jnp.einsum('bqkgd,blkd->bkgql', qi, k).astype(jnp.float32) * scale
        if sink is not None:
            sk = jnp.broadcast_to(sink.astype(jnp.float32).reshape(Hk, G, 1, 1), s.shape[:-1] + (1,))
            p = jax.nn.softmax(jnp.concatenate([s, sk], axis=-1), axis=-1)[..., :-1]
        else:
            p = jax.nn.softmax(s, axis=-1)
        return jnp.einsum('bkgql,blkd->bqkgd', p.astype(v.dtype), v)

    o = lax.map(one, qb)
    return o.swapaxes(0, 1).reshape(B, S, H, dv)


def window_attention(q, k, v, k_ctx, v_ctx, sink, scale):
    B, S, H, d = q.shape
    Hk = k.shape[2]
    G = H // Hk
    C = k_ctx.shape[1]
    nb = S // WINDOW
    pad = ((0, 0), (WINDOW, WINDOW), (0, 0), (0, 0))
    kp, vp = jnp.pad(k, pad), jnp.pad(v, pad)
    k_win = jnp.concatenate([kp[:, i * WINDOW:i * WINDOW + S].reshape(B, nb, WINDOW, Hk, d) for i in range(3)], axis=2)
    v_win = jnp.concatenate([vp[:, i * WINDOW:i * WINDOW + S].reshape(B, nb, WINDOW, Hk, d) for i in range(3)], axis=2)
    q_pos = jnp.arange(S).reshape(nb, WINDOW)
    k_pos = q_pos[:, :1] - WINDOW + jnp.arange(3 * WINDOW)[None, :]
    valid = ((jnp.abs(q_pos[:, :, None] - k_pos[:, None, :]) <= WINDOW)
             & (k_pos[:, None, :] >= 0) & (k_pos[:, None, :] < S))
    qb = q.reshape(B, nb, WINDOW, Hk, G, d).swapaxes(0, 1)
    sink_b = sink.astype(jnp.float32).reshape(Hk, G, 1, 1)
    n_loc = 3 * WINDOW

    def one(args):
        qi, ki, vi, mi = args
        s_loc = jnp.einsum('bqkgd,blkd->bkgql', qi, ki).astype(jnp.float32) * scale
        s_loc = jnp.where(mi[None, None, None], s_loc, NEG_INF)
        s_ctx = jnp.einsum('bqkgd,blkd->bkgql', qi, k_ctx).astype(jnp.float32) * scale
        s_snk = jnp.broadcast_to(sink_b, s_loc.shape[:-1] + (1,))
        p = jax.nn.softmax(jnp.concatenate([s_loc, s_ctx, s_snk], axis=-1), axis=-1).astype(v.dtype)
        return (jnp.einsum('bkgql,blkd->bqkgd', p[..., :n_loc], vi)
                + jnp.einsum('bkgql,blkd->bqkgd', p[..., n_loc:n_loc + C], v_ctx))

    o = lax.map(one, (qb, k_win.swapaxes(0, 1), v_win.swapaxes(0, 1), valid))
    return o.swapaxes(0, 1).reshape(B, S, H, d)


def mla_qkv(p, q_norm, kv_norm, w_uq, w_ukv, rope):
    B, L, _ = p.shape
    dq, dkv, kr = split_last(p, (MLA_Q_RANK, MLA_KV_RANK, MLA_ROPE))
    q = (rms_norm(dq, q_norm) @ w_uq).reshape(B, L, MLA_HEADS, MLA_NOPE + MLA_ROPE)
    kv = (rms_norm(dkv, kv_norm) @ w_ukv).reshape(B, L, MLA_HEADS, MLA_NOPE + MLA_V)
    q_nope, q_rope = q[..., :MLA_NOPE], q[..., MLA_NOPE:]
    k_nope, v = kv[..., :MLA_NOPE], kv[..., MLA_NOPE:]
    k_rope = kr.reshape(B, L, 1, MLA_ROPE)
    if rope is not None:
        q_rope = apply_rope(q_rope, rope[0], rope[1])
        k_rope = apply_rope(k_rope, rope[0], rope[1])
    q = jnp.concatenate([q_nope, q_rope], axis=-1)
    k = jnp.concatenate([k_nope, jnp.broadcast_to(k_rope, (B, L, MLA_HEADS, MLA_ROPE))], axis=-1)
    return q, k, v


def gqa_qkv(p, n_heads, n_kv, hd):
    B, L, _ = p.shape
    q, k, v = split_last(p, (n_heads * hd, n_kv * hd, n_kv * hd))
    return q.reshape(B, L, n_heads, hd), k.reshape(B, L, n_kv, hd), v.reshape(B, L, n_kv, hd)


def rwkv7_features(p, mu, w0, w2, a0, a2, g2, k_k, k_a):
    B, L, _ = p.shape
    prev = jnp.pad(p[:, :-1], ((0, 0), (1, 0), (0, 0)))
    nxt = jnp.pad(p[:, 1:], ((0, 0), (0, 1), (0, 0)))
    p = (p + mu[0] * (prev - p) + mu[1] * (nxt - p)).astype(jnp.float32)
    r, k, v, wf, wb, af, ab, gi = split_last(
        p, (RWKV_W, RWKV_W, RWKV_W, RWKV_W_LORA, RWKV_W_LORA, RWKV_A_LORA, RWKV_A_LORA, RWKV_G_LORA))

    def heads(t):
        return t.reshape(B, L, RWKV_HEADS, RWKV_HEAD)

    kk = heads(k * k_k)
    kk = kk / jnp.maximum(jnp.sqrt(jnp.sum(kk * kk, axis=-1, keepdims=True)), 1e-12)
    decay, kd, ad = [], [], []
    for d, (w_in_d, a_in_d) in enumerate(((wf, af), (wb, ab))):
        lw = -jax.nn.softplus(-(w0[d] + jnp.tanh(w_in_d) @ w2[d])) - 0.5
        a = jax.nn.sigmoid(a0[d] + a_in_d @ a2[d])
        decay.append(heads(jnp.exp(-jnp.exp(lw))))
        ad.append(heads(a))
        kd.append(heads(k * (1.0 + (a - 1.0) * k_a)))
    g = jax.nn.sigmoid(gi) @ g2
    return {'r': heads(r), 'v': heads(v), 'kk': kk, 'g': g, 'decay': decay, 'k': kd, 'a': ad}


def wkv7_scan(state0, f, d, reverse):
    xs = tuple(t.swapaxes(0, 1) for t in (f['r'], f['decay'][d], f['k'][d], f['v'], f['kk'], f['a'][d]))

    def step(S, inp):
        r, w, k, v, kk, a = inp
        sa = jnp.einsum('bhij,bhj->bhi', S, kk)
        S = S * w[:, :, None, :] - sa[..., None] * (kk * a)[:, :, None, :] + v[..., None] * k[:, :, None, :]
        return S, jnp.einsum('bhij,bhj->bhi', S, r)

    S, ys = lax.scan(step, state0, xs, reverse=reverse)
    return S, ys.swapaxes(0, 1)


def rwkv7_output(f, o_f, o_b, r_k, ln_g, ln_b, dtype):
    o = o_f + o_b
    B, L = o.shape[0], o.shape[1]
    mu = jnp.mean(o, axis=-1, keepdims=True)
    var = jnp.mean(jnp.square(o - mu), axis=-1, keepdims=True)
    o = ((o - mu) * lax.rsqrt(var + RWKV_GN_EPS) * ln_g.reshape(RWKV_HEADS, RWKV_HEAD)
         + ln_b.reshape(RWKV_HEADS, RWKV_HEAD))
    bonus = jnp.sum(f['r'] * (f['k'][0] + f['k'][1]) * r_k, axis=-1, keepdims=True) * f['v']
    y = (o + bonus).reshape(B, L, RWKV_W) * f['g']
    return y.astype(dtype)


def merge_heads(t):
    return t.reshape(t.shape[0], t.shape[1], -1)


def merge_branches(ys, gate_pre, w_branch, w_out):
    B, L, _ = gate_pre.shape
    gates = jax.nn.sigmoid(gate_pre.astype(jnp.float32)).astype(gate_pre.dtype).reshape(B, L, N_BRANCH, D_MODEL)
    acc = gates[:, :, 0] * (ys[0] @ w_branch[0])
    for i in range(1, N_BRANCH):
        acc = acc + gates[:, :, i] * (ys[i] @ w_branch[i])
    return acc @ w_out


def peer_ffn(h, wq, keys, u_tab, v_tab):
    B, L, D = h.shape
    q = (h @ wq).reshape(B, L, PEER_HEADS, 2, PEER_DQ // 2).astype(jnp.float32)
    s1 = jnp.einsum('blhd,hkd->blhk', q[..., 0, :], keys[:, 0].astype(jnp.float32))
    s2 = jnp.einsum('blhd,hkd->blhk', q[..., 1, :], keys[:, 1].astype(jnp.float32))
    v1, i1 = lax.top_k(s1, PEER_TOPK)
    v2, i2 = lax.top_k(s2, PEER_TOPK)
    cand = (v1[..., :, None] + v2[..., None, :]).reshape(B, L, PEER_HEADS, PEER_TOPK * PEER_TOPK)
    cidx = (i1[..., :, None] * PEER_N_KEYS + i2[..., None, :]).reshape(B, L, PEER_HEADS, PEER_TOPK * PEER_TOPK)
    best, pos = lax.top_k(cand, PEER_TOPK)
    idx = jnp.take_along_axis(cidx, pos, axis=-1)
    wgt = jax.nn.softmax(best, axis=-1)
    E = PEER_HEADS * PEER_TOPK
    nblk = (B * L) // PEER_BLOCK
    hb = h.reshape(nblk, PEER_BLOCK, D)
    ib = idx.reshape(nblk, PEER_BLOCK, E)
    gb = wgt.reshape(nblk, PEER_BLOCK, E).astype(h.dtype)

    def one(args):
        ht, it, gt = args
        act = jax.nn.gelu(jnp.einsum('td,ted->te', ht, jnp.take(u_tab, it, axis=0)), approximate=False)
        return jnp.einsum('te,ted->td', act * gt, jnp.take(v_tab, it, axis=0))

    return lax.map(one, (hb, ib, gb)).reshape(B, L, D)


def setup_inputs(seed: int = 0) -> dict:
    key = jax.random.key(seed)
    ks = iter(jax.random.split(key, 64))
    L, D = DEPTH, D_MODEL

    def nrm(shape, scale):
        return scale * jax.random.normal(next(ks), shape, jnp.float32)

    def gain(shape):
        return 1.0 + nrm(shape, 0.02)

    return {
        'x': nrm((BATCH, SEQ, D), 1.0),
        'c': nrm((BATCH, D), 1.0),
        'ctx': nrm((BATCH, CTX_LEN, D), 1.0),
        'c_ctx': nrm((D,), 1.0),
        'ada_w': nrm((L, D, 6 * D), 0.5 * D ** -0.5),
        'ada_b': nrm((L, 6 * D), 0.02),
        'w_in': nrm((L, D, IN_WIDTH), D ** -0.5),
        'mla_q_norm': gain((L, MLA_Q_RANK)),
        'mla_kv_norm': gain((L, MLA_KV_RANK)),
        'mla_w_uq': nrm((L, MLA_Q_RANK, MLA_HEADS * (MLA_NOPE + MLA_ROPE)), MLA_Q_RANK ** -0.5),
        'mla_w_ukv': nrm((L, MLA_KV_RANK, MLA_HEADS * (MLA_NOPE + MLA_V)), MLA_KV_RANK ** -0.5),
        'rwkv_mu': jax.random.uniform(next(ks), (L, 2, RWKV_IN), jnp.float32, 0.0, 0.5),
        'rwkv_w0': jax.random.uniform(next(ks), (L, 2, RWKV_W), jnp.float32, -6.0, 1.0),
        'rwkv_w2': nrm((L, 2, RWKV_W_LORA, RWKV_W), 0.1 * RWKV_W_LORA ** -0.5),
        'rwkv_a0': nrm((L, 2, RWKV_W), 0.1),
        'rwkv_a2': nrm((L, 2, RWKV_A_LORA, RWKV_W), RWKV_A_LORA ** -0.5),
        'rwkv_g2': nrm((L, RWKV_G_LORA, RWKV_W), RWKV_G_LORA ** -0.5),
        'rwkv_k_k': 0.85 + nrm((L, RWKV_W), 0.02),
        'rwkv_k_a': gain((L, RWKV_W)),
        'rwkv_r_k': nrm((L, RWKV_HEADS, RWKV_HEAD), 0.1),
        'rwkv_ln_g': gain((L, RWKV_W)),
        'rwkv_ln_b': nrm((L, RWKV_W), 0.02),
        'gqa_q_norm': gain((L, GQA_HEAD)),
        'gqa_k_norm': gain((L, GQA_HEAD)),
        'win_sink': nrm((L, WIN_HEADS), 1.0),
        'w_branch': nrm((L, N_BRANCH, BRANCH_W, D), DEEPNORM_BETA * BRANCH_W ** -0.5),
        'w_out': nrm((L, D, D), DEEPNORM_BETA * D ** -0.5),
        'ln1_g': gain((L, D)),
        'ln1_b': nrm((L, D), 0.02),
        'peer_wq': nrm((L, D, PEER_HEADS * PEER_DQ), D ** -0.5),
        'peer_keys': nrm((L, PEER_HEADS, 2, PEER_N_KEYS, PEER_DQ // 2), (PEER_DQ // 2) ** -0.5),
        'peer_u': nrm((L, PEER_EXPERTS, D), D ** -0.5),
        'peer_v': nrm((L, PEER_EXPERTS, D), DEEPNORM_BETA),
        'ln2_g': gain((L, D)),
        'ln2_b': nrm((L, D), 0.02),
    }


def reference(x, c, ctx, c_ctx, ada_w, ada_b, w_in, mla_q_norm, mla_kv_norm, mla_w_uq, mla_w_ukv,
              rwkv_mu, rwkv_w0, rwkv_w2, rwkv_a0, rwkv_a2, rwkv_g2, rwkv_k_k, rwkv_k_a, rwkv_r_k,
              rwkv_ln_g, rwkv_ln_b, gqa_q_norm, gqa_k_norm, win_sink, w_branch, w_out, ln1_g, ln1_b,
              peer_wq, peer_keys, peer_u, peer_v, ln2_g, ln2_b):
    seq_len = x.shape[1]
    rows = seq_len // GRID_W
    rope_mla = axial_rope_tables(rows, MLA_ROPE)
    rope_head = axial_rope_tables(rows, GQA_HEAD)
    for l in range(DEPTH):
        mod_lat = jax.nn.silu(c) @ ada_w[l] + ada_b[l]
        mod_ctx = jax.nn.silu(c_ctx) @ ada_w[l] + ada_b[l]
        sh1, sc1, gt1, sh2, sc2, gt2 = jnp.split(mod_lat[:, None, :], 6, axis=-1)
        csh1, csc1, cgt1, csh2, csc2, cgt2 = jnp.split(mod_ctx, 6, axis=-1)

        p_lat = (x * (1 + sc1) + sh1) @ w_in[l]
        p_ctx = (ctx * (1 + csc1) + csh1) @ w_in[l]
        mla_lat, rwkv_lat, gqa_lat, win_lat, gate_lat = split_last(p_lat, GROUP_WIDTHS)
        mla_ctx, rwkv_ctx, gqa_ctx, win_ctx, gate_ctx = split_last(p_ctx, GROUP_WIDTHS)

        qa, ka, va = mla_qkv(mla_lat, mla_q_norm[l], mla_kv_norm[l], mla_w_uq[l], mla_w_ukv[l], rope_mla)
        qa_c, ka_c, va_c = mla_qkv(mla_ctx, mla_q_norm[l], mla_kv_norm[l], mla_w_uq[l], mla_w_ukv[l], None)
        ya = dense_attention(qa, jnp.concatenate([ka, ka_c], axis=1), jnp.concatenate([va, va_c], axis=1), MLA_SCALE)

        fb = rwkv7_features(rwkv_lat, rwkv_mu[l], rwkv_w0[l], rwkv_w2[l], rwkv_a0[l], rwkv_a2[l],
                            rwkv_g2[l], rwkv_k_k[l], rwkv_k_a[l])
        fb_c = rwkv7_features(rwkv_ctx, rwkv_mu[l], rwkv_w0[l], rwkv_w2[l], rwkv_a0[l], rwkv_a2[l],
                              rwkv_g2[l], rwkv_k_k[l], rwkv_k_a[l])
        s0 = jnp.zeros((ctx.shape[0], RWKV_HEADS, RWKV_HEAD, RWKV_HEAD), jnp.float32)
        sf_c, of_c = wkv7_scan(s0, fb_c, 0, False)
        sb_c, ob_c = wkv7_scan(s0, fb_c, 1, True)
        _, of = wkv7_scan(sf_c, fb, 0, False)
        _, ob = wkv7_scan(sb_c, fb, 1, True)
        yb = rwkv7_output(fb, of, ob, rwkv_r_k[l], rwkv_ln_g[l], rwkv_ln_b[l], x.dtype)

        qc, kc, vc = gqa_qkv(gqa_lat, GQA_HEADS, GQA_KV_HEADS, GQA_HEAD)
        qc_c, kc_c, vc_c = gqa_qkv(gqa_ctx, GQA_HEADS, GQA_KV_HEADS, GQA_HEAD)
        qc = apply_rope(rms_norm(qc, gqa_q_norm[l]), rope_head[0], rope_head[1])
        kc = apply_rope(rms_norm(kc, gqa_k_norm[l]), rope_head[0], rope_head[1])
        qc_c = rms_norm(qc_c, gqa_q_norm[l])
        kc_c = rms_norm(kc_c, gqa_k_norm[l])
        yc = dense_attention(qc, jnp.concatenate([kc, kc_c], axis=1), jnp.concatenate([vc, vc_c], axis=1), GQA_SCALE)

        qd, kd, vd = gqa_qkv(win_lat, WIN_HEADS, WIN_KV_HEADS, WIN_HEAD)
        qd_c, kd_c, vd_c = gqa_qkv(win_ctx, WIN_HEADS, WIN_KV_HEADS, WIN_HEAD)
        qd = apply_rope(qd, rope_head[0], rope_head[1])
        kd = apply_rope(kd, rope_head[0], rope_head[1])
        yd = window_attention(qd, kd, vd, kd_c, vd_c, win_sink[l], WIN_SCALE)

        mix = merge_branches((merge_heads(ya), yb, merge_heads(yc), merge_heads(yd)), gate_lat, w_branch[l], w_out[l])
        x_mid = layer_norm(DEEPNORM_ALPHA * x + gt1 * mix, ln1_g[l], ln1_b[l])
        ffn = peer_ffn(x_mid * (1 + sc2) + sh2, peer_wq[l], peer_keys[l], peer_u[l], peer_v[l])
        x_new = layer_norm(DEEPNORM_ALPHA * x_mid + gt2 * ffn, ln2_g[l], ln2_b[l])

        if l < DEPTH - 1:
            ya_c = dense_attention(qa_c, ka_c, va_c, MLA_SCALE)
            yb_c = rwkv7_output(fb_c, of_c, ob_c, rwkv_r_k[l], rwkv_ln_g[l], rwkv_ln_b[l], ctx.dtype)
            yc_c = dense_attention(qc_c, kc_c, vc_c, GQA_SCALE)
            yd_c = dense_attention(qd_c, kd_c, vd_c, WIN_SCALE, sink=win_sink[l])
            mix_c = merge_branches((merge_heads(ya_c), yb_c, merge_heads(yc_c), merge_heads(yd_c)),
                                   gate_ctx, w_branch[l], w_out[l])
            ctx_mid = layer_norm(DEEPNORM_ALPHA * ctx + cgt1 * mix_c, ln1_g[l], ln1_b[l])
            ffn_c = peer_ffn(ctx_mid * (1 + csc2) + csh2, peer_wq[l], peer_keys[l], peer_u[l], peer_v[l])
            ctx = layer_norm(DEEPNORM_ALPHA * ctx_mid + cgt2 * ffn_c, ln2_g[l], ln2_b[l])
        x = x_new
    return x
```

```cpp
#include <hip/hip_runtime.h>
#include <cstdio>
#include <cstdint>

#define LAS __attribute__((address_space(3)))
#define GAS __attribute__((address_space(1)))
typedef unsigned short bf16_t;
typedef short bf16x8 __attribute__((ext_vector_type(8)));
typedef float f32x2 __attribute__((ext_vector_type(2)));
typedef float f32x4 __attribute__((ext_vector_type(4)));
typedef float f32x16 __attribute__((ext_vector_type(16)));
typedef unsigned u32x2 __attribute__((ext_vector_type(2)));
typedef unsigned u32x4 __attribute__((ext_vector_type(4)));

#define PROBE_REP 0
constexpr int D = 1024, BATCH = 8, SEQ = 4096, CTX = 256, LTOT = SEQ + CTX, DEPTH = 2;
constexpr int MLAT = BATCH * SEQ, MCTX = BATCH * CTX, MROWS = MLAT + MCTX;
constexpr int NB = 4, NHALF = BATCH / NB;
constexpr int ML = NB * LTOT;
constexpr int MLL = NB * SEQ;
constexpr int IN_W = 7968;
constexpr float LN_EPS = 1e-5f, RMS_EPS = 1e-6f, GN_EPS = 64e-5f;
constexpr float ALPHA = 1.4142135623730951f;
constexpr float LOG2E = 1.4426950408889634f;
constexpr float MLA_QS = 0.10206207261596577f * LOG2E;
constexpr float HD_QS = 0.125f * LOG2E;

constexpr size_t MiB = 1u << 20;
constexpr size_t WS_CTL = 0, CTL_BYTES = 1 * MiB;
constexpr size_t WS_MOD = 1 * MiB;
constexpr size_t WS_ROPE = WS_MOD + 512 * 1024;
constexpr size_t WS_LORA = 3 * MiB;
constexpr size_t WS_BON = 4 * MiB;
constexpr size_t WS_RS = 6 * MiB + 512 * 1024;
constexpr size_t WS_WUQ = 7 * MiB;
constexpr size_t WS_WUKV = 8 * MiB;
constexpr size_t WS_WIN = 9 * MiB;
constexpr size_t WS_WBR = 25 * MiB;
constexpr size_t WS_WOUT = 29 * MiB;
constexpr size_t WS_WPK = 31 * MiB;
constexpr size_t WS_XSC = 35 * MiB;
constexpr size_t WS_XMOD = 43 * MiB;
constexpr size_t WS_Y01 = 111 * MiB;
constexpr size_t WS_Y23 = 179 * MiB;
constexpr size_t WS_R = 247 * MiB;
constexpr size_t R_PR = WS_R;
constexpr size_t R_OB = R_PR + (size_t)MROWS * 2048 * 2;
constexpr size_t R_PM = R_OB;
constexpr size_t R_VC = R_PM + (size_t)ML * 512 * 2;
constexpr size_t R_VD = R_VC + (size_t)ML * 128 * 2;
static_assert(R_VD + (size_t)ML * 128 * 2 <= R_OB + (size_t)MROWS * 512 * 2, "Pm/Vc/Vd overlay OB");
constexpr size_t R_QA = R_OB + (size_t)MROWS * 512 * 2;
constexpr size_t R_KA = R_QA + (size_t)ML * 768 * 2;
constexpr size_t R_VAT = R_KA + (size_t)ML * 768 * 2;
constexpr size_t R_QC = R_VAT + (size_t)ML * 512 * 2;
constexpr size_t R_KC = R_QC + (size_t)ML * 512 * 2;
constexpr size_t R_VCT = R_KC + (size_t)ML * 128 * 2;
constexpr size_t R_QD = R_VCT + (size_t)ML * 128 * 2;
constexpr size_t R_KD = R_QD + (size_t)ML * 512 * 2;
constexpr size_t R_VDT = R_KD + (size_t)ML * 128 * 2;
constexpr size_t R_END = R_VDT + (size_t)ML * 128 * 2;
constexpr size_t WS_MODP = WS_R + 250 * MiB;
constexpr size_t WS_END = 539 * MiB;
static_assert(R_END <= WS_END && WS_MODP + 2 * 16 * 9 * 6144 * 4 <= WS_END, "ws map");
constexpr size_t R_ESCR = WS_R, ESCR_PER_BLOCK = 384 * 1024;
constexpr size_t WS_SC = WS_Y01;
constexpr size_t WS_TU = WS_SC + (size_t)MROWS * 2048 * 4;
constexpr size_t WS_TV = WS_TU + (size_t)16384 * 1024;
constexpr size_t WS_IDX = WS_TV + (size_t)16384 * 1024;
constexpr size_t PEER_TBL = (size_t)16384 * 768;
constexpr size_t PEER_SLICE = (size_t)16384 * 192;
constexpr size_t WS_FFN = WS_SC;
constexpr float PEER_SU = 64.f, PEER_SV = 4.f;
constexpr size_t WS_WGT = WS_IDX + (size_t)MROWS * 128 * 4;
static_assert(WS_WGT + (size_t)MROWS * 128 * 4 <= WS_END, "ws map peer");
constexpr int CW_QUEUE = 64;
constexpr int CW_BAR = 4096;

__device__ __forceinline__ unsigned f2bf(float f) { unsigned u = __builtin_bit_cast(unsigned, f); return (u + 0x7fffu + ((u >> 16) & 1u)) >> 16; }
__device__ __forceinline__ unsigned pk2(float lo, float hi) { unsigned r; asm("v_cvt_pk_bf16_f32 %0, %1, %2" : "=v"(r) : "v"(lo), "v"(hi)); return r; }
__device__ __forceinline__ float bf2f(unsigned h) { return __builtin_bit_cast(float, h << 16); }
__device__ __forceinline__ float bflo(unsigned w) { return __builtin_bit_cast(float, w << 16); }
__device__ __forceinline__ float bfhi(unsigned w) { return __builtin_bit_cast(float, w & 0xffff0000u); }
template <int CTRL> __device__ __forceinline__ float dpp_f(float v) { return __builtin_bit_cast(float, __builtin_amdgcn_update_dpp(0, __builtin_bit_cast(int, v), CTRL, 0xf, 0xf, true)); }
template <int CTRL> __device__ __forceinline__ unsigned dpp_u(unsigned v) { return (unsigned)__builtin_amdgcn_update_dpp(0, (int)v, CTRL, 0xf, 0xf, true); }
__device__ __forceinline__ float swap16_sum(float v) { auto r = __builtin_amdgcn_permlane16_swap(__float_as_uint(v), __float_as_uint(v), false, false); return __uint_as_float(r[0]) + __uint_as_float(r[1]); }
__device__ __forceinline__ float swap32_sum(float v) { auto r = __builtin_amdgcn_permlane32_swap(__float_as_uint(v), __float_as_uint(v), false, false); return __uint_as_float(r[0]) + __uint_as_float(r[1]); }
__device__ __forceinline__ float group8_sum(float v) { v += dpp_f<0xB1>(v); v += dpp_f<0x4E>(v); v += dpp_f<0x141>(v); return v; }
__device__ __forceinline__ float wave_sum(float v) { v = group8_sum(v); v += dpp_f<0x140>(v); v = swap16_sum(v); return swap32_sum(v); }
__device__ __forceinline__ float sigmoidf_(float x) { return __builtin_amdgcn_rcpf(1.0f + __expf(-x)); }
template <class T> __device__ __forceinline__ T* uniform_launder(T* p) {
    const unsigned long long v = (unsigned long long)p;
    unsigned lo = __builtin_amdgcn_readfirstlane((unsigned)v), hi = __builtin_amdgcn_readfirstlane((unsigned)(v >> 32));
    asm volatile("" : "+s"(lo), "+s"(hi));
    return (T*)(((unsigned long long)hi << 32) | lo);
}
#define OPAQUE_ZERO(z) size_t z; asm volatile("s_mov_b64 %0, 0" : "=s"(z))
#define LDS_WAIT() asm volatile("s_waitcnt lgkmcnt(0)" ::: "memory")
#define LDS_BARRIER() asm volatile("s_waitcnt lgkmcnt(0)\n\ts_barrier" ::: "memory")
#define VM_WAIT() asm volatile("s_waitcnt vmcnt(0)" ::: "memory")

#define XB_TMO      128
#define XB_XCNT(j)  (256  + 64 * (j))
#define XB_XSUB(j)  (1280 + 64 * (j))
#define XB_XGEN(j)  (2304 + 64 * (j))
#define XB_TOP      3328
#define XB_TOPGEN   3392
#define XCD_BAR_WORDS 3456
#define XB_SPIN_CAP (1u << 22)
__device__ __forceinline__ unsigned xb_ld(unsigned* p)              { return __hip_atomic_load(p, __ATOMIC_RELAXED, __HIP_MEMORY_SCOPE_AGENT); }
__device__ __forceinline__ unsigned xb_add(unsigned* p, unsigned v) { return __hip_atomic_fetch_add(p, v, __ATOMIC_RELAXED, __HIP_MEMORY_SCOPE_AGENT); }
__device__ __forceinline__ unsigned xb_xcc_id() { return (unsigned)__builtin_amdgcn_s_getreg((3 << 11) | 20) & 0xFu; }
#define XB_SPIN(cond, bar) do { unsigned _sp = 0; while (cond) { __builtin_amdgcn_s_sleep(1); \
    if ((++_sp & 255u) == 0u) { if (xb_ld(&(bar)[XB_TMO])) break; if (_sp > XB_SPIN_CAP) { atomicAdd(&(bar)[XB_TMO], 1u); break; } } } } while (0)
struct XcdBarrier { unsigned* bar; unsigned x; volatile LAS unsigned* st; };
__device__ __forceinline__ XcdBarrier xcd_barrier_post(unsigned* bar, volatile LAS unsigned* st) {
    XcdBarrier b; b.bar = bar; b.x = xb_xcc_id(); b.st = st;
    if (threadIdx.x == 0) (void)xb_add(&bar[XB_XCNT(b.x)], 1u);
    return b;
}
__device__ __forceinline__ void xcd_barrier_complete(unsigned* bar, unsigned x, unsigned& nloc, unsigned& nx) {
    const unsigned G = gridDim.x * gridDim.y * gridDim.z;
    unsigned sum, cnt, mine, sp = 0u;
    for (;;) {
        sum = 0u; cnt = 0u; mine = 0u;
#pragma unroll
        for (unsigned j = 0; j < 16; ++j) { const unsigned c = xb_ld(&bar[XB_XCNT(j)]); sum += c; cnt += (c > 0u) ? 1u : 0u; mine = (j == x) ? c : mine; }
        if (sum == G) break;
        __builtin_amdgcn_s_sleep(1);
        if ((++sp & 255u) == 0u) { if (xb_ld(&bar[XB_TMO])) break; if (sp > XB_SPIN_CAP) { atomicAdd(&bar[XB_TMO], 1u); break; } }
    }
    nloc = mine > 0u ? mine : 1u; nx = cnt > 0u ? cnt : 1u;
}
__device__ __forceinline__ void xcd_barrier(const XcdBarrier& b, const bool leader) {
    asm volatile("s_waitcnt vmcnt(0)" ::: "memory");
    __syncthreads();
    if (leader) {
        size_t z_; asm volatile("s_mov_b64 %0, 0" : "=s"(z_)); unsigned* bar = b.bar + z_;
        __builtin_amdgcn_s_waitcnt(0);
        unsigned nloc = b.st[0], nx = b.st[1];
        if (nloc == 0u) { xcd_barrier_complete(bar, b.x, nloc, nx); b.st[0] = nloc; b.st[1] = nx; }
        const unsigned old = xb_add(&bar[XB_XSUB(b.x)], 1u);
        const unsigned gen = old / nloc;
        if (old + 1u == (gen + 1u) * nloc) {
            __builtin_amdgcn_fence(__ATOMIC_RELEASE, "agent");
            asm volatile("s_waitcnt vmcnt(0)" ::: "memory");
            const unsigned og = xb_add(&bar[XB_TOP], 1u);
            const unsigned tg = og / nx;
            if (og + 1u == (tg + 1u) * nx) xb_add(&bar[XB_TOPGEN], 1u);
            else XB_SPIN(xb_ld(&bar[XB_TOPGEN]) == tg, bar);
            __builtin_amdgcn_fence(__ATOMIC_ACQUIRE, "agent");
            xb_add(&bar[XB_XGEN(b.x)], 1u);
            asm volatile("s_waitcnt vmcnt(0)" ::: "memory");
        } else {
            XB_SPIN(xb_ld(&bar[XB_XGEN(b.x)]) == gen, bar);
            __builtin_amdgcn_fence(__ATOMIC_ACQUIRE, "agent");
            asm volatile("s_waitcnt vmcnt(0)" ::: "memory");
        }
    }
    __syncthreads();
}

namespace pg8 {
constexpr int BM = 256, BK = 64, HALF = 128, HTB = HALF * BK * 2, STAGE_BYTES = 8 * HTB, NXCD = 8, WGM = 8;
__host__ __device__ __forceinline__ int lds_byte(int r, int c) { const int st = (r >> 4) * 2 + (c >> 5), rr = r & 15, cc = c & 31, ob = rr * 64 + cc * 2; return st * 1024 + (ob ^ (((ob >> 9) & 1) << 5)); }
__host__ __device__ __forceinline__ void stage_rc(int b, int& R, int& C) { const int st = b / 1024, sb = b % 1024, swz = sb ^ (((sb >> 9) & 1) << 5); R = (st >> 1) * 16 + swz / 64; C = (st & 1) * 32 + (swz % 64) / 2; }
__host__ __device__ __forceinline__ int perm32(int rho) { const int n = rho >> 4, i = rho & 15; return 8 * (i >> 2) + 4 * n + (i & 3); }

struct Unit { const char* a; const char* b; int nt; int pm, pn, kind; };

struct TileOrder {
    int nM, nN, nwg, G, c;
    __device__ void init(int nM_, int nN_, int G_, int c_) { nM = nM_; nN = nN_; nwg = nM * nN; G = G_; c = c_; }
    __device__ bool tile(int i, int& tm, int& tn) const { return tileL((long)i * G + c, tm, tn); }
    __device__ bool tileL(const long L, int& tm, int& tn) const {
        if (L < 0 || L >= nwg) return false;
        int wgid = (int)L; { const int q = nwg / NXCD, r = nwg % NXCD, xcd = wgid % NXCD, off = wgid / NXCD; wgid = (xcd < r ? xcd * (q + 1) : r * (q + 1) + (xcd - r) * q) + off; }
        const int nig = WGM * nN, gid = wgid / nig, fm = gid * WGM, gsz = (nM - fm) < WGM ? (nM - fm) : WGM;
        tm = fm + ((wgid % nig) % gsz); tn = (wgid % nig) / gsz; return true;
    }
};

__device__ __forceinline__ unsigned cvt_pk_bf16(float lo, float hi) { unsigned r; asm volatile("v_cvt_pk_bf16_f32 %0, %1, %2" : "=v"(r) : "v"(lo), "v"(hi)); return r; }

template <class Epi, class Sched>
__device__ __forceinline__ void gemm_phase(LAS unsigned char* lds, const int wave_id, const int lda, const int ldb, const Sched& S, const Epi& E) {
    int tid_; asm volatile("v_mbcnt_lo_u32_b32 %0, -1, 0\n\tv_mbcnt_hi_u32_b32 %0, -1, %0" : "=v"(tid_)); tid_ += wave_id * 64;
    const int tid = tid_, wid = __builtin_amdgcn_readfirstlane(tid >> 6), lane = tid & 63, wr = wid >> 2, wc = wid & 3, fr = lane & 15, fq = lane >> 4;
    unsigned voffA[2], voffB[2];
#pragma unroll
    for (int i = 0; i < 2; ++i) { int R, C; stage_rc(tid * 16 + i * 8192, R, C); const int Rb = (R & ~31) + perm32(R & 31);
        voffA[i] = (unsigned)(R * lda + C) * 2u; voffB[i] = (unsigned)(Rb * ldb + C) * 2u; }
    const size_t kstep = (size_t)(BK * 2);
    const size_t hstepA = (size_t)HALF * lda * 2, hstepB = (size_t)HALF * ldb * 2;
    const unsigned ldsw = (unsigned)wid * 1024u;
    const int aoff = lds_byte(wr * 64 + fr, fq * 8), boff = lds_byte(wc * 32 + fr, fq * 8);
#define PG8_SA(b, h) (((b) * 2 + (h)) * HTB)
#define PG8_SB(b, h) ((4 + (b) * 2 + (h)) * HTB)
#define PG8_STAGE(bufoff, gbase, voff) do { _Pragma("unroll") for (int _i = 0; _i < 2; ++_i) \
        __builtin_amdgcn_global_load_lds((const unsigned*)((const char*)(gbase) + (voff)[_i]), (LAS unsigned*)(lds + (bufoff) + ldsw + _i * 8192), 16, 0, 0); } while (0)
#define PG8_LDA(dst, b, h) do { _Pragma("unroll") for (int m = 0; m < 4; ++m) _Pragma("unroll") for (int k = 0; k < 2; ++k) dst[m][k] = *(const LAS bf16x8*)(lds + PG8_SA(b, h) + aoff + m * 2048 + k * 1024); } while (0)
#define PG8_LDB(dst, b, h) do { _Pragma("unroll") for (int n = 0; n < 2; ++n) _Pragma("unroll") for (int k = 0; k < 2; ++k) dst[n][k] = *(const LAS bf16x8*)(lds + PG8_SB(b, h) + boff + n * 2048 + k * 1024); } while (0)
#define PG8_MMA(ai, bj, At, Bt) do { __builtin_amdgcn_s_setprio(1); _Pragma("unroll") for (int m = 0; m < 4; ++m) _Pragma("unroll") for (int n = 0; n < 2; ++n) _Pragma("unroll") for (int k = 0; k < 2; ++k) \
        acc[ai][bj][m][n] = __builtin_amdgcn_mfma_f32_16x16x32_bf16(Bt[n][k], At[m][k], acc[ai][bj][m][n], 0, 0, 0); __builtin_amdgcn_s_setprio(0); } while (0)
#define PG8_WAIT_V(n) asm volatile("s_waitcnt vmcnt(" #n ")" ::: "memory")
#define PG8_WAIT_L(n) asm volatile("s_waitcnt lgkmcnt(" #n ")" ::: "memory")
#define PG8_BAR __builtin_amdgcn_s_barrier()
#define PG8_SCHED __builtin_amdgcn_sched_barrier(0)
    Unit cur, nxt; int ui = 0;
    if (!S.next(0, cur)) return;
    f32x4 acc[2][2][4][2];
#pragma unroll
    for (int a = 0; a < 2; ++a)
#pragma unroll
        for (int b = 0; b < 2; ++b)
#pragma unroll
            for (int m = 0; m < 4; ++m)
#pragma unroll
                for (int n = 0; n < 2; ++n) acc[a][b][m][n] = (f32x4){0.f, 0.f, 0.f, 0.f};
    bf16x8 At[4][2], B0[2][2], B1[2][2];
    const char* cA = cur.a; const char* cB = cur.b;
    PG8_STAGE(PG8_SB(0, 0), cB, voffB); PG8_STAGE(PG8_SB(0, 1), cB + hstepB, voffB); PG8_STAGE(PG8_SA(0, 0), cA, voffA); PG8_STAGE(PG8_SA(0, 1), cA + hstepA, voffA);
    if (wr == 1) PG8_BAR;
    PG8_WAIT_V(2); PG8_BAR;
    PG8_STAGE(PG8_SB(1, 0), cB + kstep, voffB); PG8_STAGE(PG8_SA(1, 0), cA + kstep, voffA); PG8_STAGE(PG8_SB(1, 1), cB + hstepB + kstep, voffB);
    PG8_WAIT_V(6); PG8_BAR;
    for (;;) {
        const bool has_next = S.next(ui + 1, nxt);
        const char* nA = has_next ? nxt.a : cA; const char* nB = has_next ? nxt.b : cB;
        const int nt = cur.nt;
        for (int t = 0; t < nt; t += 2) {
            const bool last = (t == nt - 2);
            const char* a1 = cA + (size_t)(t + 1) * kstep;
            const char* a2 = last ? nA : cA + (size_t)(t + 2) * kstep; const char* b2 = last ? nB : cB + (size_t)(t + 2) * kstep;
            const char* a3 = a2 + kstep; const char* b3 = b2 + kstep;
            PG8_LDB(B0, 0, 0); PG8_LDB(B1, 0, 1); PG8_SCHED; PG8_LDA(At, 0, 0); PG8_STAGE(PG8_SA(1, 1), a1 + hstepA, voffA);
            PG8_WAIT_V(8); PG8_WAIT_L(0); PG8_BAR; PG8_MMA(0, 0, At, B0); PG8_MMA(0, 1, At, B1); PG8_BAR; PG8_SCHED;
            PG8_LDA(At, 0, 1); PG8_STAGE(PG8_SB(0, 0), b2, voffB); PG8_STAGE(PG8_SB(0, 1), b2 + hstepB, voffB); PG8_STAGE(PG8_SA(0, 0), a2, voffA);
            PG8_WAIT_V(8); PG8_WAIT_L(0); PG8_BAR; PG8_MMA(1, 0, At, B0); PG8_MMA(1, 1, At, B1); PG8_BAR; PG8_SCHED;
            PG8_LDB(B0, 1, 0); PG8_LDB(B1, 1, 1); PG8_SCHED; PG8_LDA(At, 1, 0); PG8_STAGE(PG8_SA(0, 1), a2 + hstepA, voffA);
            PG8_WAIT_V(8); PG8_WAIT_L(0); PG8_BAR; PG8_MMA(0, 0, At, B0); PG8_MMA(0, 1, At, B1); PG8_BAR; PG8_SCHED;
            PG8_LDA(At, 1, 1); PG8_STAGE(PG8_SB(1, 0), b3, voffB); PG8_STAGE(PG8_SB(1, 1), b3 + hstepB, voffB); PG8_STAGE(PG8_SA(1, 0), a3, voffA);
            PG8_WAIT_V(8); PG8_WAIT_L(0); PG8_BAR; PG8_MMA(1, 0, At, B0); PG8_MMA(1, 1, At, B1); PG8_BAR; PG8_SCHED;
        }
        if (wr == 0) PG8_BAR;
        { int t2; asm volatile("v_mbcnt_lo_u32_b32 %0, -1, 0\n\tv_mbcnt_hi_u32_b32 %0, -1, %0" : "=v"(t2)); t2 += wave_id * 64;
          const int wid2 = __builtin_amdgcn_readfirstlane(t2 >> 6), lane2 = t2 & 63; E(acc, cur, wid2 >> 2, wid2 & 3, lane2 & 15, lane2 >> 4); }
        if (!has_next) break;
#pragma unroll
        for (int a = 0; a < 2; ++a)
#pragma unroll
            for (int b = 0; b < 2; ++b)
#pragma unroll
                for (int m = 0; m < 4; ++m)
#pragma unroll
                    for (int n = 0; n < 2; ++n) acc[a][b][m][n] = (f32x4){0.f, 0.f, 0.f, 0.f};
        cur = nxt; cA = nA; cB = nB; ++ui;
        if (wr == 1) PG8_BAR;
    }
    PG8_WAIT_V(0);
    PG8_BAR;
#undef PG8_SA
#undef PG8_SB
#undef PG8_STAGE
#undef PG8_LDA
#undef PG8_LDB
#undef PG8_MMA
#undef PG8_WAIT_V
#undef PG8_WAIT_L
#undef PG8_BAR
#undef PG8_SCHED
}
}

constexpr int NWAVES = 8, NTHREADS = 512;
constexpr int RING_BYTES = 131072;
constexpr int MISC_OFF = 147456 - 256;
constexpr int LDS_BYTES = 147456;

struct Args { const float* in[35]; float* out; unsigned char* ws; int ph_lo, ph_hi; };
enum { I_X = 0, I_C, I_CTX, I_CCTX, I_ADAW, I_ADAB, I_WIN, I_QNORM, I_KVNORM, I_WUQ, I_WUKV, I_MU, I_W0, I_W2, I_A0, I_A2, I_G2, I_KK, I_KA, I_RK, I_LNG, I_LNB,
       I_GQN, I_GKN, I_SINK, I_WBR, I_WOUT, I_LN1G, I_LN1B, I_PWQ, I_PKEYS, I_PU, I_PV, I_LN2G, I_LN2B };

struct Ctx {
    LAS unsigned char* lds;
    const float* const* in; float* out; unsigned char* ws;
    int tid, lane, wave, G, bid;
};

__device__ __forceinline__ void transpose_item(const float* W, int N, int k0, int nsrc0, bf16_t* WT, int ldo, int drow0, int dcol0, const float* ks, float sc, LAS float* scr, int lane) {
#pragma unroll 8
    for (int i = 0; i < 32; ++i) { const int kk = 2 * i + (lane >> 5);
        float v = 0.f; if (nsrc0 >= 0) { v = W[(size_t)(k0 + kk) * N + nsrc0 + (lane & 31)] * sc; if (ks) v *= ks[k0 + kk]; }
        scr[kk * 33 + (lane & 31)] = v; }
    LDS_WAIT(); asm volatile("" ::: "memory");
    const int c = lane & 7;
#pragma unroll
    for (int j = 0; j < 4; ++j) { const int n = (lane >> 3) + 8 * j; const LAS float* s = scr + (8 * c) * 33 + n;
        u32x4 o; o.x = pk2(s[0 * 33], s[1 * 33]); o.y = pk2(s[2 * 33], s[3 * 33]); o.z = pk2(s[4 * 33], s[5 * 33]); o.w = pk2(s[6 * 33], s[7 * 33]);
        *(u32x4*)(WT + (size_t)(drow0 + n) * ldo + dcol0 + k0 + 8 * c) = o; }
    LDS_WAIT(); asm volatile("" ::: "memory");
}
__device__ __forceinline__ int win_src_col(int n) {
    if (n < 416) return n; if (n < 512) return -1;
    if (n < 1280) return 2336 + (n - 512);
    if (n < 2048) return 3104 + (n - 1280);
    if (n < 3968) return 416 + (n - 2048);
    if (n < 4096) return -1;
    return 3872 + (n - 4096);
}
__device__ __forceinline__ void wconv_phase(Ctx& F, int l) {
    LAS float* scr = (LAS float*)(F.lds + F.wave * 16384);
    const int gw = F.bid * NWAVES + F.wave, NGW = F.G * NWAVES;
    const float* win = F.in[I_WIN] + (size_t)l * D * IN_W;
    const float* wbr = F.in[I_WBR] + (size_t)l * 4 * 512 * D;
    const float* wout = F.in[I_WOUT] + (size_t)l * D * D;
    bf16_t* win_t = (bf16_t*)(F.ws + WS_WIN); bf16_t* wbr_t = (bf16_t*)(F.ws + WS_WBR); bf16_t* wout_t = (bf16_t*)(F.ws + WS_WOUT);
    constexpr int I_A = 16 * 256, I_B = 4 * 8 * 32, I_C2 = 16 * 32;
    for (int it = gw; it < I_A + I_B + I_C2; it += NGW) {
        int r = it;
        if (r < I_A) { const int kb = r / 256, nb = r % 256; transpose_item(win, IN_W, 64 * kb, win_src_col(32 * nb), win_t, D, 32 * nb, 0, nullptr, 1.f, scr, F.lane); continue; } r -= I_A;
        if (r < I_B) { const int br = r / 256, rr = r % 256, kb = rr / 32, nb = rr % 32;
            transpose_item(wbr + (size_t)br * 512 * D, D, 64 * kb, 32 * nb, wbr_t + (size_t)(br >> 1) * D * D, D, 32 * nb, (br & 1) * 512, nullptr, 1.f, scr, F.lane); continue; } r -= I_B;
        { const int kb = r / 32, nb = r % 32; transpose_item(wout, D, 64 * kb, 32 * nb, wout_t, D, 32 * nb, 0, nullptr, 1.f, scr, F.lane); }
    }
    const float* wq = F.in[I_PWQ] + (size_t)l * D * D; const float* keys = F.in[I_PKEYS] + (size_t)l * 16 * 128 * 64;
    bf16_t* wpk = (bf16_t*)(F.ws + WS_WPK);
    for (int it = gw; it < 16 * 16 * 4; it += NGW) {
        const int kq = it & 3, g = it >> 6, k = (((it >> 2) & 15) << 6) + F.lane;
        f32x4 q[16];
#pragma unroll
        for (int j = 0; j < 16; ++j) q[j] = *(const f32x4*)(wq + (size_t)k * D + g * 64 + 4 * j);
        for (int key = 32 * kq; key < 32 * kq + 32; ++key) { const float* kr = keys + (size_t)(g * 128 + key) * 64; float s0 = 0.f, s1 = 0.f;
#pragma unroll
            for (int j = 0; j < 16; ++j) { const f32x4 kk = *(const f32x4*)(kr + 4 * j); s0 += q[j].x * kk.x + q[j].z * kk.z; s1 += q[j].y * kk.y + q[j].w * kk.w; }
            wpk[(size_t)(g * 128 + key) * D + k] = (bf16_t)f2bf(s0 + s1); }
    }
}
__device__ __forceinline__ float siluf_(float x) { return x / (1.0f + __expf(-x)); }
__device__ __forceinline__ void pro_phase(Ctx& F) {
    LAS float* scr = (LAS float*)(F.lds + F.wave * 16384);
    const int gw = F.bid * NWAVES + F.wave, NGW = F.G * NWAVES;
    const int gt = F.bid * NTHREADS + F.tid, NGT = F.G * NTHREADS;
    for (int it = gw; it < 2 * (96 + 64); it += NGW) {
        const int l = it / 160, r = it % 160;
        if (r < 96) { const int kb = r / 24, nb = r % 24;
            transpose_item(F.in[I_WUQ] + (size_t)l * 256 * 768, 768, 64 * kb, 32 * nb, (bf16_t*)(F.ws + WS_WUQ) + (size_t)l * 768 * 256, 256, 32 * nb, 0, F.in[I_QNORM] + l * 256, MLA_QS, scr, F.lane); }
        else { const int q = r - 96, kb = q / 32, nb = q % 32, n0 = 32 * nb, h = n0 >> 7, w0 = n0 & 127;
            transpose_item(F.in[I_WUKV] + (size_t)l * 128 * 1024, 1024, 64 * kb, n0, (bf16_t*)(F.ws + WS_WUKV) + (size_t)l * 1024 * 128 + (w0 < 64 ? 0 : 512 * 128), 128, h * 64 + (w0 & 63), 0, F.in[I_KVNORM] + l * 128, 1.f, scr, F.lane); }
    }
    { bf16_t* w2T = (bf16_t*)(F.ws + WS_LORA); bf16_t* a2T = w2T + 2 * 2 * 8 * 4096;
      for (int e = gt; e < 2 * 2 * 8 * 4096; e += NGT) { const int m = e & 63, j = (e >> 6) & 63, h = (e >> 12) & 7, ld = e >> 15;
          w2T[e] = (bf16_t)f2bf(F.in[I_W2][((size_t)ld * 64 + m) * 512 + h * 64 + j]); a2T[e] = (bf16_t)f2bf(F.in[I_A2][((size_t)ld * 64 + m) * 512 + h * 64 + j]); } }
    { bf16_t* g2T = (bf16_t*)(F.ws + WS_LORA) + 2 * (2 * 2 * 8 * 4096);
      for (int e = gt; e < 2 * 512 * 128; e += NGT) { const int k = e & 127, n = (e >> 7) & 511, l = e >> 16; g2T[e] = (bf16_t)f2bf(F.in[I_G2][((size_t)l * 128 + k) * 512 + n]); } }
    { float* cosA = (float*)(F.ws + WS_ROPE); float* sinA = cosA + 4096 * 16; float* cosH = sinA + 4096 * 16; float* sinH = cosH + 4096 * 32;
      for (int e = gt; e < 4096 * 48; e += NGT) { const int t = e / 48, p = e % 48; const float ri = (float)(t >> 6), ci = (float)(t & 63);
          if (p < 16) { const int i = p & 7; const float inv = powf(10000.f, -(float)i / 8.f); const float ang = (p < 8 ? ri : ci) * inv; cosA[t * 16 + p] = cosf(ang); sinA[t * 16 + p] = sinf(ang); }
          else { const int q = p - 16, i = q & 15; const float inv = powf(10000.f, -(float)i / 16.f); const float ang = (q < 16 ? ri : ci) * inv; cosH[t * 32 + q] = cosf(ang); sinH[t * 32 + q] = sinf(ang); } } }
    { float* modp = (float*)(F.ws + WS_MODP); LAS float* sl = (LAS float*)(F.lds + 131072 - 9 * 1024 * 4);
      __syncthreads();
      for (int e = F.tid; e < 9 * 1024; e += NTHREADS) sl[e] = siluf_(e < 8192 ? F.in[I_C][e] : F.in[I_CCTX][e - 8192]);
      __syncthreads();
      for (int it = gw; it < 2 * 16 * 96; it += NGW) { const int l = it / 1536, r = it % 1536, kc = r / 96, jb = r % 96, j = jb * 64 + F.lane;
          float acc[9];
#pragma unroll
          for (int b = 0; b < 9; ++b) acc[b] = 0.f;
          const float* aw = F.in[I_ADAW] + ((size_t)l * D + kc * 64) * 6144 + j;
          for (int kk = 0; kk < 64; ++kk) { const float w = aw[(size_t)kk * 6144]; const int k = kc * 64 + kk;
#pragma unroll
              for (int b = 0; b < 9; ++b) acc[b] += sl[b * 1024 + k] * w; }
#pragma unroll
          for (int b = 0; b < 9; ++b) modp[(((size_t)l * 16 + kc) * 9 + b) * 6144 + j] = acc[b]; }
      __syncthreads(); }
}
__device__ __forceinline__ void pro2_phase(Ctx& F) {
    const int gt = F.bid * NTHREADS + F.tid, NGT = F.G * NTHREADS;
    const float* modp = (const float*)(F.ws + WS_MODP); float* mod = (float*)(F.ws + WS_MOD);
    for (int e = gt; e < 2 * 9 * 6144; e += NGT) { const int j = e % 6144, b = (e / 6144) % 9, l = e / (9 * 6144);
        float s = F.in[I_ADAB][l * 6144 + j];
        for (int kc = 0; kc < 16; ++kc) s += modp[(((size_t)l * 16 + kc) * 9 + b) * 6144 + j];
        mod[e] = s; }
}
__device__ __forceinline__ int mod_slot(int grow) { return grow < MLAT ? (grow >> 12) : 8; }
__device__ __forceinline__ const float* mod_ptr(const Ctx& F, int l, int slot) { return (const float*)(F.ws + WS_MOD) + ((size_t)l * 9 + slot) * 6144; }
__device__ __forceinline__ void xmod0_phase(Ctx& F) {
    const int gw = F.bid * NWAVES + F.wave, NGW = F.G * NWAVES;
    bf16_t* xmod = (bf16_t*)(F.ws + WS_XMOD);
    for (int r = gw; r < MROWS; r += NGW) {
        const float* src = r < MLAT ? F.in[I_X] + (size_t)r * D : F.in[I_CTX] + (size_t)(r - MLAT) * D;
        const float* md = mod_ptr(F, 0, mod_slot(r));
#pragma unroll
        for (int j = 0; j < 4; ++j) { const int c = j * 256 + F.lane * 4;
            const f32x4 x = *(const f32x4*)(src + c), sh = *(const f32x4*)(md + c), sc = *(const f32x4*)(md + 1024 + c);
            u32x2 o; o.x = pk2(x.x * (1.f + sc.x) + sh.x, x.y * (1.f + sc.y) + sh.y); o.y = pk2(x.z * (1.f + sc.z) + sh.z, x.w * (1.f + sc.w) + sh.w);
            *(u32x2*)(xmod + (size_t)r * D + c) = o; }
    }
}

__device__ __forceinline__ int grow_of(int hb, int lr) { return lr < MLL ? hb * MLL + lr : MLAT + hb * NB * CTX + (lr - MLL); }
__device__ __forceinline__ int ltile_grow(int hb, int tm) { return tm < MLL / 256 ? hb * MLL + tm * 256 : MLAT + hb * NB * CTX + (tm - MLL / 256) * 256; }

struct SchedA {
    pg8::TileOrder T1, T2; const char* A; const char* B; int hb, G, c;
    __device__ __forceinline__ bool next(int i, pg8::Unit& u) const { const long L = (long)i * G + c; int tm, tn;
        if (L < T1.nwg) { T1.tileL(L, tm, tn); u.a = A + (size_t)tm * 256 * D * 2; u.b = B + (size_t)(2048 + tn * 256) * D * 2; u.nt = 16; u.pm = tm; u.pn = 8 + tn; u.kind = 1; return true; }
        if (!T2.tileL(L - T1.nwg, tm, tn)) return false;
        u.a = A + (size_t)ltile_grow(hb, tm) * D * 2; u.b = B + (size_t)tn * 256 * D * 2; u.nt = 16; u.pm = tm; u.pn = tn; u.kind = 0; return true; }
};
struct EpiRoute {
    unsigned char* ws;
    __device__ __forceinline__ void operator()(const f32x4 (&acc)[2][2][4][2], const pg8::Unit& u, int wr, int wc, int fr, int fq) const {
        OPAQUE_ZERO(z0); unsigned char* ws = this->ws + z0;
        bf16_t* rp[2]; int step[2];
        const int row0 = u.pm * 256 + wr * 64 + fr;
#pragma unroll
        for (int bj = 0; bj < 2; ++bj) { const int pn = u.pn; size_t off; int pt, co;
            if (pn < 2) { off = R_PM; pt = 512; co = pn * 256 + bj * 128; }
            else if (pn < 4) { off = R_QC; pt = 512; co = (pn - 2) * 256 + bj * 128; }
            else if (pn == 4) { off = bj ? R_VC : R_KC; pt = 128; co = 0; }
            else if (pn < 7) { off = R_QD; pt = 512; co = (pn - 5) * 256 + bj * 128; }
            else if (pn == 7) { off = bj ? R_VD : R_KD; pt = 128; co = 0; }
            else { off = R_PR; pt = 2048; co = (pn - 8) * 256 + bj * 128; }
            rp[bj] = (bf16_t*)(ws + off) + co + wc * 32 + 8 * fq + (size_t)row0 * pt; step[bj] = 16 * pt; }
#pragma unroll
        for (int ai = 0; ai < 2; ++ai) {
#pragma unroll
            for (int m = 0; m < 4; ++m) {
#pragma unroll
                for (int bj = 0; bj < 2; ++bj) { const f32x4 v0 = acc[ai][bj][m][0], v1 = acc[ai][bj][m][1];
                    u32x4 w; w.x = pg8::cvt_pk_bf16(v0[0], v0[1]); w.y = pg8::cvt_pk_bf16(v0[2], v0[3]); w.z = pg8::cvt_pk_bf16(v1[0], v1[1]); w.w = pg8::cvt_pk_bf16(v1[2], v1[3]);
                    *(u32x4*)rp[bj] = w; rp[bj] += step[bj]; }
                asm volatile("" : "+v"(rp[0]), "+v"(rp[1]) :: "memory"); }
            rp[0] += 4 * step[0]; rp[1] += 4 * step[1]; }
    }
};
__device__ __forceinline__ void phaseA(Ctx& F, int hb) {
    SchedA S; S.T1.init(hb == 0 ? MROWS / 256 : 0, 8, F.G, F.bid); S.T2.init(ML / 256, 8, F.G, F.bid); S.A = (const char*)(F.ws + WS_XMOD); S.B = (const char*)(F.ws + WS_WIN); S.hb = hb; S.G = F.G; S.c = F.bid;
    EpiRoute E{F.ws};
    pg8::gemm_phase<EpiRoute, SchedA>(F.lds, F.wave, D, D, S, E);
}

__device__ __forceinline__ void unpack8(const u32x4 w, float (&v)[8]) { v[0] = bflo(w.x); v[1] = bfhi(w.x); v[2] = bflo(w.y); v[3] = bfhi(w.y); v[4] = bflo(w.z); v[5] = bfhi(w.z); v[6] = bflo(w.w); v[7] = bfhi(w.w); }
__device__ __forceinline__ u32x4 pack8(const float (&v)[8]) { u32x4 w; w.x = pk2(v[0], v[1]); w.y = pk2(v[2], v[3]); w.z = pk2(v[4], v[5]); w.w = pk2(v[6], v[7]); return w; }
__device__ __forceinline__ void rope8(float (&v)[8], const float* cs, const float* sn) {
#pragma unroll
    for (int j = 0; j < 4; ++j) { const float a = v[2 * j], b = v[2 * j + 1], c = cs[j], s = sn[j]; v[2 * j] = a * c - b * s; v[2 * j + 1] = a * s + b * c; }
}
__device__ __forceinline__ void phaseB0(Ctx& F, int l, int hb) {
    const int gw = F.bid * NWAVES + F.wave, NGW = F.G * NWAVES, lane = F.lane;
    const float* cosA = (const float*)(F.ws + WS_ROPE); const float* sinA = cosA + 4096 * 16; const float* cosH = sinA + 4096 * 16; const float* sinH = cosH + 4096 * 32;
    bf16_t* Pm = (bf16_t*)(F.ws + R_PM); bf16_t* Ka = (bf16_t*)(F.ws + R_KA);
    bf16_t* Qc = (bf16_t*)(F.ws + R_QC); bf16_t* Kc = (bf16_t*)(F.ws + R_KC); bf16_t* Qd = (bf16_t*)(F.ws + R_QD); bf16_t* Kd = (bf16_t*)(F.ws + R_KD);
    const float* gq = F.in[I_GQN] + l * 64; const float* gk = F.in[I_GKN] + l * 64;
    for (int lr = gw; lr < ML; lr += NGW) {
        const bool lat = lr < MLL; const int t = lat ? (lr & 4095) : 0;
        { float v[8]; unpack8(*(const u32x4*)(Pm + (size_t)lr * 512 + lane * 8), v);
          float ss = 0.f;
#pragma unroll
          for (int j = 0; j < 8; ++j) ss += v[j] * v[j];
          const float sq = wave_sum(lane < 32 ? ss : 0.f), skv = wave_sum((lane >= 32 && lane < 48) ? ss : 0.f);
          if (lane < 48) { const float rs = __builtin_amdgcn_rsqf(lane < 32 ? sq * (1.f / 256.f) + RMS_EPS : skv * (1.f / 128.f) + RMS_EPS);
              float nv[8];
#pragma unroll
              for (int j = 0; j < 8; ++j) nv[j] = v[j] * rs;
              *(u32x4*)(Pm + (size_t)lr * 512 + lane * 8) = pack8(nv); }
          if (lane >= 48 && lane < 52) { const int p0 = 4 * (lane - 48);
              if (lat) rope8(v, cosA + t * 16 + p0, sinA + t * 16 + p0);
              const u32x4 w = pack8(v);
#pragma unroll
              for (int h = 0; h < 8; ++h) *(u32x4*)(Ka + (size_t)lr * 768 + h * 96 + 64 + 8 * (lane - 48)) = w; } }
        { const int p0 = 4 * (lane & 7), d0 = 8 * (lane & 7);
          float v[8]; unpack8(*(const u32x4*)(Qc + (size_t)lr * 512 + lane * 8), v);
          float ss = 0.f;
#pragma unroll
          for (int j = 0; j < 8; ++j) ss += v[j] * v[j];
          ss = group8_sum(ss); const float rs = __builtin_amdgcn_rsqf(ss * (1.f / 64.f) + RMS_EPS);
#pragma unroll
          for (int j = 0; j < 8; ++j) v[j] = v[j] * rs * gq[d0 + j];
          if (lat) rope8(v, cosH + t * 32 + p0, sinH + t * 32 + p0);
#pragma unroll
          for (int j = 0; j < 8; ++j) v[j] *= HD_QS;
          *(u32x4*)(Qc + (size_t)lr * 512 + lane * 8) = pack8(v);
          float q[8]; unpack8(*(const u32x4*)(Qd + (size_t)lr * 512 + lane * 8), q);
          if (lat) rope8(q, cosH + t * 32 + p0, sinH + t * 32 + p0);
#pragma unroll
          for (int j = 0; j < 8; ++j) q[j] *= HD_QS;
          *(u32x4*)(Qd + (size_t)lr * 512 + lane * 8) = pack8(q);
          if (lane < 16) {
              float k[8]; unpack8(*(const u32x4*)(Kc + (size_t)lr * 128 + lane * 8), k);
              float s2 = 0.f;
#pragma unroll
              for (int j = 0; j < 8; ++j) s2 += k[j] * k[j];
              s2 = group8_sum(s2); const float rk = __builtin_amdgcn_rsqf(s2 * (1.f / 64.f) + RMS_EPS);
#pragma unroll
              for (int j = 0; j < 8; ++j) k[j] = k[j] * rk * gk[d0 + j];
              if (lat) rope8(k, cosH + t * 32 + p0, sinH + t * 32 + p0);
              *(u32x4*)(Kc + (size_t)lr * 128 + lane * 8) = pack8(k);
              float kd[8]; unpack8(*(const u32x4*)(Kd + (size_t)lr * 128 + lane * 8), kd);
              if (lat) rope8(kd, cosH + t * 32 + p0, sinH + t * 32 + p0);
              *(u32x4*)(Kd + (size_t)lr * 128 + lane * 8) = pack8(kd);
          } }
    }
    LAS bf16_t* tile = (LAS bf16_t*)F.lds;
    for (int it = F.bid; it < 2 * (ML / 64); it += F.G) {
        const int which = it / (ML / 64), rb = it % (ML / 64), lr0 = rb * 64;
        const bf16_t* src = (const bf16_t*)(F.ws + (which ? R_VD : R_VC)); bf16_t* dst = (bf16_t*)(F.ws + (which ? R_VDT : R_VCT));
        __syncthreads();
#pragma unroll
        for (int i = 0; i < 2; ++i) { const int e = F.tid + i * 512, r = e >> 4, c8 = e & 15;
            *(LAS u32x4*)(tile + r * 136 + c8 * 8) = *(const u32x4*)(src + (size_t)(lr0 + r) * 128 + c8 * 8); }
        __syncthreads();
        const int c = F.tid >> 2, pq = F.tid & 3;
        const bool lat = lr0 < MLL; const int bl = lat ? (lr0 >> 12) : ((lr0 - MLL) >> 8); const int pos0 = lat ? (lr0 & 4095) : 4096 + ((lr0 - MLL) & 255);
        unsigned w[8];
#pragma unroll
        for (int j = 0; j < 8; ++j) w[j] = (unsigned)tile[(pq * 16 + 2 * j) * 136 + c] | ((unsigned)tile[(pq * 16 + 2 * j + 1) * 136 + c] << 16);
        bf16_t* o = dst + ((size_t)(bl * 2 + (c >> 6)) * 64 + (c & 63)) * LTOT + pos0 + pq * 16;
        *(u32x4*)o = (u32x4){w[0], w[1], w[2], w[3]}; *(u32x4*)(o + 8) = (u32x4){w[4], w[5], w[6], w[7]};
    }
    __syncthreads();
}

struct SchedB1 {
    pg8::TileOrder T; const char* A; const char* B; int ldb2; int nt;
    __device__ __forceinline__ bool next(int i, pg8::Unit& u) const { int tm, tn; if (!T.tile(i, tm, tn)) return false;
        u.a = A + (size_t)tm * 256 * 512 * 2; u.b = B + (size_t)tn * 256 * ldb2; u.nt = nt; u.pm = tm; u.pn = tn; u.kind = 0; return true; }
};
struct EpiMlaQ {
    unsigned char* ws;
    __device__ __forceinline__ void operator()(const f32x4 (&acc)[2][2][4][2], const pg8::Unit& u, int wr, int wc, int fr, int fq) const {
        OPAQUE_ZERO(z0); unsigned char* ws = this->ws + z0;
        bf16_t* qp = (bf16_t*)(ws + R_QA) + (size_t)(u.pm * 256 + wr * 64 + fr) * 768 + u.pn * 256 + wc * 32 + 8 * fq;
#pragma unroll
        for (int ai = 0; ai < 2; ++ai) {
#pragma unroll
            for (int m = 0; m < 4; ++m) {
#pragma unroll
                for (int bj = 0; bj < 2; ++bj) { const f32x4 v0 = acc[ai][bj][m][0], v1 = acc[ai][bj][m][1];
                    u32x4 w; w.x = pg8::cvt_pk_bf16(v0[0], v0[1]); w.y = pg8::cvt_pk_bf16(v0[2], v0[3]); w.z = pg8::cvt_pk_bf16(v1[0], v1[1]); w.w = pg8::cvt_pk_bf16(v1[2], v1[3]);
                    *(u32x4*)(qp + bj * 128) = w; }
                qp += 16 * 768; asm volatile("" : "+v"(qp) :: "memory"); }
            qp += 64 * 768; }
    }
};
struct EpiMlaK {
    unsigned char* ws;
    __device__ __forceinline__ void operator()(const f32x4 (&acc)[2][2][4][2], const pg8::Unit& u, int wr, int wc, int fr, int fq) const {
        OPAQUE_ZERO(z0); unsigned char* ws = this->ws + z0;
        const int c0 = u.pn * 256 + wc * 32 + 8 * fq;
        bf16_t* kp = (bf16_t*)(ws + R_KA) + (size_t)(u.pm * 256 + wr * 64 + fr) * 768 + (c0 >> 6) * 96 + (c0 & 63);
#pragma unroll
        for (int ai = 0; ai < 2; ++ai) {
#pragma unroll
            for (int m = 0; m < 4; ++m) {
#pragma unroll
                for (int bj = 0; bj < 2; ++bj) { const f32x4 v0 = acc[ai][bj][m][0], v1 = acc[ai][bj][m][1];
                    u32x4 w; w.x = pg8::cvt_pk_bf16(v0[0], v0[1]); w.y = pg8::cvt_pk_bf16(v0[2], v0[3]); w.z = pg8::cvt_pk_bf16(v1[0], v1[1]); w.w = pg8::cvt_pk_bf16(v1[2], v1[3]);
                    *(u32x4*)(kp + bj * 192) = w; }
                kp += 16 * 768; asm volatile("" : "+v"(kp) :: "memory"); }
            kp += 64 * 768; }
    }
};
struct EpiMlaVT {
    unsigned char* ws;
    __device__ __forceinline__ void operator()(const f32x4 (&acc)[2][2][4][2], const pg8::Unit& u, int wr, int wc, int fr, int fq) const {
        OPAQUE_ZERO(z0); unsigned char* ws = this->ws + z0;
        const int lr0 = u.pn * 256;
        const bool lat = lr0 < MLL; const int bl = lat ? (lr0 >> 12) : ((lr0 - MLL) >> 8); const int pos0 = lat ? (lr0 & 4095) : 4096 + ((lr0 - MLL) & 255);
        bf16_t* vp = (bf16_t*)(ws + R_VAT) + ((size_t)bl * 512 + u.pm * 256 + wr * 64 + fr) * LTOT + pos0 + wc * 32 + 8 * fq;
#pragma unroll
        for (int ai = 0; ai < 2; ++ai) {
#pragma unroll
            for (int m = 0; m < 4; ++m) {
#pragma unroll
                for (int bj = 0; bj < 2; ++bj) { const f32x4 v0 = acc[ai][bj][m][0], v1 = acc[ai][bj][m][1];
                    u32x4 w; w.x = pg8::cvt_pk_bf16(v0[0], v0[1]); w.y = pg8::cvt_pk_bf16(v0[2], v0[3]); w.z = pg8::cvt_pk_bf16(v1[0], v1[1]); w.w = pg8::cvt_pk_bf16(v1[2], v1[3]);
                    *(u32x4*)(vp + bj * 128) = w; }
                vp += (size_t)16 * LTOT; asm volatile("" : "+v"(vp) :: "memory"); }
            vp += (size_t)64 * LTOT; }
    }
};
struct SchedB1T {
    pg8::TileOrder T; const char* A; const char* B;
    __device__ __forceinline__ bool next(int i, pg8::Unit& u) const { int tm, tn; if (!T.tile(i, tm, tn)) return false;
        u.a = A + (size_t)tm * 256 * 128 * 2; u.b = B + (size_t)tn * 256 * 512 * 2; u.nt = 2; u.pm = tm; u.pn = tn; u.kind = 0; return true; }
};
__device__ __forceinline__ void phaseB1q(Ctx& F, int l) {
    SchedB1 S; S.T.init(ML / 256, 3, F.G, F.bid); S.A = (const char*)(F.ws + R_PM); S.B = (const char*)(F.ws + WS_WUQ) + (size_t)l * 768 * 256 * 2; S.ldb2 = 256 * 2; S.nt = 4;
    EpiMlaQ E{F.ws}; pg8::gemm_phase<EpiMlaQ, SchedB1>(F.lds, F.wave, 512, 256, S, E);
}
__device__ __forceinline__ void phaseB1k(Ctx& F, int l) {
    SchedB1 S; S.T.init(ML / 256, 2, F.G, F.bid); S.A = (const char*)(F.ws + R_PM) + 256 * 2; S.B = (const char*)(F.ws + WS_WUKV) + (size_t)l * 1024 * 128 * 2; S.ldb2 = 128 * 2; S.nt = 2;
    EpiMlaK E{F.ws}; pg8::gemm_phase<EpiMlaK, SchedB1>(F.lds, F.wave, 512, 128, S, E);
}
__device__ __forceinline__ void phaseB1v(Ctx& F, int l) {
    SchedB1T S; S.T.init(2, ML / 256, F.G, F.bid); S.A = (const char*)(F.ws + WS_WUKV) + ((size_t)l * 1024 * 128 + 512 * 128) * 2; S.B = (const char*)(F.ws + R_PM) + 256 * 2;
    EpiMlaVT E{F.ws}; pg8::gemm_phase<EpiMlaVT, SchedB1T>(F.lds, F.wave, 128, 512, S, E);
}

struct AttnWave { const bf16_t* q; int qpitch; bf16_t* o; int opitch; int qpos; const float* rope; };
struct AttnKeys { const bf16_t* k; int kpitch; const bf16_t* vt; int lat_p0, lat_n, ctx_n; int bl; int wmask; int has_sink; float sink2; };
template <int DQK>
__device__ __forceinline__ void attn_unit(Ctx& F, const AttnWave& W, const AttnKeys& Kd) {
    constexpr int NCH = DQK / 8, ND0 = DQK / 16, KT_BYTES = NCH * 1024, VT_BYTES = 64 * 144, BUF = KT_BYTES + VT_BYTES;
    constexpr int KPASS = (NCH * 64 + 511) / 512;
    LAS unsigned char* lds = F.lds;
    const int tid = F.tid, lane = F.lane, r32 = lane & 31, hi = lane >> 5;
    const int ntiles = Kd.lat_n + Kd.ctx_n;
    bf16x8 qf[ND0];
#pragma unroll
    for (int d0 = 0; d0 < ND0; ++d0) qf[d0] = *(const bf16x8*)(W.q + (size_t)r32 * W.qpitch + d0 * 16 + hi * 8);
    if constexpr (DQK == 96) if (W.rope) {
#pragma unroll
        for (int d0 = 4; d0 < 6; ++d0) { float v[8]; unpack8(__builtin_bit_cast(u32x4, qf[d0]), v); const float* cs = W.rope + r32 * 16 + 8 * (d0 - 4) + 4 * hi;
            rope8(v, cs, cs + 4096 * 16); qf[d0] = __builtin_bit_cast(bf16x8, pack8(v)); } }
    f32x16 o0 = {}, o1 = {}; float m_run = 0.f, l_run = 0.f; f32x16 negm = {};
    u32x4 kreg[KPASS], vreg;
    auto tile_pos = [&](int t) -> int { return t < Kd.lat_n ? Kd.lat_p0 + 64 * t : 4096 + 64 * (t - Kd.lat_n); };
    auto gload = [&](int t) {
        const int pos = tile_pos(t);
        const int krow0 = pos < 4096 ? Kd.bl * 4096 + pos : MLL + Kd.bl * 256 + (pos - 4096);
#pragma unroll
        for (int p = 0; p < KPASS; ++p) { const int e = tid + p * 512; if (e < NCH * 64) { const int key = e & 63, ch = e >> 6; kreg[p] = *(const u32x4*)(Kd.k + (size_t)(krow0 + key) * Kd.kpitch + ch * 8); } }
        { const int d = tid >> 3, kc = tid & 7; vreg = *(const u32x4*)(Kd.vt + (size_t)d * LTOT + pos + kc * 8); }
    };
    auto lstore = [&](int buf) {
        LAS unsigned char* kb = lds + buf * BUF; LAS unsigned char* vb = kb + KT_BYTES;
#pragma unroll
        for (int p = 0; p < KPASS; ++p) { const int e = tid + p * 512; if (e < NCH * 64) { const int key = e & 63, ch = e >> 6; *(LAS u32x4*)(kb + ch * 1024 + key * 16) = kreg[p]; } }
        { const int d = tid >> 3, kc = tid & 7, g = kc >> 1, half = kc & 1;
          *(LAS u32x2*)(vb + d * 144 + g * 32 + half * 8) = (u32x2){vreg.x, vreg.y};
          *(LAS u32x2*)(vb + d * 144 + g * 32 + (2 + half) * 8) = (u32x2){vreg.z, vreg.w}; }
    };
    __syncthreads();
    gload(0); lstore(0);
    __syncthreads();
    for (int t = 0; t < ntiles; ++t) {
        const int buf = t & 1;
        if (t + 1 < ntiles) gload(t + 1);
        LAS unsigned char* kb = lds + buf * BUF; LAS unsigned char* vb = kb + KT_BYTES;
        f32x16 p0 = negm, p1 = negm;
#pragma unroll
        for (int d0 = 0; d0 < ND0; ++d0) {
            const bf16x8 k0 = *(const LAS bf16x8*)(kb + (2 * d0 + hi) * 1024 + r32 * 16);
            const bf16x8 k1 = *(const LAS bf16x8*)(kb + (2 * d0 + hi) * 1024 + (32 + r32) * 16);
            p0 = __builtin_amdgcn_mfma_f32_32x32x16_bf16(k0, qf[d0], p0, 0, 0, 0);
            p1 = __builtin_amdgcn_mfma_f32_32x32x16_bf16(k1, qf[d0], p1, 0, 0, 0);
        }
        if (Kd.wmask && t < Kd.lat_n) {
            const int jb = tile_pos(t) + 4 * hi - (W.qpos + r32);
#pragma unroll
            for (int r = 0; r < 16; ++r) { const int dj = jb + (r & 3) + 8 * (r >> 2);
                if (dj > 128 || dj < -128) p0[r] = -INFINITY;
                if (dj + 32 > 128 || dj + 32 < -128) p1[r] = -INFINITY; }
        }
        float ma = __builtin_fmaxf(__builtin_fmaxf(p0[0], p0[1]), p1[0]), mb = __builtin_fmaxf(__builtin_fmaxf(p0[2], p0[3]), p1[1]);
        ma = __builtin_fmaxf(__builtin_fmaxf(ma, p1[2]), p1[3]);
#pragma unroll
        for (int r = 4; r < 16; r += 4) { ma = __builtin_fmaxf(__builtin_fmaxf(ma, p0[r]), p0[r + 1]); mb = __builtin_fmaxf(__builtin_fmaxf(mb, p0[r + 2]), p0[r + 3]);
            ma = __builtin_fmaxf(__builtin_fmaxf(ma, p1[r]), p1[r + 1]); mb = __builtin_fmaxf(__builtin_fmaxf(mb, p1[r + 2]), p1[r + 3]); }
        float mx = __builtin_fmaxf(ma, mb);
        { auto rr = __builtin_amdgcn_permlane32_swap(__float_as_uint(mx), __float_as_uint(mx), false, false); mx = __builtin_fmaxf(__uint_as_float(rr[0]), __uint_as_float(rr[1])); }
        if (t == 0 || __any(mx > 8.0f)) {
            const float dl = t == 0 ? __builtin_fmaxf(mx, -100.f) : __builtin_fmaxf(mx, 0.f), alpha = __builtin_amdgcn_exp2f(-dl);
            m_run += dl; l_run *= alpha;
#pragma unroll
            for (int r = 0; r < 16; ++r) { o0[r] *= alpha; o1[r] *= alpha; p0[r] -= dl; p1[r] -= dl; negm[r] = -m_run; }
        }
        float ps0 = 0.f, ps1 = 0.f;
#pragma unroll
        for (int r = 0; r < 16; ++r) { p0[r] = __builtin_amdgcn_exp2f(p0[r]); p1[r] = __builtin_amdgcn_exp2f(p1[r]); ps0 += p0[r]; ps1 += p1[r]; }
        l_run += ps0 + ps1;
        bf16x8 pf[4];
#pragma unroll
        for (int s = 0; s < 4; ++s) { u32x4 w;
            if (s < 2) { w.x = pg8::cvt_pk_bf16(p0[8 * s + 0], p0[8 * s + 1]); w.y = pg8::cvt_pk_bf16(p0[8 * s + 2], p0[8 * s + 3]); w.z = pg8::cvt_pk_bf16(p0[8 * s + 4], p0[8 * s + 5]); w.w = pg8::cvt_pk_bf16(p0[8 * s + 6], p0[8 * s + 7]); }
            else { const int b = 8 * (s - 2); w.x = pg8::cvt_pk_bf16(p1[b + 0], p1[b + 1]); w.y = pg8::cvt_pk_bf16(p1[b + 2], p1[b + 3]); w.z = pg8::cvt_pk_bf16(p1[b + 4], p1[b + 5]); w.w = pg8::cvt_pk_bf16(p1[b + 6], p1[b + 7]); }
            pf[s] = __builtin_bit_cast(bf16x8, w); }
#pragma unroll
        for (int s = 0; s < 4; ++s) {
            const bf16x8 v0 = *(const LAS bf16x8*)(vb + r32 * 144 + s * 32 + hi * 16);
            const bf16x8 v1 = *(const LAS bf16x8*)(vb + (32 + r32) * 144 + s * 32 + hi * 16);
            o0 = __builtin_amdgcn_mfma_f32_32x32x16_bf16(v0, pf[s], o0, 0, 0, 0);
            o1 = __builtin_amdgcn_mfma_f32_32x32x16_bf16(v1, pf[s], o1, 0, 0, 0);
        }
        if (t + 1 < ntiles) lstore(buf ^ 1);
        __syncthreads();
    }
    { auto rr = __builtin_amdgcn_permlane32_swap(__float_as_uint(l_run), __float_as_uint(l_run), false, false); l_run = __uint_as_float(rr[0]) + __uint_as_float(rr[1]); }
    if (Kd.has_sink) l_run += __builtin_amdgcn_exp2f(Kd.sink2 - m_run);
    const float inv = 1.0f / l_run;
    bf16_t* orow = W.o + (size_t)r32 * W.opitch;
#pragma unroll
    for (int g = 0; g < 4; ++g) {
        u32x2 a; a.x = pg8::cvt_pk_bf16(o0[4 * g] * inv, o0[4 * g + 1] * inv); a.y = pg8::cvt_pk_bf16(o0[4 * g + 2] * inv, o0[4 * g + 3] * inv);
        *(u32x2*)(orow + 8 * g + 4 * hi) = a;
        u32x2 b; b.x = pg8::cvt_pk_bf16(o1[4 * g] * inv, o1[4 * g + 1] * inv); b.y = pg8::cvt_pk_bf16(o1[4 * g + 2] * inv, o1[4 * g + 3] * inv);
        *(u32x2*)(orow + 32 + 8 * g + 4 * hi) = b;
    }
}

typedef float f32x2v __attribute__((ext_vector_type(2))); typedef __bf16 bf16x2v __attribute__((ext_vector_type(2)));
__device__ __forceinline__ unsigned cvtpk_s(float lo, float hi) { f32x2v v = {lo, hi}; bf16x2v b = __builtin_convertvector(v, bf16x2v); return __builtin_bit_cast(unsigned, b); }
__device__ __forceinline__ void attn_unit_p64(Ctx& F, const AttnWave& W, const AttnKeys& Kd) {
    constexpr int KT_BYTES = 8192, VT_BYTES = 64 * 144, VOFF = 2 * KT_BYTES;
    LAS unsigned char* lds = F.lds;
    const int tid = F.tid, lane = F.lane, r32 = lane & 31, hi = lane >> 5;
    const int NT = Kd.lat_n + Kd.ctx_n;
    bf16x8 qf[4];
#pragma unroll
    for (int d0 = 0; d0 < 4; ++d0) qf[d0] = *(const bf16x8*)(W.q + (size_t)r32 * W.qpitch + d0 * 16 + hi * 8);
    f32x16 o0 = {}, o1 = {}; float m_run = 0.f, l_run = 0.f; f32x16 negm = {}; asm volatile("" : "+v"(negm));
    u32x4 kreg, vreg;
    auto tile_pos = [&](int t) -> int { return t < Kd.lat_n ? Kd.lat_p0 + 64 * t : 4096 + 64 * (t - Kd.lat_n); };
    auto gloadK = [&](int t) { const int pos = tile_pos(t); const int krow0 = pos < 4096 ? Kd.bl * 4096 + pos : MLL + Kd.bl * 256 + (pos - 4096);
        const int key = tid & 63, ch = tid >> 6; kreg = *(const u32x4*)(Kd.k + (size_t)(krow0 + key) * Kd.kpitch + ch * 8); };
    auto gloadV = [&](int t) { const int pos = tile_pos(t); const int d = tid >> 3, kc = tid & 7; vreg = *(const u32x4*)(Kd.vt + (size_t)d * LTOT + pos + kc * 8); };
    auto lstoreK = [&](int kslot) { const int key = tid & 63, ch = tid >> 6; *(LAS u32x4*)(lds + kslot + ch * 1024 + key * 16) = kreg; };
    auto lstoreV = [&](int vslot) { LAS unsigned char* vb = lds + VOFF + vslot; const int d = tid >> 3, kc = tid & 7, g = kc >> 1, half = kc & 1;
        *(LAS u32x2*)(vb + d * 144 + g * 32 + half * 8) = (u32x2){vreg.x, vreg.y};
        *(LAS u32x2*)(vb + d * 144 + g * 32 + (2 + half) * 8) = (u32x2){vreg.z, vreg.w}; };
    auto wmask = [&](f32x16& c0, f32x16& c1, int t) {
        if (Kd.wmask && t < Kd.lat_n) {
            const int jb = tile_pos(t) + 4 * hi - (W.qpos + r32);
#pragma unroll
            for (int r = 0; r < 16; ++r) { const int dj = jb + (r & 3) + 8 * (r >> 2);
                if (dj > 128 || dj < -128) c0[r] = -INFINITY;
                if (dj + 32 > 128 || dj + 32 < -128) c1[r] = -INFINITY; }
        } };
    const LAS unsigned char* kp0 = lds + hi * 1024 + r32 * 16;
    const LAS unsigned char* vp0 = lds + VOFF + r32 * 144 + hi * 16;
    bf16x8 kf[8], vf[8]; u32x4 pw0, pw1, pw2, pw3; f32x16 pA0, pA1, pB0, pB1;
    __syncthreads();
    gloadK(0); gloadV(0); lstoreK(0); lstoreV(0);
    if (NT > 1) { gloadK(1); lstoreK(KT_BYTES); }
    if (NT > 2) gloadK(2);
    if (NT > 1) gloadV(1);
    LDS_BARRIER();
    pA0 = negm; pA1 = negm;
#pragma unroll
    for (int d0 = 0; d0 < 4; ++d0) {
        const bf16x8 k0 = *(const LAS bf16x8*)(kp0 + d0 * 2048);
        const bf16x8 k1 = *(const LAS bf16x8*)(kp0 + d0 * 2048 + 512);
        pA0 = __builtin_amdgcn_mfma_f32_32x32x16_bf16(k0, qf[d0], pA0, 0, 0, 0);
        pA1 = __builtin_amdgcn_mfma_f32_32x32x16_bf16(k1, qf[d0], pA1, 0, 0, 0);
    }
    wmask(pA0, pA1, 0);
#define AP_MX3(a, b, c) __builtin_fmaxf(__builtin_fmaxf((a), (b)), (c))
#define AP_ROWMAX(C0, C1, rm) do { float a_ = AP_MX3(C0[0], C0[1], C1[0]), b_ = AP_MX3(C0[2], C0[3], C1[1]); a_ = AP_MX3(a_, C1[2], C1[3]); \
        _Pragma("unroll") for (int r = 4; r < 16; r += 4) { a_ = AP_MX3(a_, C0[r], C0[r + 1]); b_ = AP_MX3(b_, C0[r + 2], C0[r + 3]); a_ = AP_MX3(a_, C1[r], C1[r + 1]); b_ = AP_MX3(b_, C1[r + 2], C1[r + 3]); } \
        rm = __builtin_fmaxf(a_, b_); { auto rr_ = __builtin_amdgcn_permlane32_swap(__float_as_uint(rm), __float_as_uint(rm), false, false); rm = __builtin_fmaxf(__uint_as_float(rr_[0]), __uint_as_float(rr_[1])); } } while (0)
    { float rm; AP_ROWMAX(pA0, pA1, rm); const float dl = __builtin_fmaxf(rm, -100.f);
      m_run = dl;
#pragma unroll
      for (int r = 0; r < 16; ++r) { pA0[r] -= dl; pA1[r] -= dl; negm[r] = -m_run; }
      asm volatile("" : "+v"(negm));
#pragma unroll
      for (int r = 0; r < 16; ++r) { pA0[r] = __builtin_amdgcn_exp2f(pA0[r]); pA1[r] = __builtin_amdgcn_exp2f(pA1[r]); } }
    LDS_BARRIER();
    if (NT > 2) lstoreK(0);
    if (NT > 1) lstoreV(VT_BYTES);
    if (NT > 1) {
#pragma unroll
        for (int j = 0; j < 4; ++j) { kf[2 * j] = *(const LAS bf16x8*)(kp0 + KT_BYTES + j * 2048); kf[2 * j + 1] = *(const LAS bf16x8*)(kp0 + KT_BYTES + j * 2048 + 512); } }
    LDS_BARRIER();
    int vs_prev = 0, vs_st = 2 * VT_BYTES;
    bool resc = false; float alpha = 1.f;
#define AP_SBAR() __builtin_amdgcn_sched_barrier(0)
#define AP_PIN(x) asm volatile("" : "+v"(x))
#define AP_MF(a, b, c) __builtin_amdgcn_mfma_f32_32x32x16_bf16(a, b, c, 0, 0, 0)
#define AP_PKW(P, B) cvtpk_s(P[B], P[(B) + 1])
#define AP_PAF(k) __builtin_bit_cast(bf16x8, pw##k)
#define AP_EX(v) __builtin_amdgcn_exp2f(v)
#define AP_VRD(i) do { vf[i] = *(const LAS bf16x8*)(vp_ + ((i) >> 1) * 32 + ((i) & 1) * 4608); } while (0)
#define AP_KRD(G, j) do { if (G) { kf[2 * (j)] = *(const LAS bf16x8*)(kn_ + (j) * 2048); kf[2 * (j) + 1] = *(const LAS bf16x8*)(kn_ + (j) * 2048 + 512); AP_SBAR(); } } while (0)
#define AP_GAPA(MF, A0, A1, A2, A3, W0, W1, PW) do { MF; sacc += A0; sacc += A1; sacc += A2; sacc += A3; AP_PIN(sacc); W0; W1; AP_PIN(PW); AP_SBAR(); } while (0)
#define AP_GAPB(MF, X, B) do { MF; X[B] = AP_EX(X[B]); X[(B) + 1] = AP_EX(X[(B) + 1]); X[(B) + 2] = AP_EX(X[(B) + 2]); X[(B) + 3] = AP_EX(X[(B) + 3]); AP_PIN(X); AP_SBAR(); } while (0)
#define AP_STEP(C0, C1, P0, P1, t) do { AP_SBAR(); \
        const bool gk_ = (t) + 2 < NT, gl_ = (t) + 1 < NT; \
        if (gk_) gloadK((t) + 2); if (gl_) gloadV((t) + 1); \
        const LAS unsigned char* vp_ = vp0 + vs_prev; const LAS unsigned char* kn_ = kp0 + ((((t) + 1) & 1) ? KT_BYTES : 0); \
        AP_VRD(0); AP_SBAR(); float sacc = (P0[0] + P0[1]); \
        AP_GAPA(C0 = AP_MF(kf[0], qf[0], negm), P0[2], P0[3], P0[4], P0[5],     pw0[0] = AP_PKW(P0, 0), pw0[1] = AP_PKW(P0, 2), pw0); \
        AP_VRD(1); AP_SBAR(); AP_GAPA(C1 = AP_MF(kf[1], qf[0], negm), P0[6], P0[7], P0[8], P0[9],     pw0[2] = AP_PKW(P0, 4), pw0[3] = AP_PKW(P0, 6), pw0); \
        AP_VRD(2); AP_SBAR(); AP_GAPA(C0 = AP_MF(kf[2], qf[1], C0),   P0[10], P0[11], P0[12], P0[13], pw1[0] = AP_PKW(P0, 8), pw1[1] = AP_PKW(P0, 10), pw1); \
        AP_VRD(3); AP_SBAR(); AP_GAPA(C1 = AP_MF(kf[3], qf[1], C1),   P0[14], P0[15], P1[0], P1[1],   pw1[2] = AP_PKW(P0, 12), pw1[3] = AP_PKW(P0, 14), pw1); \
        AP_VRD(4); AP_SBAR(); AP_GAPA(C0 = AP_MF(kf[4], qf[2], C0),   P1[2], P1[3], P1[4], P1[5],     pw2[0] = AP_PKW(P1, 0), pw2[1] = AP_PKW(P1, 2), pw2); \
        AP_VRD(5); AP_SBAR(); AP_GAPA(C1 = AP_MF(kf[5], qf[2], C1),   P1[6], P1[7], P1[8], P1[9],     pw2[2] = AP_PKW(P1, 4), pw2[3] = AP_PKW(P1, 6), pw2); \
        AP_VRD(6); AP_SBAR(); AP_GAPA(C0 = AP_MF(kf[6], qf[3], C0),   P1[10], P1[11], P1[12], P1[13], pw3[0] = AP_PKW(P1, 8), pw3[1] = AP_PKW(P1, 10), pw3); \
        AP_VRD(7); AP_SBAR(); AP_GAPA(C1 = AP_MF(kf[7], qf[3], C1),   P1[14], P1[15], 0.f, 0.f,       pw3[2] = AP_PKW(P1, 12), pw3[3] = AP_PKW(P1, 14), pw3); \
        l_run += sacc; \
        wmask(C0, C1, (t)); \
        { float rm; AP_ROWMAX(C0, C1, rm); resc = false; \
          if (__builtin_expect(__any(rm > 8.0f), 0)) { const float dl = __builtin_fmaxf(rm, 0.f); m_run += dl; \
            _Pragma("unroll") for (int r = 0; r < 16; ++r) { C0[r] -= dl; C1[r] -= dl; } \
            _Pragma("unroll") for (int r = 0; r < 16; ++r) negm[r] = -m_run; asm volatile("" : "+v"(negm)); \
            alpha = __builtin_amdgcn_exp2f(-dl); l_run *= alpha; resc = true; } } \
        AP_SBAR(); \
        AP_GAPB(o0 = AP_MF(vf[0], AP_PAF(0), o0), C0, 0); \
        AP_GAPB(o1 = AP_MF(vf[1], AP_PAF(0), o1), C0, 4); \
        AP_KRD(gl_, 0); AP_GAPB(o0 = AP_MF(vf[2], AP_PAF(1), o0), C0, 8); \
        AP_KRD(gl_, 1); AP_GAPB(o1 = AP_MF(vf[3], AP_PAF(1), o1), C0, 12); \
        AP_KRD(gl_, 2); AP_GAPB(o0 = AP_MF(vf[4], AP_PAF(2), o0), C1, 0); \
        AP_KRD(gl_, 3); AP_GAPB(o1 = AP_MF(vf[5], AP_PAF(2), o1), C1, 4); \
        AP_GAPB(o0 = AP_MF(vf[6], AP_PAF(3), o0), C1, 8); \
        AP_GAPB(o1 = AP_MF(vf[7], AP_PAF(3), o1), C1, 12); \
        if (gk_) lstoreK(((t) & 1) ? KT_BYTES : 0); \
        if (gl_) lstoreV(vs_st); \
        LDS_BARRIER(); \
        if (resc) { _Pragma("unroll") for (int r = 0; r < 16; ++r) { o0[r] *= alpha; o1[r] *= alpha; } } \
        vs_prev = vs_prev == 2 * VT_BYTES ? 0 : vs_prev + VT_BYTES; vs_st = vs_st == 2 * VT_BYTES ? 0 : vs_st + VT_BYTES; \
    } while (0)
#define AP_DRAIN(P0, P1) do { float sacc = P0[0] + P0[1]; _Pragma("unroll") for (int r = 2; r < 16; ++r) sacc += P0[r]; _Pragma("unroll") for (int r = 0; r < 16; ++r) sacc += P1[r]; l_run += sacc; \
        pw0 = (u32x4){AP_PKW(P0, 0), AP_PKW(P0, 2), AP_PKW(P0, 4), AP_PKW(P0, 6)}; pw1 = (u32x4){AP_PKW(P0, 8), AP_PKW(P0, 10), AP_PKW(P0, 12), AP_PKW(P0, 14)}; \
        pw2 = (u32x4){AP_PKW(P1, 0), AP_PKW(P1, 2), AP_PKW(P1, 4), AP_PKW(P1, 6)}; pw3 = (u32x4){AP_PKW(P1, 8), AP_PKW(P1, 10), AP_PKW(P1, 12), AP_PKW(P1, 14)}; \
        const LAS unsigned char* vp_ = vp0 + vs_prev; \
        _Pragma("unroll") for (int i = 0; i < 8; ++i) AP_VRD(i); \
        o0 = AP_MF(vf[0], AP_PAF(0), o0); o1 = AP_MF(vf[1], AP_PAF(0), o1); o0 = AP_MF(vf[2], AP_PAF(1), o0); o1 = AP_MF(vf[3], AP_PAF(1), o1); \
        o0 = AP_MF(vf[4], AP_PAF(2), o0); o1 = AP_MF(vf[5], AP_PAF(2), o1); o0 = AP_MF(vf[6], AP_PAF(3), o0); o1 = AP_MF(vf[7], AP_PAF(3), o1); } while (0)
    int t = 1;
    for (; t + 1 < NT; t += 2) { AP_STEP(pB0, pB1, pA0, pA1, t); AP_STEP(pA0, pA1, pB0, pB1, t + 1); }
    if (t < NT) { AP_STEP(pB0, pB1, pA0, pA1, t); AP_DRAIN(pB0, pB1); }
    else { AP_DRAIN(pA0, pA1); }
#undef AP_MX3
#undef AP_ROWMAX
#undef AP_SBAR
#undef AP_PIN
#undef AP_MF
#undef AP_PKW
#undef AP_PAF
#undef AP_EX
#undef AP_VRD
#undef AP_KRD
#undef AP_GAPA
#undef AP_GAPB
#undef AP_STEP
#undef AP_DRAIN
    { auto rr = __builtin_amdgcn_permlane32_swap(__float_as_uint(l_run), __float_as_uint(l_run), false, false); l_run = __uint_as_float(rr[0]) + __uint_as_float(rr[1]); }
    if (Kd.has_sink) l_run += __builtin_amdgcn_exp2f(Kd.sink2 - m_run);
    const float inv = 1.0f / l_run;
    bf16_t* orow = W.o + (size_t)r32 * W.opitch;
#pragma unroll
    for (int g = 0; g < 4; ++g) {
        u32x2 a; a.x = pg8::cvt_pk_bf16(o0[4 * g] * inv, o0[4 * g + 1] * inv); a.y = pg8::cvt_pk_bf16(o0[4 * g + 2] * inv, o0[4 * g + 3] * inv);
        *(u32x2*)(orow + 8 * g + 4 * hi) = a;
        u32x2 b; b.x = pg8::cvt_pk_bf16(o1[4 * g] * inv, o1[4 * g + 1] * inv); b.y = pg8::cvt_pk_bf16(o1[4 * g + 2] * inv, o1[4 * g + 3] * inv);
        *(u32x2*)(orow + 32 + 8 * g + 4 * hi) = b;
    }
}

template <int C> __device__ __forceinline__ void qd_fmac(float& acc, float bsrc, float x) { asm("v_fmac_f32_dpp %0, %1, %2 quad_perm:[%c3,%c3,%c3,%c3] row_mask:0xf bank_mask:0xf" : "+v"(acc) : "v"(bsrc), "v"(x), "n"(C)); }
template <int C> __device__ __forceinline__ float qd_mul(float bsrc, float x) { float d; asm("v_mul_f32_dpp %0, %1, %2 quad_perm:[%c3,%c3,%c3,%c3] row_mask:0xf bank_mask:0xf" : "=v"(d) : "v"(bsrc), "v"(x), "n"(C)); return d; }
__device__ __forceinline__ float dpp_ror8(float x) { float d; asm("s_nop 1\n\tv_mov_b32_dpp %0, %1 row_ror:8 row_mask:0xf bank_mask:0xf" : "=v"(d) : "v"(x)); return d; }
template <int N> __device__ __forceinline__ float ror_add(float x) { float d; asm("s_nop 1\n\tv_add_f32_dpp %0, %1, %1 row_ror:%c2 row_mask:0xf bank_mask:0xf" : "=v"(d) : "v"(x), "n"(N)); return d; }
__device__ __forceinline__ float quads_sum(float x) { return swap32_sum(swap16_sum(ror_add<8>(ror_add<4>(x)))); }
__device__ __forceinline__ float row16_sum(float v) { v += dpp_f<0xB1>(v); v += dpp_f<0x4E>(v); return ror_add<8>(ror_add<4>(v)); }
constexpr int SC_TS = 32;
constexpr int SC_SCR = 0, SC_H = 16384, SC_HPLANE = 4096, SC_HSET = 24576, SC_Y = 65536, SC_YP = 72, SC_LW = 83968, SC_LA = 88064, SC_MU = 92160, SC_CST = 94720, SC_W2 = 96256, SC_A2 = 104448, SC_END = 112640;
static_assert(SC_END <= MISC_OFF, "scan LDS map");
typedef _Float16 sh2 __attribute__((ext_vector_type(2)));
typedef _Float16 sh8 __attribute__((ext_vector_type(8)));
__device__ __forceinline__ unsigned pkh2(float a, float b) { const sh2 v = {(_Float16)a, (_Float16)b}; return __builtin_bit_cast(unsigned, v); }
__device__ __forceinline__ u32x4 packh8(const float (&v)[8]) { return (u32x4){pkh2(v[0], v[1]), pkh2(v[2], v[3]), pkh2(v[4], v[5]), pkh2(v[6], v[7])}; }
__device__ __forceinline__ void scan_item(Ctx& F, int l, int bg, int h, int dir, bool emit_ctx) {
    const int tid = F.tid, lane = F.lane, w = F.wave;
    const bool prep = w >= 4; const int pw = w & 3;
    LAS unsigned char* cb = F.lds;
    LAS float* ybufb = (LAS float*)(cb + SC_Y);
    LAS bf16_t* w2s = (LAS bf16_t*)(cb + SC_W2); LAS bf16_t* a2s = (LAS bf16_t*)(cb + SC_A2); LAS float* cst = (LAS float*)(cb + SC_CST);
    LAS bf16_t* linw = (LAS bf16_t*)(cb + SC_LW); LAS bf16_t* lina = (LAS bf16_t*)(cb + SC_LA); LAS float* mus = (LAS float*)(cb + SC_MU);
    const bf16_t* Pr = (const bf16_t*)(F.ws + R_PR);
    bf16_t* OUT = dir ? (bf16_t*)(F.ws + R_OB) : (bf16_t*)(F.ws + WS_Y01) + 512; const int opitch = dir ? 512 : D;
    float* BON = (float*)(F.ws + WS_BON);
    auto slice_col = [&](int s_) -> int { return s_ == 0 ? h * 64 : s_ == 1 ? 512 + h * 64 : s_ == 2 ? 1024 + h * 64 : s_ == 3 ? 1536 + 64 * dir : 1664 + 64 * dir; };
    constexpr int NCH = LTOT / SC_TS;
    auto chunk_geo = [&](int ch, int& tlo, int& lrow0, int& slen) { const bool isctx = ch < CTX / SC_TS; const int cc = isctx ? ch : ch - CTX / SC_TS; slen = isctx ? CTX : SEQ;
        tlo = dir ? slen - SC_TS * (cc + 1) : SC_TS * cc; lrow0 = isctx ? MLAT + bg * CTX : bg * SEQ; };
    __syncthreads();
    for (int e = tid; e < 640; e += NTHREADS) { const int s_ = e >> 7, which = (e >> 6) & 1, c = e & 63; mus[e] = F.in[I_MU][((size_t)l * 2 + which) * 1920 + slice_col(s_) + c]; }
    if (tid < 320) { const int which = tid >> 6, c = tid & 63; const int ci = (l * 2 + dir) * 512 + h * 64 + c, cj = l * 512 + h * 64 + c;
        cst[tid] = which == 0 ? F.in[I_W0][ci] : which == 1 ? F.in[I_A0][ci] : which == 2 ? F.in[I_KK][cj] : which == 3 ? F.in[I_KA][cj] : F.in[I_RK][cj]; }
    { const u32x4* w2T = (const u32x4*)((const bf16_t*)(F.ws + WS_LORA) + ((size_t)((l * 2 + dir) * 8 + h) * 64) * 64); const u32x4* a2T = w2T + 2 * 2 * 8 * 4096 / 8;
      ((LAS u32x4*)w2s)[tid] = w2T[tid]; ((LAS u32x4*)a2s)[tid] = a2T[tid]; }
    __syncthreads();
    if (prep) {
        const int t8 = lane >> 3, cg = lane & 7, ptt = 8 * pw + t8;
        const int n16 = lane & 15, q16 = lane >> 4;
        u32x4 px[5], pp[5], pn[5];
        const int ptok = dir ? SC_TS - 1 - ptt : ptt;
        auto issue_loads = [&](int ch) { int tlo, lrow0, slen; chunk_geo(ch, tlo, lrow0, slen); const int t = tlo + ptok;
            const bf16_t* row = Pr + (size_t)(lrow0 + t) * 2048 + 8 * cg; const int dp = t > 0 ? 2048 : 0, dn = t < slen - 1 ? 2048 : 0;
#pragma unroll
            for (int s_ = 0; s_ < 5; ++s_) { const bf16_t* ptr = row + slice_col(s_); px[s_] = *(const u32x4*)ptr; pp[s_] = *(const u32x4*)(ptr - dp); pn[s_] = *(const u32x4*)(ptr + dn); } };
        auto prepare = [&](int ch) { int tlo, lrow0, slen; chunk_geo(ch, tlo, lrow0, slen); const int set = ch & 1;
            LAS float* fW = (LAS float*)(cb + SC_SCR); LAS float* fB = fW + 2048;
            LAS unsigned char* hK = cb + SC_H + set * SC_HSET;
            const int t = tlo + ptok; const float zp = t > 0 ? 1.f : 0.f, zn = t < slen - 1 ? 1.f : 0.f;
            float kv[8], rv[8];
#pragma unroll
            for (int s_ = 0; s_ < 5; ++s_) { float x[8], xp[8], xn[8], sh[8]; unpack8(px[s_], x); unpack8(pp[s_], xp); unpack8(pn[s_], xn);
                const LAS float* m0 = mus + (s_ * 2) * 64 + 8 * cg; const LAS float* m1 = m0 + 64;
#pragma unroll
                for (int j = 0; j < 8; ++j) sh[j] = x[j] + m0[j] * (xp[j] * zp - x[j]) + m1[j] * (xn[j] * zn - x[j]);
                if (s_ == 0) { *(LAS u32x4*)(hK + 4 * SC_HPLANE + (ptt * 64 + 8 * cg) * 2) = packh8(sh);
#pragma unroll
                    for (int j = 0; j < 8; ++j) rv[j] = sh[j]; }
                else if (s_ == 1) {
#pragma unroll
                    for (int j = 0; j < 8; ++j) kv[j] = sh[j]; }
                else if (s_ == 2) *(LAS u32x4*)(hK + 5 * SC_HPLANE + (ptt * 64 + 8 * cg) * 2) = packh8(sh);
                else if (s_ == 3) { float th[8];
#pragma unroll
                    for (int j = 0; j < 8; ++j) { const float ex = __expf(2.0f * sh[j]); th[j] = 1.0f - 2.0f * __builtin_amdgcn_rcpf(ex + 1.0f); }
                    *(LAS u32x4*)(linw + ptt * 64 + 8 * cg) = pack8(th); }
                else *(LAS u32x4*)(lina + ptt * 64 + 8 * cg) = pack8(sh); }
            asm volatile("" ::: "memory");
            if (ch + 1 < NCH) issue_loads(ch + 1);
            LDS_WAIT();
#pragma unroll
            for (int ct = 0; ct < 4; ++ct) { f32x4 cw_ = {0.f, 0.f, 0.f, 0.f}, ca_ = {0.f, 0.f, 0.f, 0.f};
#pragma unroll
                for (int ks = 0; ks < 2; ++ks) {
                    const bf16x8 aw = *(const LAS bf16x8*)(linw + (8 * pw + (n16 & 7)) * 64 + 32 * ks + 8 * q16);
                    const bf16x8 aa = *(const LAS bf16x8*)(lina + (8 * pw + (n16 & 7)) * 64 + 32 * ks + 8 * q16);
                    const bf16x8 bwf = *(const LAS bf16x8*)(w2s + (16 * ct + n16) * 64 + 32 * ks + 8 * q16), baf = *(const LAS bf16x8*)(a2s + (16 * ct + n16) * 64 + 32 * ks + 8 * q16);
                    cw_ = __builtin_amdgcn_mfma_f32_16x16x32_bf16(aw, bwf, cw_, 0, 0, 0);
                    ca_ = __builtin_amdgcn_mfma_f32_16x16x32_bf16(aa, baf, ca_, 0, 0, 0); }
                if (q16 < 2) { const float w0c = cst[16 * ct + n16], a0c = cst[64 + 16 * ct + n16];
#pragma unroll
                    for (int r = 0; r < 4; ++r) { const int o = (8 * pw + 4 * q16 + r) * 64 + 16 * ct + n16; fW[o] = cw_[r] + w0c; fB[o] = ca_[r] + a0c; } } }
            LDS_WAIT();
            { float kkr[8], av[8], wd[8], lw[8], la[8]; float ss = 0.f, bsum = 0.f; const int o = ptt * 64 + 8 * cg;
              { const f32x4 a = *(const LAS f32x4*)(fW + o), b = *(const LAS f32x4*)(fW + o + 4), c = *(const LAS f32x4*)(fB + o), d = *(const LAS f32x4*)(fB + o + 4);
#pragma unroll
                for (int j = 0; j < 4; ++j) { lw[j] = a[j]; lw[4 + j] = b[j]; la[j] = c[j]; la[4 + j] = d[j]; } }
#pragma unroll
              for (int j = 0; j < 8; ++j) { kkr[j] = kv[j] * cst[128 + 8 * cg + j]; ss += kkr[j] * kkr[j];
                  wd[j] = __expf(-0.6065306597126334f * __builtin_amdgcn_rcpf(1.0f + __expf(-lw[j]))); av[j] = __builtin_amdgcn_rcpf(1.0f + __expf(-la[j])); }
              ss = group8_sum(ss); const float inv = __builtin_amdgcn_rcpf(fmaxf(__builtin_amdgcn_sqrtf(ss), 1e-12f));
              float kk[8], kb[8], kd[8];
#pragma unroll
              for (int j = 0; j < 8; ++j) { kk[j] = kkr[j] * inv; kb[j] = kk[j] * av[j]; kd[j] = kv[j] * (1.0f + (av[j] - 1.0f) * cst[192 + 8 * cg + j]); bsum += rv[j] * kd[j] * cst[256 + 8 * cg + j]; }
              float ew[8];
#pragma unroll
              for (int j = 0; j < 8; ++j) ew[j] = 1.0f - wd[j];
              *(LAS u32x4*)(hK + o * 2) = packh8(kk); *(LAS u32x4*)(hK + SC_HPLANE + o * 2) = packh8(ew); *(LAS u32x4*)(hK + 2 * SC_HPLANE + o * 2) = packh8(kb); *(LAS u32x4*)(hK + 3 * SC_HPLANE + o * 2) = packh8(kd);
              bsum = group8_sum(bsum);
              if (cg == 0) BON[((size_t)(lrow0 + t) * 8 + h) * 2 + dir] = bsum; } };
        auto outp = [&](int ch) { int tlo, lrow0, slen; chunk_geo(ch, tlo, lrow0, slen); const bool isctx = ch < CTX / SC_TS; const LAS float* ybuf = ybufb + (ch & 1) * (32 * SC_YP);
            if (!isctx || emit_ctx) {
                const f32x4 ya = *(const LAS f32x4*)(ybuf + ptt * SC_YP + 8 * cg), yb = *(const LAS f32x4*)(ybuf + ptt * SC_YP + 8 * cg + 4);
                *(u32x4*)(OUT + (size_t)(lrow0 + tlo + ptok) * opitch + h * 64 + 8 * cg) = (u32x4){pk2(ya[0], ya[1]), pk2(ya[2], ya[3]), pk2(yb[0], yb[1]), pk2(yb[2], yb[3])}; } };
        issue_loads(0);
        for (int ch = -1; ch < NCH; ++ch) {
            if (ch > 0) outp(ch - 1);
            if (ch + 1 < NCH) prepare(ch + 1);
            LDS_BARRIER();
        }
        outp(NCH - 1);
    } else {
        sh2 Sa[4], Sb[4];
#pragma unroll
        for (int c = 0; c < 4; ++c) { Sa[c] = (sh2){(_Float16)0.f, (_Float16)0.f}; Sb[c] = Sa[c]; }
        const int g = lane & 7, ra = 16 * pw + (lane >> 3);
        LDS_BARRIER();
        for (int ch = 0; ch < NCH; ++ch) {
            const int set = ch & 1; const LAS sh8* fH = (const LAS sh8*)(cb + SC_H + set * SC_HSET) + g; const LAS _Float16* vbuf = (const LAS _Float16*)(cb + SC_H + set * SC_HSET + 5 * SC_HPLANE) + ra;
            LAS float* ybuf = ybufb + set * (32 * SC_YP) + g * SC_YP + ra;
            asm volatile("" : "+v"(fH), "+v"(vbuf), "+v"(ybuf));
            float yk_a = 0.f, yk_b = 0.f;
#define SC_LOAD(T, K_, E_, B_, D_, R_, VA, VB) do { const LAS sh8* q_ = fH + (T) * 8; K_ = q_[0]; E_ = q_[256]; B_ = q_[512]; D_ = q_[768]; R_ = q_[1024]; VA = vbuf[(T) * 64]; VB = vbuf[(T) * 64 + 8]; } while (0)
            sh8 k4, e4, b4, d4, r4; _Float16 va, vb;
            SC_LOAD(0, k4, e4, b4, d4, r4, va, vb);
#pragma unroll 8
            for (int st = 0; st < SC_TS; ++st) {
                const int tn = (st + 1 < SC_TS) ? st + 1 : st;
                sh8 k4n, e4n, b4n, d4n, r4n; _Float16 van, vbn;
                SC_LOAD(tn, k4n, e4n, b4n, d4n, r4n, van, vbn);
                float sa_ = 0.f, sb_ = 0.f;
#pragma unroll
                for (int c = 0; c < 4; ++c) { const sh2 kc = {k4[2 * c], k4[2 * c + 1]}; sa_ = __builtin_amdgcn_fdot2(Sa[c], kc, sa_, false); sb_ = __builtin_amdgcn_fdot2(Sb[c], kc, sb_, false); }
                const sh2 va2 = {va, va}, vb2 = {vb, vb};
#pragma unroll
                for (int c = 0; c < 4; ++c) { const sh2 ec = {e4[2 * c], e4[2 * c + 1]}, dc = {d4[2 * c], d4[2 * c + 1]};
                    Sa[c] = Sa[c] - Sa[c] * ec; Sb[c] = Sb[c] - Sb[c] * ec; Sa[c] = dc * va2 + Sa[c]; Sb[c] = dc * vb2 + Sb[c]; }
                const float nsa = -group8_sum(sa_), nsb = -group8_sum(sb_);
                const sh2 na2 = {(_Float16)nsa, (_Float16)nsa}, nb2 = {(_Float16)nsb, (_Float16)nsb};
#pragma unroll
                for (int c = 0; c < 4; ++c) { const sh2 bc = {b4[2 * c], b4[2 * c + 1]}; Sa[c] = bc * na2 + Sa[c]; Sb[c] = bc * nb2 + Sb[c]; }
                float ya_ = 0.f, yb_ = 0.f;
#pragma unroll
                for (int c = 0; c < 4; ++c) { const sh2 rc = {r4[2 * c], r4[2 * c + 1]}; ya_ = __builtin_amdgcn_fdot2(Sa[c], rc, ya_, false); yb_ = __builtin_amdgcn_fdot2(Sb[c], rc, yb_, false); }
                const float y_a = group8_sum(ya_), y_b = group8_sum(yb_);
                yk_a = g == (st & 7) ? y_a : yk_a; yk_b = g == (st & 7) ? y_b : yk_b;
                if ((st & 7) == 7) { ybuf[(st - 7) * SC_YP] = yk_a; ybuf[(st - 7) * SC_YP + 8] = yk_b; }
                k4 = k4n; e4 = e4n; b4 = b4n; d4 = d4n; r4 = r4n; va = van; vb = vbn;
            }
#undef SC_LOAD
            LDS_BARRIER();
        }
    }
    __syncthreads();
}

__device__ __forceinline__ void phaseC(Ctx& F0, int l, int hb, int rep = 0) {
    Ctx F = F0;
    volatile LAS unsigned* MISC = (volatile LAS unsigned*)(F.lds + MISC_OFF);
    unsigned* head = (unsigned*)(F.ws + WS_CTL) + CW_QUEUE + 64 * ((l * NHALF + hb) * 4 + rep);
    const bool do_ctx = (l < DEPTH - 1);
    const int N_SCAN = hb == 0 ? BATCH * 8 * 2 : 0;
    constexpr int N_MLA = NB * 8 * 16, N_GQA = NB * 2 * 64, N_WIN = NB * 2 * 64, N_CX = NB * 8 + NB * 2 * 4 + NB * 2 * 4;
    const int total = N_SCAN + N_MLA + N_GQA + N_WIN + (do_ctx ? N_CX : 0);
    const int wave = F.wave;
    for (;;) {
        __syncthreads();
        if (F.tid == 0) MISC[16] = __hip_atomic_fetch_add(head, 1u, __ATOMIC_RELAXED, __HIP_MEMORY_SCOPE_AGENT);
        __syncthreads();
        int it = (int)MISC[16];
        if (it >= total) break;
        { OPAQUE_ZERO(zq); int ln; asm volatile("v_mbcnt_lo_u32_b32 %0, -1, 0\n\tv_mbcnt_hi_u32_b32 %0, -1, %0" : "=v"(ln));
          F.ws = F0.ws + zq; F.in = F0.in + zq; F.lane = ln; F.tid = F0.wave * 64 + ln; }
        bf16_t* Y01 = (bf16_t*)(F.ws + WS_Y01); bf16_t* Y23 = (bf16_t*)(F.ws + WS_Y23);
        if (it < N_SCAN) { if (rep != 1) scan_item(F, l, it >> 4, (it >> 1) & 7, it & 1, do_ctx); continue; } it -= N_SCAN;
        bool mla, win = false, cx = false; int bl, hh, qb;
        if (it < N_MLA) { mla = true; bl = it >> 7; hh = (it >> 4) & 7; qb = it & 15; }
        else if ((it -= N_MLA) < N_GQA + N_WIN) { mla = false; win = it >= N_GQA; if (win) it -= N_GQA; bl = it >> 7; hh = (it >> 6) & 1; qb = it & 63; }
        else if ((it -= N_GQA + N_WIN) < NB * 8) { mla = true; cx = true; bl = it >> 3; hh = it & 7; qb = 0; }
        else { it -= NB * 8; mla = false; cx = true; win = it >= NB * 8; if (win) it -= NB * 8; bl = it >> 3; hh = (it >> 2) & 1; qb = it & 3; }
        if (mla) { const int h = hh, t0 = qb * 256 + wave * 32; const int lr = cx ? MLL + bl * 256 + wave * 32 : bl * 4096 + t0;
            AttnWave W{(const bf16_t*)(F.ws + R_QA) + (size_t)lr * 768 + h * 96, 768, Y01 + (size_t)grow_of(hb, lr) * D + h * 64, D, 0, cx ? nullptr : (const float*)(F.ws + WS_ROPE) + (size_t)t0 * 16};
            AttnKeys K{(const bf16_t*)(F.ws + R_KA) + h * 96, 768, (const bf16_t*)(F.ws + R_VAT) + (size_t)(bl * 8 + h) * 64 * LTOT, 0, cx ? 0 : 64, 4, bl, 0, 0, 0.f};
            attn_unit<96>(F, W, K); }
        else { const int kvh = hh, hq = 4 * kvh + (wave >> 1); const int t0 = qb * 64 + (wave & 1) * 32, lr = cx ? MLL + bl * 256 + t0 : bl * 4096 + t0;
            AttnWave W{(const bf16_t*)(F.ws + (win ? R_QD : R_QC)) + (size_t)lr * 512 + hq * 64, 512, Y23 + (size_t)grow_of(hb, lr) * D + (win ? 512 : 0) + hq * 64, D, t0, nullptr};
            AttnKeys K{(const bf16_t*)(F.ws + (win ? R_KD : R_KC)) + kvh * 64, 128, (const bf16_t*)(F.ws + (win ? R_VDT : R_VCT)) + (size_t)(bl * 2 + kvh) * 64 * LTOT, 0, cx ? 0 : 64, 4, bl, 0, win ? 1 : 0, win ? F.in[I_SINK][l * 8 + hq] * LOG2E : 0.f};
            if (win && !cx) { int p0 = qb * 64 - 128, n = 5; if (p0 < 0) { n -= (-p0) / 64; p0 = 0; } if (p0 + 64 * n > SEQ) n = (SEQ - p0) / 64; K.lat_p0 = p0; K.lat_n = n; K.wmask = 1; }
            attn_unit_p64(F, W, K); }
    }
}

__device__ __forceinline__ void phaseD(Ctx& F, int l) {
    const bool do_ctx = (l < DEPTH - 1); const int nrows = do_ctx ? MROWS : MLAT;
    LAS bf16_t* sgb = (LAS bf16_t*)F.lds;
    LAS float* vs = (LAS float*)(F.lds + 4096);
    LAS float* on = vs + 16 * 512;
    LAS float* bn = on + 16 * 512;
    const bf16_t* Pr = (const bf16_t*)(F.ws + R_PR); const bf16_t* OF = (const bf16_t*)(F.ws + WS_Y01) + 512; const bf16_t* OB = (const bf16_t*)(F.ws + R_OB);
    const float* BON = (const float*)(F.ws + WS_BON); bf16_t* Y01 = (bf16_t*)(F.ws + WS_Y01);
    const float* mu0 = F.in[I_MU] + (size_t)l * 2 * 1920, * mu1 = mu0 + 1920;
    const int lane = F.lane, w = F.wave, n16 = lane & 15, kg = lane >> 4;
    bf16x8 bf[4][4];
    { const bf16_t* g2T = (const bf16_t*)(F.ws + WS_LORA) + 2 * (2 * 2 * 8 * 4096) + (size_t)l * 512 * 128;
#pragma unroll
      for (int ct = 0; ct < 4; ++ct)
#pragma unroll
          for (int ks = 0; ks < 4; ++ks) bf[ct][ks] = *(const bf16x8*)(g2T + (size_t)(64 * w + 16 * ct + n16) * 128 + 32 * ks + 8 * kg); }
    float lg[4], lb[4];
#pragma unroll
    for (int ct = 0; ct < 4; ++ct) { lg[ct] = F.in[I_LNG][l * 512 + 64 * w + 16 * ct + n16]; lb[ct] = F.in[I_LNB][l * 512 + 64 * w + 16 * ct + n16]; }
    for (int r0 = F.bid * 16; r0 < nrows; r0 += F.G * 16) {
        __syncthreads();
#pragma unroll
        for (int rr = 0; rr < 2; ++rr) { const int li = 2 * w + rr, lr = r0 + li; const bool lat = lr < MLAT; const int t = lat ? (lr & 4095) : ((lr - MLAT) & 255), slen = lat ? SEQ : CTX;
          const bf16_t* p = Pr + (size_t)lr * 2048;
          auto shifted = [&](int col, float (&sh)[8]) { float x[8], xp[8], xn[8]; unpack8(*(const u32x4*)(p + col), x);
              unpack8(*(const u32x4*)(p + col - (t > 0 ? 2048 : 0)), xp); unpack8(*(const u32x4*)(p + col + (t < slen - 1 ? 2048 : 0)), xn);
              const float zp = t > 0 ? 1.f : 0.f, zn = t < slen - 1 ? 1.f : 0.f;
#pragma unroll
              for (int j = 0; j < 8; ++j) sh[j] = x[j] + mu0[col + j] * (xp[j] * zp - x[j]) + mu1[col + j] * (xn[j] * zn - x[j]); };
          float sh[8];
          shifted(1024 + lane * 8, sh);
          *(LAS f32x4*)(vs + li * 512 + lane * 8) = (f32x4){sh[0], sh[1], sh[2], sh[3]}; *(LAS f32x4*)(vs + li * 512 + lane * 8 + 4) = (f32x4){sh[4], sh[5], sh[6], sh[7]};
          if (lane < 16) { shifted(1792 + lane * 8, sh);
#pragma unroll
              for (int j = 0; j < 8; ++j) sh[j] = sigmoidf_(sh[j]);
              *(LAS u32x4*)(sgb + li * 128 + lane * 8) = pack8(sh); }
          float a[8], b[8]; unpack8(*(const u32x4*)(OF + (size_t)lr * D + lane * 8), a); unpack8(*(const u32x4*)(OB + (size_t)lr * 512 + lane * 8), b);
          float s_ = 0.f;
#pragma unroll
          for (int j = 0; j < 8; ++j) { a[j] += b[j]; s_ += a[j]; }
          const float mean = group8_sum(s_) * (1.f / 64.f); float q = 0.f;
#pragma unroll
          for (int j = 0; j < 8; ++j) { a[j] -= mean; q += a[j] * a[j]; }
          const float rstd = __builtin_amdgcn_rsqf(group8_sum(q) * (1.f / 64.f) + GN_EPS);
          *(LAS f32x4*)(on + li * 512 + lane * 8) = (f32x4){a[0] * rstd, a[1] * rstd, a[2] * rstd, a[3] * rstd}; *(LAS f32x4*)(on + li * 512 + lane * 8 + 4) = (f32x4){a[4] * rstd, a[5] * rstd, a[6] * rstd, a[7] * rstd};
          if (lane < 8) { const size_t gi = ((size_t)lr * 8 + lane) * 2; bn[li * 8 + lane] = BON[gi] + BON[gi + 1]; } }
        __syncthreads();
        f32x4 acc[4];
#pragma unroll
        for (int ct = 0; ct < 4; ++ct) acc[ct] = (f32x4){0.f, 0.f, 0.f, 0.f};
#pragma unroll
        for (int ks = 0; ks < 4; ++ks) { const bf16x8 af = *(const LAS bf16x8*)(sgb + n16 * 128 + 32 * ks + 8 * kg);
#pragma unroll
            for (int ct = 0; ct < 4; ++ct) acc[ct] = __builtin_amdgcn_mfma_f32_16x16x32_bf16(af, bf[ct][ks], acc[ct], 0, 0, 0); }
#pragma unroll
        for (int ct = 0; ct < 4; ++ct) { const int n = 64 * w + 16 * ct + n16;
#pragma unroll
            for (int r = 0; r < 4; ++r) { const int li = 4 * kg + r;
                const float y = (on[li * 512 + n] * lg[ct] + lb[ct] + bn[li * 8 + w] * vs[li * 512 + n]) * acc[ct][r];
                Y01[(size_t)(r0 + li) * D + 512 + n] = (bf16_t)f2bf(y); } }
    }
    __syncthreads();
}

constexpr size_t R_ACC = WS_R + 100 * MiB;
constexpr size_t R_CTXP = WS_R + 170 * MiB;
struct SchedE {
    pg8::TileOrder T; unsigned char* ws; int ctxjobs, c;
    __device__ __forceinline__ bool next(int i, pg8::Unit& u) const { int tm, tn, sub, br; bool cj = false;
        if (T.tile(i >> 3, tm, tn)) { sub = i & 7; br = sub >> 1; }
        else { if (!ctxjobs || i < 16 || i > 17 || c >= 128) return false; const int tile = c >> 2; br = c & 3; tm = MLAT / 256 + (tile >> 2); tn = tile & 3; sub = 2 * br + (i & 1); cj = true; }
        u.pm = tm; u.pn = tn; u.kind = sub | (cj ? 8 : 0);
        if (!(sub & 1)) { u.a = (const char*)(ws + WS_XMOD) + (size_t)tm * 256 * D * 2; u.b = (const char*)(ws + WS_WIN) + (size_t)(4096 + br * 1024 + tn * 256) * D * 2; u.nt = 16; }
        else { u.a = (const char*)(ws + (br < 2 ? WS_Y01 : WS_Y23)) + (size_t)tm * 256 * D * 2 + (br & 1) * 512 * 2;
               u.b = (const char*)(ws + WS_WBR) + (size_t)(br >> 1) * D * D * 2 + (size_t)tn * 256 * D * 2 + (br & 1) * 512 * 2; u.nt = 8; }
        return true; }
};
__device__ __forceinline__ float sig255(float x) { return __builtin_amdgcn_rcpf(__builtin_fmaf(__expf(-x), 1.0f / 255.0f, 1.0f / 255.0f)); }
struct EpiMerge {
    unsigned char* ws; int bid; int tid0;
    __device__ __forceinline__ void operator()(const f32x4 (&acc)[2][2][4][2], const pg8::Unit& u, int wr, int wc, int fr, int fq) const {
        OPAQUE_ZERO(z0); unsigned char* ws = this->ws + z0;
        int tid = tid0; asm volatile("" : "+v"(tid));
        u32x4* sp = (u32x4*)(ws + R_ESCR + (size_t)bid * ESCR_PER_BLOCK) + tid; u32x4* pp = (u32x4*)(ws + R_ESCR + (size_t)bid * ESCR_PER_BLOCK + 131072) + tid;
        if (!(u.kind & 1)) {
#pragma unroll
            for (int ai = 0; ai < 2; ++ai)
#pragma unroll
                for (int m = 0; m < 4; ++m) { u32x4 w;
#pragma unroll
                    for (int bj = 0; bj < 2; ++bj) { const f32x4 v0 = acc[ai][bj][m][0], v1 = acc[ai][bj][m][1]; unsigned a_ = 0u, b_ = 0u;
#pragma unroll
                        for (int j = 0; j < 4; ++j) { a_ = __builtin_amdgcn_cvt_pk_u8_f32(sig255(v0[j]), j, a_); b_ = __builtin_amdgcn_cvt_pk_u8_f32(sig255(v1[j]), j, b_); }
                        w[2 * bj] = a_; w[2 * bj + 1] = b_; }
                    *sp = w; sp += 512; asm volatile("" : "+v"(sp) :: "memory"); }
        } else {
            const int br = (u.kind & 7) >> 1; const bool cj = (u.kind & 8) != 0;
            float* cp = (float*)(ws + R_CTXP) + ((size_t)br * MCTX + (u.pm * 256 - MLAT) + wr * 64 + fr) * D + u.pn * 256 + wc * 32 + 8 * fq;
            bf16_t* op = (bf16_t*)(ws + R_ACC) + (size_t)(u.pm * 256 + wr * 64 + fr) * D + u.pn * 256 + wc * 32 + 8 * fq;
#pragma unroll
            for (int ai = 0; ai < 2; ++ai)
#pragma unroll
                for (int m = 0; m < 4; ++m) { const u32x4 gs = *sp;
#pragma unroll
                    for (int bj = 0; bj < 2; ++bj) { const unsigned ga = gs[2 * bj], gb = gs[2 * bj + 1];
                        f32x4 v0 = acc[ai][bj][m][0], v1 = acc[ai][bj][m][1];
#pragma unroll
                        for (int j = 0; j < 4; ++j) { v0[j] *= (float)((ga >> (8 * j)) & 0xffu); v1[j] *= (float)((gb >> (8 * j)) & 0xffu); }
                        if (cj) { float* q = cp + (size_t)(ai * 128 + m * 16) * D + bj * 128; *(f32x4*)q = v0 * (1.0f / 255.0f); *(f32x4*)(q + 4) = v1 * (1.0f / 255.0f); }
                        else if (br > 0) { float q_[8]; unpack8(*pp, q_); v0 += (f32x4){q_[0], q_[1], q_[2], q_[3]}; v1 += (f32x4){q_[4], q_[5], q_[6], q_[7]}; }
                        if (cj) {}
                        else if (br < 3) { u32x4 w; w.x = pg8::cvt_pk_bf16(v0[0], v0[1]); w.y = pg8::cvt_pk_bf16(v0[2], v0[3]); w.z = pg8::cvt_pk_bf16(v1[0], v1[1]); w.w = pg8::cvt_pk_bf16(v1[2], v1[3]); *pp = w; }
                        else { v0 = v0 * (1.0f / 255.0f); v1 = v1 * (1.0f / 255.0f);
                            u32x4 w; w.x = pg8::cvt_pk_bf16(v0[0], v0[1]); w.y = pg8::cvt_pk_bf16(v0[2], v0[3]); w.z = pg8::cvt_pk_bf16(v1[0], v1[1]); w.w = pg8::cvt_pk_bf16(v1[2], v1[3]);
                            *(u32x4*)(op + (size_t)(ai * 128 + m * 16) * D + bj * 128) = w; }
                        pp += 512; asm volatile("" : "+v"(pp) :: "memory"); }
                    sp += 512; asm volatile("" : "+v"(sp) :: "memory"); }
        }
    }
};
__device__ __forceinline__ void phaseE(Ctx& F, int l) {
    SchedE S; S.T.init(MLAT / 256, 4, F.G, F.bid); S.ws = F.ws; S.ctxjobs = (l < DEPTH - 1) ? 1 : 0; S.c = F.bid;
    EpiMerge E{F.ws, F.bid, F.tid};
    pg8::gemm_phase<EpiMerge, SchedE>(F.lds, F.wave, D, D, S, E);
}
__device__ __forceinline__ void phaseE2(Ctx& F) {
    const int gt = F.bid * NTHREADS + F.tid, NGT = F.G * NTHREADS;
    const float* cp = (const float*)(F.ws + R_CTXP); bf16_t* acc = (bf16_t*)(F.ws + R_ACC) + (size_t)MLAT * D;
    for (int e = gt; e < MCTX * D / 8; e += NGT) { float v[8];
#pragma unroll
        for (int j = 0; j < 8; ++j) v[j] = 0.f;
#pragma unroll
        for (int br = 0; br < 4; ++br) { const f32x4 a = *(const f32x4*)(cp + (size_t)br * MCTX * D + (size_t)e * 8), b = *(const f32x4*)(cp + (size_t)br * MCTX * D + (size_t)e * 8 + 4);
#pragma unroll
            for (int j = 0; j < 4; ++j) { v[j] += a[j]; v[4 + j] += b[j]; } }
        *(u32x4*)(acc + (size_t)e * 8) = pack8(v); }
}

__device__ __forceinline__ float* stream_row(const Ctx& F, int grow) { return grow < MLAT ? F.out + (size_t)grow * D : (float*)(F.ws + WS_XSC) + (size_t)(grow - MLAT) * D; }
struct SchedF {
    pg8::TileOrder T; const char* A; const char* B; int nt;
    __device__ __forceinline__ bool next(int i, pg8::Unit& u) const { int tm, tn; if (!T.tile(i, tm, tn)) return false;
        u.a = A + (size_t)tm * 256 * D * 2; u.b = B + (size_t)tn * 256 * D * 2; u.nt = nt; u.pm = tm; u.pn = tn; u.kind = 0; return true; }
};
struct EpiOut {
    Ctx F; int l;
    __device__ __forceinline__ void operator()(const f32x4 (&acc)[2][2][4][2], const pg8::Unit& u, int wr, int wc, int fr, int fq) const {
        int row = u.pm * 256 + wr * 64 + fr; const int c0 = u.pn * 256 + wc * 32 + 8 * fq;
#pragma unroll
        for (int ai = 0; ai < 2; ++ai) {
#pragma unroll
            for (int m = 0; m < 4; ++m) { float* so = stream_row(F, row) + c0;
                const float* xi = (l == 0) ? (row < MLAT ? F.in[I_X] + (size_t)row * D : F.in[I_CTX] + (size_t)(row - MLAT) * D) + c0 : so;
                const float* gt = mod_ptr(F, l, mod_slot(row)) + 2048 + c0;
#pragma unroll
                for (int bj = 0; bj < 2; ++bj)
#pragma unroll
                    for (int n = 0; n < 2; ++n) { const int c = bj * 128 + 4 * n;
                        const f32x4 x = *(const f32x4*)(xi + c), g = *(const f32x4*)(gt + c);
                        *(f32x4*)(so + c) = x * ALPHA + g * acc[ai][bj][m][n]; }
                row += 16; asm volatile("" : "+v"(row) :: "memory"); }
            row += 64; }
    }
};
__device__ __forceinline__ void phaseF(Ctx& F, int l) {
    SchedF S; S.T.init((l < DEPTH - 1 ? MROWS : MLAT) / 256, 4, F.G, F.bid); S.A = (const char*)(F.ws + R_ACC); S.B = (const char*)(F.ws + WS_WOUT); S.nt = 16;
    EpiOut E{F, l};
    pg8::gemm_phase<EpiOut, SchedF>(F.lds, F.wave, D, D, S, E);
}
__device__ __forceinline__ void ln_row(f32x4 (&v)[4], const float* g, const float* b, int lane) {
    float s = 0.f;
#pragma unroll
    for (int j = 0; j < 4; ++j) s += (v[j].x + v[j].y) + (v[j].z + v[j].w);
    const float mean = wave_sum(s) * (1.f / D); float s2 = 0.f;
#pragma unroll
    for (int j = 0; j < 4; ++j) { v[j] = v[j] - mean; s2 += (v[j].x * v[j].x + v[j].y * v[j].y) + (v[j].z * v[j].z + v[j].w * v[j].w); }
    const float rstd = __builtin_amdgcn_rsqf(wave_sum(s2) * (1.f / D) + LN_EPS);
#pragma unroll
    for (int j = 0; j < 4; ++j) { const int c = j * 256 + lane * 4; v[j] = v[j] * rstd * *(const f32x4*)(g + c) + *(const f32x4*)(b + c); }
}
__device__ __forceinline__ void phaseF2(Ctx& F, int l) {
    const int gw = F.bid * NWAVES + F.wave, NGW = F.G * NWAVES; const int nrows = l < DEPTH - 1 ? MROWS : MLAT;
    bf16_t* hmod = (bf16_t*)(F.ws + WS_XMOD);
    for (int r = gw; r < nrows; r += NGW) {
        float* so = stream_row(F, r); const float* md = mod_ptr(F, l, mod_slot(r));
        f32x4 v[4];
#pragma unroll
        for (int j = 0; j < 4; ++j) v[j] = *(const f32x4*)(so + j * 256 + F.lane * 4);
        ln_row(v, F.in[I_LN1G] + l * D, F.in[I_LN1B] + l * D, F.lane);
#pragma unroll
        for (int j = 0; j < 4; ++j) { const int c = j * 256 + F.lane * 4; *(f32x4*)(so + c) = v[j];
            const f32x4 sh = *(const f32x4*)(md + 3072 + c), sc = *(const f32x4*)(md + 4096 + c);
            u32x2 o; o.x = pk2(v[j].x * (1.f + sc.x) + sh.x, v[j].y * (1.f + sc.y) + sh.y); o.y = pk2(v[j].z * (1.f + sc.z) + sh.z, v[j].w * (1.f + sc.w) + sh.w);
            *(u32x2*)(hmod + (size_t)r * D + c) = o; }
    }
}

struct EpiScores {
    float* SC;
    __device__ __forceinline__ void operator()(const f32x4 (&acc)[2][2][4][2], const pg8::Unit& u, int wr, int wc, int fr, int fq) const {
        OPAQUE_ZERO(z0); float* sp = SC + z0 + (size_t)(u.pm * 256 + wr * 64 + fr) * 2048 + u.pn * 256 + wc * 32 + 8 * fq;
#pragma unroll
        for (int ai = 0; ai < 2; ++ai) {
#pragma unroll
            for (int m = 0; m < 4; ++m) {
#pragma unroll
                for (int bj = 0; bj < 2; ++bj)
#pragma unroll
                    for (int n = 0; n < 2; ++n) *(f32x4*)(sp + bj * 128 + 4 * n) = acc[ai][bj][m][n];
                sp += 16 * 2048; asm volatile("" : "+v"(sp) :: "memory"); }
            sp += 64 * 2048; }
    }
};
__device__ __forceinline__ void phaseG(Ctx& F, int l) {
    SchedF S; S.T.init((l < DEPTH - 1 ? MROWS : MLAT) / 256, 8, F.G, F.bid); S.A = (const char*)(F.ws + WS_XMOD); S.B = (const char*)(F.ws + WS_WPK); S.nt = 16;
    EpiScores E{(float*)(F.ws + WS_SC)};
    pg8::gemm_phase<EpiScores, SchedF>(F.lds, F.wave, D, D, S, E);
}

__device__ __forceinline__ unsigned fkey(float f) { const unsigned u = __float_as_uint(f); return (u & 0x80000000u) ? ~u : (u | 0x80000000u); }
__device__ __forceinline__ float kval(unsigned k) { const unsigned u = (k & 0x80000000u) ? (k & 0x7fffffffu) : ~k; return __uint_as_float(u); }
__device__ __forceinline__ void ce_desc(unsigned& a, unsigned& b) { const unsigned hi_ = a > b ? a : b, lo_ = a > b ? b : a; a = hi_; b = lo_; }
__device__ __forceinline__ void bitonic_merge16(unsigned (&a)[16]) {
#pragma unroll
    for (int j = 8; j > 0; j >>= 1) {
#pragma unroll
        for (int i = 0; i < 16; ++i) { const int l_ = i ^ j; if (l_ > i) ce_desc(a[i], a[l_]); } }
}
__device__ __forceinline__ void sort16_desc(unsigned (&a)[16]) {
#pragma unroll
    for (int k = 2; k <= 16; k <<= 1) {
#pragma unroll
        for (int j = k >> 1; j > 0; j >>= 1) {
#pragma unroll
            for (int i = 0; i < 16; ++i) { const int l_ = i ^ j; if (l_ > i) { if ((i & k) == 0) ce_desc(a[i], a[l_]); else ce_desc(a[l_], a[i]); } } } }
}
constexpr int ST_I[50] = {0,0,0,0,0,0,0,0,0,0,0,0,0,0,0,0, 1,1,1,1,1,1,1,1, 2,2,2,2,2, 3,3,3,3, 4,4,4, 5,5, 6,6, 7,7, 8, 9, 10, 11, 12, 13, 14, 15};
constexpr int ST_J[50] = {0,1,2,3,4,5,6,7,8,9,10,11,12,13,14,15, 0,1,2,3,4,5,6,7, 0,1,2,3,4, 0,1,2,3, 0,1,2, 0,1, 0,1, 0,1, 0, 0, 0, 0, 0, 0, 0, 0};
__device__ __forceinline__ unsigned fp6_code(float x) {
    const float a = fminf(fabsf(x), 7.5f);
    int e = (int)((__float_as_uint(a) >> 23) & 0xffu) - 127; e = e < 0 ? 0 : e;
    const unsigned q = (unsigned)(int)__builtin_rintf(__builtin_ldexpf(a, 3 - e));
    return (q + ((unsigned)e << 3)) | ((__float_as_uint(x) >> 26) & 32u);
}
__device__ __forceinline__ void phaseH(Ctx& F, int l) {
    const int gt = F.bid * NTHREADS + F.tid, NGT = F.G * NTHREADS; const int nrows = l < DEPTH - 1 ? MROWS : MLAT;
    { const float* pu = F.in[I_PU] + (size_t)l * 16384 * 1024; const float* pv = F.in[I_PV] + (size_t)l * 16384 * 1024; unsigned char* tu = F.ws + WS_TU;
      for (int task = gt; task < 16384 * 64; task += NGT) { const int c8 = task & 7, sl = (task >> 3) & 3, part = (task >> 5) & 1, e = task >> 6;
          const float* s = (part ? pv : pu) + (size_t)e * 1024 + 256 * sl + 4 * c8; const float sc = part ? PEER_SV : PEER_SU;
          unsigned dw[6];
#pragma unroll
          for (int hf = 0; hf < 2; ++hf) { unsigned c[16];
#pragma unroll
              for (int j = 0; j < 4; ++j) { const f32x4 a = *(const f32x4*)(s + 32 * (4 * hf + j)) * sc;
#pragma unroll
                  for (int k = 0; k < 4; ++k) c[4 * j + k] = fp6_code(a[k]); }
              dw[3 * hf] = c[0] | (c[1] << 6) | (c[2] << 12) | (c[3] << 18) | (c[4] << 24) | (c[5] << 30);
              dw[3 * hf + 1] = (c[5] >> 2) | (c[6] << 4) | (c[7] << 10) | (c[8] << 16) | (c[9] << 22) | (c[10] << 28);
              dw[3 * hf + 2] = (c[10] >> 4) | (c[11] << 2) | (c[12] << 8) | (c[13] << 14) | (c[14] << 20) | (c[15] << 26); }
          unsigned char* row = tu + (size_t)part * PEER_TBL + (size_t)sl * PEER_SLICE + (size_t)e * 192;
          *(u32x4*)(row + c8 * 16) = (u32x4){dw[0], dw[1], dw[2], dw[3]};
          *(u32x2*)(row + 128 + c8 * 8) = (u32x2){dw[4], dw[5]}; } }
    const float* SC = (const float*)(F.ws + WS_SC); int* IDX = (int*)(F.ws + WS_IDX); float* WGT = (float*)(F.ws + WS_WGT);
    LAS float* stg = (LAS float*)(F.lds + 65536);
    const int tid = F.tid;
    __syncthreads();
    for (int base = F.bid * NTHREADS; base < nrows * 16; base += NGT) {
        const int task = base + tid, row = task >> 4, g = task & 15;
        const float* src = SC + (size_t)base * 128;
        f32x4 pre[4];
#pragma unroll
        for (int i = 0; i < 4; ++i) { const int idx = i * 512 + tid; pre[i] = *(const f32x4*)(src + (size_t)(idx >> 2) * 128 + (idx & 3) * 4); }
        unsigned t[16];
#pragma unroll
        for (int ps = 0; ps < 8; ++ps) {
            LAS float* sb = stg + (ps & 1) * (512 * 17);
#pragma unroll
            for (int i = 0; i < 4; ++i) { const int idx = i * 512 + tid; LAS float* d = sb + (idx >> 2) * 17 + (idx & 3) * 4; d[0] = pre[i][0]; d[1] = pre[i][1]; d[2] = pre[i][2]; d[3] = pre[i][3]; }
            if (ps + 1 < 8) {
#pragma unroll
                for (int i = 0; i < 4; ++i) { const int idx = i * 512 + tid; pre[i] = *(const f32x4*)(src + (size_t)(idx >> 2) * 128 + (ps + 1) * 16 + (idx & 3) * 4); } }
            LDS_BARRIER();
            unsigned b[16];
#pragma unroll
            for (int k = 0; k < 16; ++k) b[k] = (fkey(sb[tid * 17 + k]) & ~127u) | (unsigned)(127 - (ps * 16 + k));
            sort16_desc(b);
            if (ps == 0) {
#pragma unroll
                for (int k = 0; k < 16; ++k) t[k] = b[k]; }
            else {
#pragma unroll
                for (int k = 0; k < 16; ++k) t[k] = t[k] > b[15 - k] ? t[k] : b[15 - k];
                bitonic_merge16(t); }
        }
        unsigned o[16];
#pragma unroll
        for (int i = 0; i < 16; ++i) o[i] = dpp_u<0xB1>(t[i]);
        const bool odd = g & 1; const unsigned omask = odd ? 0xffffffffu : 0u;
        float v1[16], v2[16];
        LAS int* L1 = (LAS int*)F.lds + F.tid; LAS int* L2 = L1 + 16 * 512;
#pragma unroll
        for (int i = 0; i < 16; ++i) { const unsigned dx = (t[i] ^ o[i]) & omask; const unsigned a = t[i] ^ dx, b = o[i] ^ dx;
            v1[i] = kval(a & ~127u); v2[i] = kval(b & ~127u); L1[i * 512] = 127 - (int)(a & 127u); L2[i * 512] = 127 - (int)(b & 127u); }
        unsigned bk[16];
#define STAIR_KEY(N) ((fkey(v1[ST_I[N]] + v2[ST_J[N]]) & ~255u) | (unsigned)(ST_I[N] * 16 + ST_J[N]))
#pragma unroll
        for (int k = 0; k < 16; ++k) bk[k] = STAIR_KEY(k);
        sort16_desc(bk);
#pragma unroll
        for (int blk = 1; blk < 3; ++blk) { unsigned b[16];
#pragma unroll
            for (int k = 0; k < 16; ++k) b[k] = STAIR_KEY(16 * blk + k);
            sort16_desc(b);
#pragma unroll
            for (int k = 0; k < 16; ++k) bk[k] = bk[k] > b[15 - k] ? bk[k] : b[15 - k];
            bitonic_merge16(bk); }
#pragma unroll
        for (int n = 48; n < 50; ++n) { unsigned x = STAIR_KEY(n);
#pragma unroll
            for (int q = 0; q < 16; ++q) { const unsigned hi_ = bk[q] > x ? bk[q] : x; x = bk[q] > x ? x : bk[q]; bk[q] = hi_; } }
#undef STAIR_KEY
        float den = 0.f; float w[16]; const float smax = kval(bk[0] & ~255u);
#pragma unroll
        for (int q = 0; q < 16; ++q) { w[q] = __expf(kval(bk[q] & ~255u) - smax); den += w[q]; }
        const float inv = 1.0f / den;
        if (!odd) { const int h = g >> 1; int* io = IDX + (size_t)row * 128 + h * 16; float* wo = WGT + (size_t)row * 128 + h * 16;
#pragma unroll
            for (int q4 = 0; q4 < 4; ++q4) { int e[4];
#pragma unroll
                for (int j = 0; j < 4; ++j) { const unsigned k = bk[4 * q4 + j]; e[j] = L1[((k >> 4) & 15u) * 512] * 128 + L2[(k & 15u) * 512]; }
                *(int4*)(io + 4 * q4) = make_int4(e[0], e[1], e[2], e[3]);
                *(f32x4*)(wo + 4 * q4) = (f32x4){w[4 * q4] * inv, w[4 * q4 + 1] * inv, w[4 * q4 + 2] * inv, w[4 * q4 + 3] * inv}; } }
    }
}

__device__ __forceinline__ void unpack16(const u32x4 a, const u32x4 b, float (&v)[16]) {
    v[0] = bflo(a.x); v[1] = bfhi(a.x); v[2] = bflo(a.y); v[3] = bfhi(a.y); v[4] = bflo(a.z); v[5] = bfhi(a.z); v[6] = bflo(a.w); v[7] = bfhi(a.w);
    v[8] = bflo(b.x); v[9] = bfhi(b.x); v[10] = bflo(b.y); v[11] = bfhi(b.y); v[12] = bflo(b.z); v[13] = bfhi(b.z); v[14] = bflo(b.w); v[15] = bfhi(b.w); }
__device__ __forceinline__ f32x2 gelu_pk(f32x2 v) {
    const f32x2 av = __builtin_elementwise_abs(v), d = av * 0.2316418882f + 1.0f;
    f32x2 t; t.x = __builtin_amdgcn_rcpf(d.x); t.y = __builtin_amdgcn_rcpf(d.y);
    f32x2 q = t * 0.5307027145f + (-0.7265760135f); q = q * t + 0.7107068705f; q = q * t + (-0.142248368f); q = q * t + 0.127414796f; q = q * t;
    const f32x2 s = (v * v) * (-0.72134752044f);
    f32x2 e; e.x = __builtin_amdgcn_exp2f(s.x); e.y = __builtin_amdgcn_exp2f(s.y);
    const f32x2 m = v * (q * e), r = v - m;
    f32x2 o; o.x = v.x < 0.f ? m.x : r.x; o.y = v.y < 0.f ? m.y : r.y; return o;
}
typedef unsigned u32x6 __attribute__((ext_vector_type(6)));
typedef unsigned u32x16 __attribute__((ext_vector_type(16)));
typedef float f32x32 __attribute__((ext_vector_type(32)));
typedef __bf16 hbf16x32 __attribute__((ext_vector_type(32)));
typedef __bf16 hbf16x2 __attribute__((ext_vector_type(2)));
__device__ __forceinline__ float gelu1(float v) {
    const float av = fabsf(v), t = __builtin_amdgcn_rcpf(av * 0.2316418882f + 1.0f);
    float q = t * 0.5307027145f + (-0.7265760135f); q = q * t + 0.7107068705f; q = q * t + (-0.142248368f); q = q * t + 0.127414796f; q = q * t;
    const float e = __builtin_amdgcn_exp2f((v * v) * (-0.72134752044f));
    const float m = v * (q * e);
    return v < 0.f ? m : v - m;
}
__device__ __forceinline__ void grid_bar_in_phase(Ctx& F) {
    XcdBarrier b_; b_.bar = (unsigned*)(F.ws + WS_CTL) + CW_BAR; b_.x = xb_xcc_id(); b_.st = (volatile LAS unsigned*)(F.lds + MISC_OFF) + 8; xcd_barrier(b_, F.tid == 0);
}
__device__ __forceinline__ f32x4 ldbf4(const bf16_t* p) { const u32x2 w = *(const u32x2*)p; return (f32x4){bflo(w.x), bfhi(w.x), bflo(w.y), bfhi(w.y)}; }
__device__ __forceinline__ void phaseI(Ctx& F, int l) {
    const int gw = F.bid * NWAVES + F.wave, NGW = F.G * NWAVES, lane = F.lane; const int nrows = l < DEPTH - 1 ? MROWS : MLAT;
    const bf16_t* hmod = (const bf16_t*)(F.ws + WS_XMOD); const unsigned char* TUu = F.ws + WS_TU; const unsigned char* TUv = TUu + PEER_TBL;
    const int* IDX = (const int*)(F.ws + WS_IDX); const float* WGT = (const float*)(F.ws + WS_WGT);
    bf16_t* xmod = (bf16_t*)(F.ws + WS_XMOD); bf16_t* FFNB = (bf16_t*)(F.ws + WS_FFN);
    const int c8 = lane & 7, eg = lane >> 3; const bool lb0 = (lane & 1) != 0, lb1 = (lane & 2) != 0, lb2 = (lane & 4) != 0; const int il = (lb2 ? 4 : 0) + (lb0 ? 2 : 0) + (lb1 ? 1 : 0);
    LAS float* pre = (LAS float*)F.lds + F.wave * (17 * 128);
    const int ntok = (nrows - gw + NGW - 1) / NGW;
#define PI_LOADS(TB, QA, QB, ID) do { unsigned o_[8]; \
            _Pragma("unroll") for (int i = 0; i < 8; ++i) o_[i] = (unsigned)__builtin_amdgcn_ds_bpermute(4 * (8 * i + eg), (int)(ID)); \
            _Pragma("unroll") for (int i = 0; i < 8; ++i) { QA[i] = *(const u32x4*)(TB + (o_[i] + (unsigned)c8 * 16u)); QB[i] = *(const u32x2*)(TB + (o_[i] + (unsigned)c8 * 8u) + 128); } \
            __builtin_amdgcn_sched_barrier(0); } while (0)
    for (int sl = 0; sl < 4; ++sl) {
        const unsigned char* tb = TUu + (size_t)sl * PEER_SLICE;
        unsigned hh[16], hhn[16];
        unsigned id0, id1, id0n = 0u, id1n = 0u;
#define PI_META_U(R, H, I0, I1) do { const bf16_t* hp = hmod + (size_t)(R) * D + 256 * sl + 4 * c8; \
            _Pragma("unroll") for (int j = 0; j < 8; ++j) { const u32x2 w = *(const u32x2*)(hp + 32 * j); H[2 * j] = w.x; H[2 * j + 1] = w.y; } \
            I0 = (unsigned)IDX[(size_t)(R) * 128 + lane] * 192u; I1 = (unsigned)IDX[(size_t)(R) * 128 + 64 + lane] * 192u; } while (0)
#define PI_CONSUME_U(QA, QB, KEEP) do { float t_[8]; \
            _Pragma("unroll") for (int i = 0; i < 8; ++i) { \
                const u32x6 u6 = {QA[i].x, QA[i].y, QA[i].z, QA[i].w, QB[i].x, QB[i].y}; \
                const hbf16x32 ub = __builtin_amdgcn_cvt_scalef32_pk32_bf16_fp6(u6, 1.0f); \
                float q_[4] = {0.f, 0.f, 0.f, 0.f};        \
                _Pragma("unroll") for (int m = 0; m < 16; ++m) { hbf16x2 a_; a_[0] = ub[2 * m]; a_[1] = ub[2 * m + 1]; q_[m & 3] = __builtin_amdgcn_fdot2_f32_bf16(a_, __builtin_bit_cast(hbf16x2, hh[m]), q_[m & 3], false); } \
                t_[i] = (q_[0] + q_[1]) + (q_[2] + q_[3]); __builtin_amdgcn_sched_barrier(0); } \
              \
            float a_[4]; _Pragma("unroll") for (int k = 0; k < 4; ++k) { const float kp = lb2 ? t_[4 + k] : t_[k], sd = lb2 ? t_[k] : t_[4 + k]; a_[k] = kp + dpp_f<0x141>(sd); } \
            float b_[2]; _Pragma("unroll") for (int k = 0; k < 2; ++k) { const float kp = lb0 ? a_[2 + k] : a_[k], sd = lb0 ? a_[k] : a_[2 + k]; b_[k] = kp + dpp_f<0xB1>(sd); } \
            { const float kp = lb1 ? b_[1] : b_[0], sd = lb1 ? b_[0] : b_[1]; KEEP = kp + dpp_f<0x4E>(sd); } } while (0)
        PI_META_U(gw, hh, id0, id1);
        u32x4 qaA[8], qaB[8]; u32x2 qbA[8], qbB[8];
        PI_LOADS(tb, qaA, qbA, id0);
        for (int kt = 0; kt < ntok; ++kt) {
            const bool has_next = kt + 1 < ntok;
            if (has_next) PI_META_U(gw + (kt + 1) * NGW, hhn, id0n, id1n);
            __builtin_amdgcn_sched_barrier(0);
            PI_LOADS(tb, qaB, qbB, id1);
            float ka, kb;
            PI_CONSUME_U(qaA, qbA, ka);
            if (has_next) PI_LOADS(tb, qaA, qbA, id0n);
            PI_CONSUME_U(qaB, qbB, kb);
            LAS float* pp = pre + kt * 128 + 8 * il + eg;
            if (sl == 0) { pp[0] = ka; pp[64] = kb; } else { pp[0] += ka; pp[64] += kb; }
            id0 = id0n; id1 = id1n;
#pragma unroll
            for (int m = 0; m < 16; ++m) hh[m] = hhn[m];
        }
#undef PI_META_U
#undef PI_CONSUME_U
    }
    { int kt = 0;
      for (int r = gw; r < nrows; r += NGW, ++kt) { LAS float* pp = pre + kt * 128 + lane;
          const float w0 = WGT[(size_t)r * 128 + lane], w1 = WGT[(size_t)r * 128 + 64 + lane];
          pp[0] = gelu1(pp[0] * (1.0f / PEER_SU)) * w0 * (1.0f / PEER_SV); pp[64] = gelu1(pp[64] * (1.0f / PEER_SU)) * w1 * (1.0f / PEER_SV); } }
    for (int sl = 0; sl < 4; ++sl) {
        const unsigned char* tb = TUv + (size_t)sl * PEER_SLICE;
        unsigned id0 = (unsigned)IDX[(size_t)gw * 128 + lane] * 192u, id1 = (unsigned)IDX[(size_t)gw * 128 + 64 + lane] * 192u, id0n = 0u, id1n = 0u;
        u32x4 qaA[8], qaB[8]; u32x2 qbA[8], qbB[8];
        PI_LOADS(tb, qaA, qbA, id0);
#define PI_ACC16(X) X(0) X(1) X(2) X(3) X(4) X(5) X(6) X(7) X(8) X(9) X(10) X(11) X(12) X(13) X(14) X(15)
#define PI_FMA(J) asm("v_pk_fma_f32 %0, %1, %2, %0" : "+v"(acc[J]) : "v"(__builtin_shufflevector(vf, vf, 2 * (J), 2 * (J) + 1)), "v"(cf2));
#define PI_CONSUME_V(QA, QB, CF) do { _Pragma("unroll") for (int i = 0; i < 8; ++i) { \
                const float cf = __uint_as_float((unsigned)__builtin_amdgcn_ds_bpermute(4 * (8 * i + eg), (int)__float_as_uint(CF))); \
                const u32x6 v6 = {QA[i].x, QA[i].y, QA[i].z, QA[i].w, QB[i].x, QB[i].y}; \
                const f32x32 vf = __builtin_amdgcn_cvt_scalef32_pk32_f32_fp6(v6, 1.0f); \
                const f32x2 cf2 = {cf, cf}; \
                PI_ACC16(PI_FMA) \
                __builtin_amdgcn_sched_barrier(0); } } while (0)
        for (int kt = 0; kt < ntok; ++kt) {
            const int r = gw + kt * NGW; const bool has_next = kt + 1 < ntok;
            if (has_next) { id0n = (unsigned)IDX[(size_t)(r + NGW) * 128 + lane] * 192u; id1n = (unsigned)IDX[(size_t)(r + NGW) * 128 + 64 + lane] * 192u; }
            const float cfa = pre[kt * 128 + lane], cfb = pre[kt * 128 + 64 + lane];
            __builtin_amdgcn_sched_barrier(0);
            PI_LOADS(tb, qaB, qbB, id1);
            f32x2 acc[16];
#pragma unroll
            for (int j = 0; j < 16; ++j) acc[j] = (f32x2){0.f, 0.f};
            PI_CONSUME_V(qaA, qbA, cfa);
            if (has_next) PI_LOADS(tb, qaA, qbA, id0n);
            PI_CONSUME_V(qaB, qbB, cfb);
            float h16[16];
            { const bool b3 = (lane & 8) != 0;
#pragma unroll
              for (int k = 0; k < 16; ++k) { const float lo_ = acc[k >> 1][k & 1], hi_ = acc[8 + (k >> 1)][k & 1]; const float keep = b3 ? hi_ : lo_, send = b3 ? lo_ : hi_;
                  h16[k] = keep + dpp_ror8(send); } }
            float h8[8];
#pragma unroll
            for (int k = 0; k < 8; ++k) { auto rr = __builtin_amdgcn_permlane16_swap(__float_as_uint(h16[k]), __float_as_uint(h16[8 + k]), false, false); h8[k] = __uint_as_float(rr[0]) + __uint_as_float(rr[1]); }
            float h4[4];
#pragma unroll
            for (int k = 0; k < 4; ++k) { auto rr = __builtin_amdgcn_permlane32_swap(__float_as_uint(h8[k]), __float_as_uint(h8[4 + k]), false, false); h4[k] = __uint_as_float(rr[0]) + __uint_as_float(rr[1]); }
            const int cb = 32 * (((lane >> 3) & 1) * 4 + ((lane >> 4) & 1) * 2 + ((lane >> 5) & 1)) + 4 * c8;
            if (sl < 3) *(u32x2*)(FFNB + (size_t)r * D + 256 * sl + cb) = (u32x2){pk2(h4[0], h4[1]), pk2(h4[2], h4[3])};
            else {
                float* so = stream_row(F, r) + cb; const float* md = mod_ptr(F, l, mod_slot(r)) + 5120 + cb; const bf16_t* ff = FFNB + (size_t)r * D + cb;
                float u[16]; float s = 0.f;
#pragma unroll
                for (int q = 0; q < 4; ++q) { const f32x4 x = *(const f32x4*)(so + 256 * q), g = *(const f32x4*)(md + 256 * q), a = q < 3 ? ldbf4(ff + 256 * q) : (f32x4){h4[0], h4[1], h4[2], h4[3]};
#pragma unroll
                    for (int j = 0; j < 4; ++j) { u[4 * q + j] = ALPHA * x[j] + g[j] * a[j]; s += u[4 * q + j]; } }
                const float mean = wave_sum(s) * (1.f / D); float s2 = 0.f;
#pragma unroll
                for (int j = 0; j < 16; ++j) { u[j] -= mean; s2 += u[j] * u[j]; }
                const float rstd = __builtin_amdgcn_rsqf(wave_sum(s2) * (1.f / D) + LN_EPS);
                const float* g2 = F.in[I_LN2G] + l * D + cb; const float* b2 = F.in[I_LN2B] + l * D + cb;
#pragma unroll
                for (int q = 0; q < 4; ++q) { const f32x4 gg = *(const f32x4*)(g2 + 256 * q), bb = *(const f32x4*)(b2 + 256 * q);
#pragma unroll
                    for (int j = 0; j < 4; ++j) u[4 * q + j] = u[4 * q + j] * rstd * gg[j] + bb[j];
                    *(f32x4*)(so + 256 * q) = (f32x4){u[4 * q], u[4 * q + 1], u[4 * q + 2], u[4 * q + 3]}; }
                if (l < DEPTH - 1) { const float* mn = mod_ptr(F, l + 1, mod_slot(r)) + cb; bf16_t* xp = xmod + (size_t)r * D + cb;
#pragma unroll
                    for (int q = 0; q < 4; ++q) { const f32x4 sc = *(const f32x4*)(mn + 1024 + 256 * q), sh = *(const f32x4*)(mn + 256 * q);
                        *(u32x2*)(xp + 256 * q) = (u32x2){pk2(u[4 * q] * (1.f + sc[0]) + sh[0], u[4 * q + 1] * (1.f + sc[1]) + sh[1]), pk2(u[4 * q + 2] * (1.f + sc[2]) + sh[2], u[4 * q + 3] * (1.f + sc[3]) + sh[3])}; } }
            }
            id0 = id0n; id1 = id1n;
        }
#undef PI_CONSUME_V
#undef PI_FMA
#undef PI_ACC16
    }
#undef PI_LOADS
}

enum { PH_PRO = 0, PH_PRO2, PH_XMOD0, PH_WCONV, PH_A, PH_B0, PH_B1, PH_C, PH_D, PH_E, PH_F, PH_F2, PH_G, PH_H, PH_I, PH_COUNT };
__device__ __forceinline__ Ctx make_ctx(const Args& a, unsigned char* lds, int wave0) {
    Ctx F; F.lds = (LAS unsigned char*)lds;
    int lane; asm volatile("v_mbcnt_lo_u32_b32 %0, -1, 0\n\tv_mbcnt_hi_u32_b32 %0, -1, %0" : "=v"(lane));
    OPAQUE_ZERO(z);
    F.lane = lane; F.wave = wave0 + (int)z; F.tid = F.wave * 64 + lane; F.G = gridDim.x; F.bid = (int)blockIdx.x + (int)z;
    F.in = a.in + z; F.out = a.out + z; F.ws = a.ws + z; return F;
}
__global__ void __launch_bounds__(NTHREADS, 2) __attribute__((amdgpu_waves_per_eu(2, 2))) k_all(Args a) {
    extern __shared__ __attribute__((aligned(16))) unsigned char lds[];
    const int wave0 = __builtin_amdgcn_readfirstlane((int)threadIdx.x >> 6);
    volatile LAS unsigned* MISC = (volatile LAS unsigned*)((LAS unsigned char*)lds + MISC_OFF);
    if (threadIdx.x < 64) MISC[threadIdx.x] = 0u;
    __syncthreads();
    (void)xcd_barrier_post((unsigned*)(a.ws + WS_CTL) + CW_BAR, MISC + 8);
#define GRID_BAR() do { XcdBarrier b_; b_.bar = (unsigned*)(a.ws + WS_CTL) + CW_BAR; b_.x = xb_xcc_id(); b_.st = (volatile LAS unsigned*)((LAS unsigned char*)lds + MISC_OFF) + 8; int ln_; asm volatile("v_mbcnt_lo_u32_b32 %0, -1, 0\n\tv_mbcnt_hi_u32_b32 %0, -1, %0" : "=v"(ln_)); xcd_barrier(b_, wave0 == 0 && ln_ == 0); } while (0)
#define PH(call) do { Ctx F = make_ctx(a, lds, wave0); call; } while (0)
    PH(pro_phase(F)); PH(wconv_phase(F, 0)); GRID_BAR();
    if (PROBE_REP & 512) { PH(pro_phase(F)); PH(wconv_phase(F, 0)); GRID_BAR(); }
    PH(pro2_phase(F)); GRID_BAR();
    PH(xmod0_phase(F)); GRID_BAR();
#define MIXER(l, hb) \
            PH(phaseA(F, hb)); GRID_BAR(); \
            PH(phaseB0(F, l, hb)); GRID_BAR(); \
            PH(phaseB1q(F, l)); PH(phaseB1k(F, l)); PH(phaseB1v(F, l)); GRID_BAR(); \
            PH(phaseC(F, l, hb, 0)); GRID_BAR(); \
            if (PROBE_REP & 2) { PH(phaseC(F, l, hb, 1)); GRID_BAR(); } \
            if (hb == 0) { PH(phaseD(F, l)); GRID_BAR(); }
#define LAYER(l) \
        MIXER(l, 0) MIXER(l, 1) \
        PH(phaseE(F, l)); GRID_BAR(); \
        if (PROBE_REP & 8) { PH(phaseE(F, l)); GRID_BAR(); } \
        if (l + 1 < DEPTH) { PH(phaseE2(F)); GRID_BAR(); } \
        PH(phaseF(F, l)); GRID_BAR(); \
        PH(phaseF2(F, l)); GRID_BAR(); \
        PH(phaseG(F, l)); GRID_BAR(); \
        if (PROBE_REP & 16) { PH(phaseG(F, l)); GRID_BAR(); } \
        if (PROBE_REP & 64) { PH(phaseH(F, l)); GRID_BAR(); } \
        PH(phaseH(F, l)); __syncthreads(); if (l + 1 < DEPTH) PH(wconv_phase(F, l + 1)); GRID_BAR(); \
        PH(phaseI(F, l)); if (l + 1 < DEPTH) GRID_BAR();
    LAYER(0) LAYER(1)
#undef LAYER
#undef MIXER
#undef PH
#undef GRID_BAR
}

extern "C" void kernel_launch(void* const* d_in, const int* in_sizes, int n_in, void* d_out, int out_size, void* d_ws, size_t ws_size, hipStream_t stream) {
    if (n_in != 35 || ws_size < WS_END) { fprintf(stderr, "kernel_launch: need 35 inputs and >= %zu B of workspace (got %d, %zu)\n", (size_t)WS_END, n_in, ws_size); return; }
    static int grid = 0;
    if (!grid) {
        int dev = 0, cus = 0, per_cu = 0;
        (void)hipGetDevice(&dev); (void)hipDeviceGetAttribute(&cus, hipDeviceAttributeMultiprocessorCount, dev);
        (void)hipFuncSetAttribute((const void*)k_all, hipFuncAttributeMaxDynamicSharedMemorySize, LDS_BYTES);
        if (hipOccupancyMaxActiveBlocksPerMultiprocessor(&per_cu, (const void*)k_all, NTHREADS, LDS_BYTES) != hipSuccess || per_cu < 1) fprintf(stderr, "kernel_launch: occupancy query says %d blocks per CU\n", per_cu);
        (void)hipGetLastError();
        grid = 256;
        if (cus != 256) fprintf(stderr, "kernel_launch: note: built for a 256-CU device, this one reports %d CUs\n", cus);
    }
    (void)hipMemsetAsync((char*)d_ws + WS_CTL, 0, CTL_BYTES, stream);
    Args a{};
    for (int i = 0; i < 35; ++i) a.in[i] = (const float*)d_in[i];
    a.out = (float*)d_out; a.ws = (unsigned char*)d_ws;
    hipLaunchKernelGGL(k_all, dim3(grid), dim3(NTHREADS), LDS_BYTES, stream, a);
}
```

```cpp
#include <hip/hip_runtime.h>
#include <cstdio>
#include <cstdint>

#define LAS __attribute__((address_space(3)))
#define GAS __attribute__((address_space(1)))
typedef unsigned short bf16_t;
typedef short bf16x8 __attribute__((ext_vector_type(8)));
typedef float f32x2 __attribute__((ext_vector_type(2)));
typedef float f32x4 __attribute__((ext_vector_type(4)));
typedef float f32x16 __attribute__((ext_vector_type(16)));
typedef unsigned u32x2 __attribute__((ext_vector_type(2)));
typedef unsigned u32x4 __attribute__((ext_vector_type(4)));

#define PROBE_REP 0
constexpr int D = 1024, BATCH = 8, SEQ = 4096, CTX = 256, LTOT = SEQ + CTX, DEPTH = 2;
constexpr int MLAT = BATCH * SEQ, MCTX = BATCH * CTX, MROWS = MLAT + MCTX;
constexpr int NB = 4, NHALF = BATCH / NB;
constexpr int ML = NB * LTOT;
constexpr int MLL = NB * SEQ;
constexpr int IN_W = 7968;
constexpr float LN_EPS = 1e-5f, RMS_EPS = 1e-6f, GN_EPS = 64e-5f;
constexpr float ALPHA = 1.4142135623730951f;
constexpr float LOG2E = 1.4426950408889634f;
constexpr float MLA_QS = 0.10206207261596577f * LOG2E;
constexpr float HD_QS = 0.125f * LOG2E;

constexpr size_t MiB = 1u << 20;
constexpr size_t WS_CTL = 0, CTL_BYTES = 1 * MiB;
constexpr size_t WS_MOD = 1 * MiB;
constexpr size_t WS_ROPE = WS_MOD + 512 * 1024;
constexpr size_t WS_LORA = 3 * MiB;
constexpr size_t WS_BON = 4 * MiB;
constexpr size_t WS_RS = 6 * MiB + 512 * 1024;
constexpr size_t WS_WUQ = 7 * MiB;
constexpr size_t WS_WUKV = 8 * MiB;
constexpr size_t WS_WIN = 9 * MiB;
constexpr size_t WS_WBR = 25 * MiB;
constexpr size_t WS_WOUT = 29 * MiB;
constexpr size_t WS_WPK = 31 * MiB;
constexpr size_t WS_XSC = 35 * MiB;
constexpr size_t WS_XMOD = 43 * MiB;
constexpr size_t WS_Y01 = 111 * MiB;
constexpr size_t WS_Y23 = 179 * MiB;
constexpr size_t WS_R = 247 * MiB;
constexpr size_t R_PR = WS_R;
constexpr size_t R_OB = R_PR + (size_t)MROWS * 2048 * 2;
constexpr size_t R_PM = R_OB;
constexpr size_t R_VC = R_PM + (size_t)ML * 512 * 2;
constexpr size_t R_VD = R_VC + (size_t)ML * 128 * 2;
static_assert(R_VD + (size_t)ML * 128 * 2 <= R_OB + (size_t)MROWS * 512 * 2, "Pm/Vc/Vd overlay OB");
constexpr size_t R_QA = R_OB + (size_t)MROWS * 512 * 2;
constexpr size_t R_KA = R_QA + (size_t)ML * 768 * 2;
constexpr size_t R_VAT = R_KA + (size_t)ML * 768 * 2;
constexpr size_t R_QC = R_VAT + (size_t)ML * 512 * 2;
constexpr size_t R_KC = R_QC + (size_t)ML * 512 * 2;
constexpr size_t R_VCT = R_KC + (size_t)ML * 128 * 2;
constexpr size_t R_QD = R_VCT + (size_t)ML * 128 * 2;
constexpr size_t R_KD = R_QD + (size_t)ML * 512 * 2;
constexpr size_t R_VDT = R_KD + (size_t)ML * 128 * 2;
constexpr size_t R_END = R_VDT + (size_t)ML * 128 * 2;
constexpr size_t WS_MODP = WS_R + 250 * MiB;
constexpr size_t WS_END = 539 * MiB;
static_assert(R_END <= WS_END && WS_MODP + 2 * 16 * 9 * 6144 * 4 <= WS_END, "ws map");
constexpr size_t R_ESCR = WS_R, ESCR_PER_BLOCK = 384 * 1024;
constexpr size_t WS_SC = WS_Y01;
constexpr size_t WS_TU = WS_SC + (size_t)MROWS * 2048 * 4;
constexpr size_t WS_TV = WS_TU + (size_t)16384 * 1024;
constexpr size_t WS_IDX = WS_TV + (size_t)16384 * 1024;
constexpr size_t PEER_TBL = (size_t)16384 * 768;
constexpr size_t PEER_SLICE = (size_t)16384 * 192;
constexpr size_t WS_FFN = WS_SC;
constexpr float PEER_SU = 64.f, PEER_SV = 4.f;
constexpr size_t WS_WGT = WS_IDX + (size_t)MROWS * 128 * 4;
static_assert(WS_WGT + (size_t)MROWS * 128 * 4 <= WS_END, "ws map peer");
constexpr int CW_QUEUE = 64;
constexpr int CW_BAR = 4096;

__device__ __forceinline__ unsigned f2bf(float f) { unsigned u = __builtin_bit_cast(unsigned, f); return (u + 0x7fffu + ((u >> 16) & 1u)) >> 16; }
__device__ __forceinline__ unsigned pk2(float lo, float hi) { unsigned r; asm("v_cvt_pk_bf16_f32 %0, %1, %2" : "=v"(r) : "v"(lo), "v"(hi)); return r; }
__device__ __forceinline__ float bf2f(unsigned h) { return __builtin_bit_cast(float, h << 16); }
__device__ __forceinline__ float bflo(unsigned w) { return __builtin_bit_cast(float, w << 16); }
__device__ __forceinline__ float bfhi(unsigned w) { return __builtin_bit_cast(float, w & 0xffff0000u); }
template <int CTRL> __device__ __forceinline__ float dpp_f(float v) { return __builtin_bit_cast(float, __builtin_amdgcn_update_dpp(0, __builtin_bit_cast(int, v), CTRL, 0xf, 0xf, true)); }
template <int CTRL> __device__ __forceinline__ unsigned dpp_u(unsigned v) { return (unsigned)__builtin_amdgcn_update_dpp(0, (int)v, CTRL, 0xf, 0xf, true); }
__device__ __forceinline__ float swap16_sum(float v) { auto r = __builtin_amdgcn_permlane16_swap(__float_as_uint(v), __float_as_uint(v), false, false); return __uint_as_float(r[0]) + __uint_as_float(r[1]); }
__device__ __forceinline__ float swap32_sum(float v) { auto r = __builtin_amdgcn_permlane32_swap(__float_as_uint(v), __float_as_uint(v), false, false); return __uint_as_float(r[0]) + __uint_as_float(r[1]); }
__device__ __forceinline__ float group8_sum(float v) { v += dpp_f<0xB1>(v); v += dpp_f<0x4E>(v); v += dpp_f<0x141>(v); return v; }
__device__ __forceinline__ float wave_sum(float v) { v = group8_sum(v); v += dpp_f<0x140>(v); v = swap16_sum(v); return swap32_sum(v); }
__device__ __forceinline__ float sigmoidf_(float x) { return __builtin_amdgcn_rcpf(1.0f + __expf(-x)); }
template <class T> __device__ __forceinline__ T* uniform_launder(T* p) {
    const unsigned long long v = (unsigned long long)p;
    unsigned lo = __builtin_amdgcn_readfirstlane((unsigned)v), hi = __builtin_amdgcn_readfirstlane((unsigned)(v >> 32));
    asm volatile("" : "+s"(lo), "+s"(hi));
    return (T*)(((unsigned long long)hi << 32) | lo);
}
#define OPAQUE_ZERO(z) size_t z; asm volatile("s_mov_b64 %0, 0" : "=s"(z))
#define LDS_WAIT() asm volatile("s_waitcnt lgkmcnt(0)" ::: "memory")
#define LDS_BARRIER() asm volatile("s_waitcnt lgkmcnt(0)\n\ts_barrier" ::: "memory")
#define VM_WAIT() asm volatile("s_waitcnt vmcnt(0)" ::: "memory")

#define XB_TMO      128
#define XB_XCNT(j)  (256  + 64 * (j))
#define XB_XSUB(j)  (1280 + 64 * (j))
#define XB_XGEN(j)  (2304 + 64 * (j))
#define XB_TOP      3328
#define XB_TOPGEN   3392
#define XCD_BAR_WORDS 3456
#define XB_SPIN_CAP (1u << 22)
__device__ __forceinline__ unsigned xb_ld(unsigned* p)              { return __hip_atomic_load(p, __ATOMIC_RELAXED, __HIP_MEMORY_SCOPE_AGENT); }
__device__ __forceinline__ unsigned xb_add(unsigned* p, unsigned v) { return __hip_atomic_fetch_add(p, v, __ATOMIC_RELAXED, __HIP_MEMORY_SCOPE_AGENT); }
__device__ __forceinline__ unsigned xb_xcc_id() { return (unsigned)__builtin_amdgcn_s_getreg((3 << 11) | 20) & 0xFu; }
#define XB_SPIN(cond, bar) do { unsigned _sp = 0; while (cond) { __builtin_amdgcn_s_sleep(1); \
    if ((++_sp & 255u) == 0u) { if (xb_ld(&(bar)[XB_TMO])) break; if (_sp > XB_SPIN_CAP) { atomicAdd(&(bar)[XB_TMO], 1u); break; } } } } while (0)
struct XcdBarrier { unsigned* bar; unsigned x; volatile LAS unsigned* st; };
__device__ __forceinline__ XcdBarrier xcd_barrier_post(unsigned* bar, volatile LAS unsigned* st) {
    XcdBarrier b; b.bar = bar; b.x = xb_xcc_id(); b.st = st;
    if (threadIdx.x == 0) (void)xb_add(&bar[XB_XCNT(b.x)], 1u);
    return b;
}
__device__ __forceinline__ void xcd_barrier_complete(unsigned* bar, unsigned x, unsigned& nloc, unsigned& nx) {
    const unsigned G = gridDim.x * gridDim.y * gridDim.z;
    unsigned sum, cnt, mine, sp = 0u;
    for (;;) {
        sum = 0u; cnt = 0u; mine = 0u;
#pragma unroll
        for (unsigned j = 0; j < 16; ++j) { const unsigned c = xb_ld(&bar[XB_XCNT(j)]); sum += c; cnt += (c > 0u) ? 1u : 0u; mine = (j == x) ? c : mine; }
        if (sum == G) break;
        __builtin_amdgcn_s_sleep(1);
        if ((++sp & 255u) == 0u) { if (xb_ld(&bar[XB_TMO])) break; if (sp > XB_SPIN_CAP) { atomicAdd(&bar[XB_TMO], 1u); break; } }
    }
    nloc = mine > 0u ? mine : 1u; nx = cnt > 0u ? cnt : 1u;
}
__device__ __forceinline__ void xcd_barrier(const XcdBarrier& b, const bool leader) {
    asm volatile("s_waitcnt vmcnt(0)" ::: "memory");
    __syncthreads();
    if (leader) {
        size_t z_; asm volatile("s_mov_b64 %0, 0" : "=s"(z_)); unsigned* bar = b.bar + z_;
        __builtin_amdgcn_s_waitcnt(0);
        unsigned nloc = b.st[0], nx = b.st[1];
        if (nloc == 0u) { xcd_barrier_complete(bar, b.x, nloc, nx); b.st[0] = nloc; b.st[1] = nx; }
        const unsigned old = xb_add(&bar[XB_XSUB(b.x)], 1u);
        const unsigned gen = old / nloc;
        if (old + 1u == (gen + 1u) * nloc) {
            __builtin_amdgcn_fence(__ATOMIC_RELEASE, "agent");
            asm volatile("s_waitcnt vmcnt(0)" ::: "memory");
            const unsigned og = xb_add(&bar[XB_TOP], 1u);
            const unsigned tg = og / nx;
            if (og + 1u == (tg + 1u) * nx) xb_add(&bar[XB_TOPGEN], 1u);
            else XB_SPIN(xb_ld(&bar[XB_TOPGEN]) == tg, bar);
            __builtin_amdgcn_fence(__ATOMIC_ACQUIRE, "agent");
            xb_add(&bar[XB_XGEN(b.x)], 1u);
            asm volatile("s_waitcnt vmcnt(0)" ::: "memory");
        } else {
            XB_SPIN(xb_ld(&bar[XB_XGEN(b.x)]) == gen, bar);
            __builtin_amdgcn_fence(__ATOMIC_ACQUIRE, "agent");
            asm volatile("s_waitcnt vmcnt(0)" ::: "memory");
        }
    }
    __syncthreads();
}

namespace pg8 {
constexpr int BM = 256, BK = 64, HALF = 128, HTB = HALF * BK * 2, STAGE_BYTES = 8 * HTB, NXCD = 8, WGM = 8;
__host__ __device__ __forceinline__ int lds_byte(int r, int c) { const int st = (r >> 4) * 2 + (c >> 5), rr = r & 15, cc = c & 31, ob = rr * 64 + cc * 2; return st * 1024 + (ob ^ (((ob >> 9) & 1) << 5)); }
__host__ __device__ __forceinline__ void stage_rc(int b, int& R, int& C) { const int st = b / 1024, sb = b % 1024, swz = sb ^ (((sb >> 9) & 1) << 5); R = (st >> 1) * 16 + swz / 64; C = (st & 1) * 32 + (swz % 64) / 2; }
__host__ __device__ __forceinline__ int perm32(int rho) { const int n = rho >> 4, i = rho & 15; return 8 * (i >> 2) + 4 * n + (i & 3); }

struct Unit { const char* a; const char* b; int nt; int pm, pn, kind; };

struct TileOrder {
    int nM, nN, nwg, G, c;
    __device__ void init(int nM_, int nN_, int G_, int c_) { nM = nM_; nN = nN_; nwg = nM * nN; G = G_; c = c_; }
    __device__ bool tile(int i, int& tm, int& tn) const { return tileL((long)i * G + c, tm, tn); }
    __device__ bool tileL(const long L, int& tm, int& tn) const {
        if (L < 0 || L >= nwg) return false;
        int wgid = (int)L; { const int q = nwg / NXCD, r = nwg % NXCD, xcd = wgid % NXCD, off = wgid / NXCD; wgid = (xcd < r ? xcd * (q + 1) : r * (q + 1) + (xcd - r) * q) + off; }
        const int nig = WGM * nN, gid = wgid / nig, fm = gid * WGM, gsz = (nM - fm) < WGM ? (nM - fm) : WGM;
        tm = fm + ((wgid % nig) % gsz); tn = (wgid % nig) / gsz; return true;
    }
};

__device__ __forceinline__ unsigned cvt_pk_bf16(float lo, float hi) { unsigned r; asm volatile("v_cvt_pk_bf16_f32 %0, %1, %2" : "=v"(r) : "v"(lo), "v"(hi)); return r; }

template <class Epi, class Sched>
__device__ __forceinline__ void gemm_phase(LAS unsigned char* lds, const int wave_id, const int lda, const int ldb, const Sched& S, const Epi& E) {
    int tid_; asm volatile("v_mbcnt_lo_u32_b32 %0, -1, 0\n\tv_mbcnt_hi_u32_b32 %0, -1, %0" : "=v"(tid_)); tid_ += wave_id * 64;
    const int tid = tid_, wid = __builtin_amdgcn_readfirstlane(tid >> 6), lane = tid & 63, wr = wid >> 2, wc = wid & 3, fr = lane & 15, fq = lane >> 4;
    unsigned voffA[2], voffB[2];
#pragma unroll
    for (int i = 0; i < 2; ++i) { int R, C; stage_rc(tid * 16 + i * 8192, R, C); const int Rb = (R & ~31) + perm32(R & 31);
        voffA[i] = (unsigned)(R * lda + C) * 2u; voffB[i] = (unsigned)(Rb * ldb + C) * 2u; }
    const size_t kstep = (size_t)(BK * 2);
    const size_t hstepA = (size_t)HALF * lda * 2, hstepB = (size_t)HALF * ldb * 2;
    const unsigned ldsw = (unsigned)wid * 1024u;
    const int aoff = lds_byte(wr * 64 + fr, fq * 8), boff = lds_byte(wc * 32 + fr, fq * 8);
#define PG8_SA(b, h) (((b) * 2 + (h)) * HTB)
#define PG8_SB(b, h) ((4 + (b) * 2 + (h)) * HTB)
#define PG8_STAGE(bufoff, gbase, voff) do { _Pragma("unroll") for (int _i = 0; _i < 2; ++_i) \
        __builtin_amdgcn_global_load_lds((const unsigned*)((const char*)(gbase) + (voff)[_i]), (LAS unsigned*)(lds + (bufoff) + ldsw + _i * 8192), 16, 0, 0); } while (0)
#define PG8_LDA(dst, b, h) do { _Pragma("unroll") for (int m = 0; m < 4; ++m) _Pragma("unroll") for (int k = 0; k < 2; ++k) dst[m][k] = *(const LAS bf16x8*)(lds + PG8_SA(b, h) + aoff + m * 2048 + k * 1024); } while (0)
#define PG8_LDB(dst, b, h) do { _Pragma("unroll") for (int n = 0; n < 2; ++n) _Pragma("unroll") for (int k = 0; k < 2; ++k) dst[n][k] = *(const LAS bf16x8*)(lds + PG8_SB(b, h) + boff + n * 2048 + k * 1024); } while (0)
#define PG8_MMA(ai, bj, At, Bt) do { __builtin_amdgcn_s_setprio(1); _Pragma("unroll") for (int m = 0; m < 4; ++m) _Pragma("unroll") for (int n = 0; n < 2; ++n) _Pragma("unroll") for (int k = 0; k < 2; ++k) \
        acc[ai][bj][m][n] = __builtin_amdgcn_mfma_f32_16x16x32_bf16(Bt[n][k], At[m][k], acc[ai][bj][m][n], 0, 0, 0); __builtin_amdgcn_s_setprio(0); } while (0)
#define PG8_WAIT_V(n) asm volatile("s_waitcnt vmcnt(" #n ")" ::: "memory")
#define PG8_WAIT_L(n) asm volatile("s_waitcnt lgkmcnt(" #n ")" ::: "memory")
#define PG8_BAR __builtin_amdgcn_s_barrier()
#define PG8_SCHED __builtin_amdgcn_sched_barrier(0)
    Unit cur, nxt; int ui = 0;
    if (!S.next(0, cur)) return;
    f32x4 acc[2][2][4][2];
#pragma unroll
    for (int a = 0; a < 2; ++a)
#pragma unroll
        for (int b = 0; b < 2; ++b)
#pragma unroll
            for (int m = 0; m < 4; ++m)
#pragma unroll
                for (int n = 0; n < 2; ++n) acc[a][b][m][n] = (f32x4){0.f, 0.f, 0.f, 0.f};
    bf16x8 At[4][2], B0[2][2], B1[2][2];
    const char* cA = cur.a; const char* cB = cur.b;
    PG8_STAGE(PG8_SB(0, 0), cB, voffB); PG8_STAGE(PG8_SB(0, 1), cB + hstepB, voffB); PG8_STAGE(PG8_SA(0, 0), cA, voffA); PG8_STAGE(PG8_SA(0, 1), cA + hstepA, voffA);
    if (wr == 1) PG8_BAR;
    PG8_WAIT_V(2); PG8_BAR;
    PG8_STAGE(PG8_SB(1, 0), cB + kstep, voffB); PG8_STAGE(PG8_SA(1, 0), cA + kstep, voffA); PG8_STAGE(PG8_SB(1, 1), cB + hstepB + kstep, voffB);
    PG8_WAIT_V(6); PG8_BAR;
    for (;;) {
        const bool has_next = S.next(ui + 1, nxt);
        const char* nA = has_next ? nxt.a : cA; const char* nB = has_next ? nxt.b : cB;
        const int nt = cur.nt;
        for (int t = 0; t < nt; t += 2) {
            const bool last = (t == nt - 2);
            const char* a1 = cA + (size_t)(t + 1) * kstep;
            const char* a2 = last ? nA : cA + (size_t)(t + 2) * kstep; const char* b2 = last ? nB : cB + (size_t)(t + 2) * kstep;
            const char* a3 = a2 + kstep; const char* b3 = b2 + kstep;
            PG8_LDB(B0, 0, 0); PG8_LDB(B1, 0, 1); PG8_SCHED; PG8_LDA(At, 0, 0); PG8_STAGE(PG8_SA(1, 1), a1 + hstepA, voffA);
            PG8_WAIT_V(8); PG8_WAIT_L(0); PG8_BAR; PG8_MMA(0, 0, At, B0); PG8_MMA(0, 1, At, B1); PG8_BAR; PG8_SCHED;
            PG8_LDA(At, 0, 1); PG8_STAGE(PG8_SB(0, 0), b2, voffB); PG8_STAGE(PG8_SB(0, 1), b2 + hstepB, voffB); PG8_STAGE(PG8_SA(0, 0), a2, voffA);
            PG8_WAIT_V(8); PG8_WAIT_L(0); PG8_BAR; PG8_MMA(1, 0, At, B0); PG8_MMA(1, 1, At, B1); PG8_BAR; PG8_SCHED;
            PG8_LDB(B0, 1, 0); PG8_LDB(B1, 1, 1); PG8_SCHED; PG8_LDA(At, 1, 0); PG8_STAGE(PG8_SA(0, 1), a2 + hstepA, voffA);
            PG8_WAIT_V(8); PG8_WAIT_L(0); PG8_BAR; PG8_MMA(0, 0, At, B0); PG8_MMA(0, 1, At, B1); PG8_BAR; PG8_SCHED;
            PG8_LDA(At, 1, 1); PG8_STAGE(PG8_SB(1, 0), b3, voffB); PG8_STAGE(PG8_SB(1, 1), b3 + hstepB, voffB); PG8_STAGE(PG8_SA(1, 0), a3, voffA);
            PG8_WAIT_V(8); PG8_WAIT_L(0); PG8_BAR; PG8_MMA(1, 0, At, B0); PG8_MMA(1, 1, At, B1); PG8_BAR; PG8_SCHED;
        }
        if (wr == 0) PG8_BAR;
        { int t2; asm volatile("v_mbcnt_lo_u32_b32 %0, -1, 0\n\tv_mbcnt_hi_u32_b32 %0, -1, %0" : "=v"(t2)); t2 += wave_id * 64;
          const int wid2 = __builtin_amdgcn_readfirstlane(t2 >> 6), lane2 = t2 & 63; E(acc, cur, wid2 >> 2, wid2 & 3, lane2 & 15, lane2 >> 4); }
        if (!has_next) break;
#pragma unroll
        for (int a = 0; a < 2; ++a)
#pragma unroll
            for (int b = 0; b < 2; ++b)
#pragma unroll
                for (int m = 0; m < 4; ++m)
#pragma unroll
                    for (int n = 0; n < 2; ++n) acc[a][b][m][n] = (f32x4){0.f, 0.f, 0.f, 0.f};
        cur = nxt; cA = nA; cB = nB; ++ui;
        if (wr == 1) PG8_BAR;
    }
    PG8_WAIT_V(0);
    PG8_BAR;
#undef PG8_SA
#undef PG8_SB
#undef PG8_STAGE
#undef PG8_LDA
#undef PG8_LDB
#undef PG8_MMA
#undef PG8_WAIT_V
#undef PG8_WAIT_L
#undef PG8_BAR
#undef PG8_SCHED
}
}

constexpr int NWAVES = 8, NTHREADS = 512;
constexpr int RING_BYTES = 131072;
constexpr int MISC_OFF = 147456 - 256;
constexpr int LDS_BYTES = 147456;

struct Args { const float* in[35]; float* out; unsigned char* ws; int ph_lo, ph_hi; };
enum { I_X = 0, I_C, I_CTX, I_CCTX, I_ADAW, I_ADAB, I_WIN, I_QNORM, I_KVNORM, I_WUQ, I_WUKV, I_MU, I_W0, I_W2, I_A0, I_A2, I_G2, I_KK, I_KA, I_RK, I_LNG, I_LNB,
       I_GQN, I_GKN, I_SINK, I_WBR, I_WOUT, I_LN1G, I_LN1B, I_PWQ, I_PKEYS, I_PU, I_PV, I_LN2G, I_LN2B };

struct Ctx {
    LAS unsigned char* lds;
    const float* const* in; float* out; unsigned char* ws;
    int tid, lane, wave, G, bid;
};

__device__ __forceinline__ void transpose_item(const float* W, int N, int k0, int nsrc0, bf16_t* WT, int ldo, int drow0, int dcol0, const float* ks, float sc, LAS float* scr, int lane) {
#pragma unroll 8
    for (int i = 0; i < 32; ++i) { const int kk = 2 * i + (lane >> 5);
        float v = 0.f; if (nsrc0 >= 0) { v = W[(size_t)(k0 + kk) * N + nsrc0 + (lane & 31)] * sc; if (ks) v *= ks[k0 + kk]; }
        scr[kk * 33 + (lane & 31)] = v; }
    LDS_WAIT(); asm volatile("" ::: "memory");
    const int c = lane & 7;
#pragma unroll
    for (int j = 0; j < 4; ++j) { const int n = (lane >> 3) + 8 * j; const LAS float* s = scr + (8 * c) * 33 + n;
        u32x4 o; o.x = pk2(s[0 * 33], s[1 * 33]); o.y = pk2(s[2 * 33], s[3 * 33]); o.z = pk2(s[4 * 33], s[5 * 33]); o.w = pk2(s[6 * 33], s[7 * 33]);
        *(u32x4*)(WT + (size_t)(drow0 + n) * ldo + dcol0 + k0 + 8 * c) = o; }
    LDS_WAIT(); asm volatile("" ::: "memory");
}
__device__ __forceinline__ int win_src_col(int n) {
    if (n < 416) return n; if (n < 512) return -1;
    if (n < 1280) return 2336 + (n - 512);
    if (n < 2048) return 3104 + (n - 1280);
    if (n < 3968) return 416 + (n - 2048);
    if (n < 4096) return -1;
    return 3872 + (n - 4096);
}
__device__ __forceinline__ void wconv_phase(Ctx& F, int l) {
    LAS float* scr = (LAS float*)(F.lds + F.wave * 16384);
    const int gw = F.bid * NWAVES + F.wave, NGW = F.G * NWAVES;
    const float* win = F.in[I_WIN] + (size_t)l * D * IN_W;
    const float* wbr = F.in[I_WBR] + (size_t)l * 4 * 512 * D;
    const float* wout = F.in[I_WOUT] + (size_t)l * D * D;
    bf16_t* win_t = (bf16_t*)(F.ws + WS_WIN); bf16_t* wbr_t = (bf16_t*)(F.ws + WS_WBR); bf16_t* wout_t = (bf16_t*)(F.ws + WS_WOUT);
    constexpr int I_A = 16 * 256, I_B = 4 * 8 * 32, I_C2 = 16 * 32;
    for (int it = gw; it < I_A + I_B + I_C2; it += NGW) {
        int r = it;
        if (r < I_A) { const int kb = r / 256, nb = r % 256; transpose_item(win, IN_W, 64 * kb, win_src_col(32 * nb), win_t, D, 32 * nb, 0, nullptr, 1.f, scr, F.lane); continue; } r -= I_A;
        if (r < I_B) { const int br = r / 256, rr = r % 256, kb = rr / 32, nb = rr % 32;
            transpose_item(wbr + (size_t)br * 512 * D, D, 64 * kb, 32 * nb, wbr_t + (size_t)(br >> 1) * D * D, D, 32 * nb, (br & 1) * 512, nullptr, 1.f, scr, F.lane); continue; } r -= I_B;
        { const int kb = r / 32, nb = r % 32; transpose_item(wout, D, 64 * kb, 32 * nb, wout_t, D, 32 * nb, 0, nullptr, 1.f, scr, F.lane); }
    }
    const float* wq = F.in[I_PWQ] + (size_t)l * D * D; const float* keys = F.in[I_PKEYS] + (size_t)l * 16 * 128 * 64;
    bf16_t* wpk = (bf16_t*)(F.ws + WS_WPK);
    for (int it = gw; it < 16 * 16 * 4; it += NGW) {
        const int kq = it & 3, g = it >> 6, k = (((it >> 2) & 15) << 6) + F.lane;
        f32x4 q[16];
#pragma unroll
        for (int j = 0; j < 16; ++j) q[j] = *(const f32x4*)(wq + (size_t)k * D + g * 64 + 4 * j);
        for (int key = 32 * kq; key < 32 * kq + 32; ++key) { const float* kr = keys + (size_t)(g * 128 + key) * 64; float s0 = 0.f, s1 = 0.f;
#pragma unroll
            for (int j = 0; j < 16; ++j) { const f32x4 kk = *(const f32x4*)(kr + 4 * j); s0 += q[j].x * kk.x + q[j].z * kk.z; s1 += q[j].y * kk.y + q[j].w * kk.w; }
            wpk[(size_t)(g * 128 + key) * D + k] = (bf16_t)f2bf(s0 + s1); }
    }
}
__device__ __forceinline__ float siluf_(float x) { return x / (1.0f + __expf(-x)); }
__device__ __forceinline__ void pro_phase(Ctx& F) {
    LAS float* scr = (LAS float*)(F.lds + F.wave * 16384);
    const int gw = F.bid * NWAVES + F.wave, NGW = F.G * NWAVES;
    const int gt = F.bid * NTHREADS + F.tid, NGT = F.G * NTHREADS;
    for (int it = gw; it < 2 * (96 + 64); it += NGW) {
        const int l = it / 160, r = it % 160;
        if (r < 96) { const int kb = r / 24, nb = r % 24;
            transpose_item(F.in[I_WUQ] + (size_t)l * 256 * 768, 768, 64 * kb, 32 * nb, (bf16_t*)(F.ws + WS_WUQ) + (size_t)l * 768 * 256, 256, 32 * nb, 0, F.in[I_QNORM] + l * 256, MLA_QS, scr, F.lane); }
        else { const int q = r - 96, kb = q / 32, nb = q % 32, n0 = 32 * nb, h = n0 >> 7, w0 = n0 & 127;
            transpose_item(F.in[I_WUKV] + (size_t)l * 128 * 1024, 1024, 64 * kb, n0, (bf16_t*)(F.ws + WS_WUKV) + (size_t)l * 1024 * 128 + (w0 < 64 ? 0 : 512 * 128), 128, h * 64 + (w0 & 63), 0, F.in[I_KVNORM] + l * 128, 1.f, scr, F.lane); }
    }
    { bf16_t* w2T = (bf16_t*)(F.ws + WS_LORA); bf16_t* a2T = w2T + 2 * 2 * 8 * 4096;
      for (int e = gt; e < 2 * 2 * 8 * 4096; e += NGT) { const int m = e & 63, j = (e >> 6) & 63, h = (e >> 12) & 7, ld = e >> 15;
          w2T[e] = (bf16_t)f2bf(F.in[I_W2][((size_t)ld * 64 + m) * 512 + h * 64 + j]); a2T[e] = (bf16_t)f2bf(F.in[I_A2][((size_t)ld * 64 + m) * 512 + h * 64 + j]); } }
    { bf16_t* g2T = (bf16_t*)(F.ws + WS_LORA) + 2 * (2 * 2 * 8 * 4096);
      for (int e = gt; e < 2 * 512 * 128; e += NGT) { const int k = e & 127, n = (e >> 7) & 511, l = e >> 16; g2T[e] = (bf16_t)f2bf(F.in[I_G2][((size_t)l * 128 + k) * 512 + n]); } }
    { float* cosA = (float*)(F.ws + WS_ROPE); float* sinA = cosA + 4096 * 16; float* cosH = sinA + 4096 * 16; float* sinH = cosH + 4096 * 32;
      for (int e = gt; e < 4096 * 48; e += NGT) { const int t = e / 48, p = e % 48; const float ri = (float)(t >> 6), ci = (float)(t & 63);
          if (p < 16) { const int i = p & 7; const float inv = powf(10000.f, -(float)i / 8.f); const float ang = (p < 8 ? ri : ci) * inv; cosA[t * 16 + p] = cosf(ang); sinA[t * 16 + p] = sinf(ang); }
          else { const int q = p - 16, i = q & 15; const float inv = powf(10000.f, -(float)i / 16.f); const float ang = (q < 16 ? ri : ci) * inv; cosH[t * 32 + q] = cosf(ang); sinH[t * 32 + q] = sinf(ang); } } }
    { float* modp = (float*)(F.ws + WS_MODP); LAS float* sl = (LAS float*)(F.lds + 131072 - 9 * 1024 * 4);
      __syncthreads();
      for (int e = F.tid; e < 9 * 1024; e += NTHREADS) sl[e] = siluf_(e < 8192 ? F.in[I_C][e] : F.in[I_CCTX][e - 8192]);
      __syncthreads();
      for (int it = gw; it < 2 * 16 * 96; it += NGW) { const int l = it / 1536, r = it % 1536, kc = r / 96, jb = r % 96, j = jb * 64 + F.lane;
          float acc[9];
#pragma unroll
          for (int b = 0; b < 9; ++b) acc[b] = 0.f;
          const float* aw = F.in[I_ADAW] + ((size_t)l * D + kc * 64) * 6144 + j;
          for (int kk = 0; kk < 64; ++kk) { const float w = aw[(size_t)kk * 6144]; const int k = kc * 64 + kk;
#pragma unroll
              for (int b = 0; b < 9; ++b) acc[b] += sl[b * 1024 + k] * w; }
#pragma unroll
          for (int b = 0; b < 9; ++b) modp[(((size_t)l * 16 + kc) * 9 + b) * 6144 + j] = acc[b]; }
      __syncthreads(); }
}
__device__ __forceinline__ void pro2_phase(Ctx& F) {
    const int gt = F.bid * NTHREADS + F.tid, NGT = F.G * NTHREADS;
    const float* modp = (const float*)(F.ws + WS_MODP); float* mod = (float*)(F.ws + WS_MOD);
    for (int e = gt; e < 2 * 9 * 6144; e += NGT) { const int j = e % 6144, b = (e / 6144) % 9, l = e / (9 * 6144);
        float s = F.in[I_ADAB][l * 6144 + j];
        for (int kc = 0; kc < 16; ++kc) s += modp[(((size_t)l * 16 + kc) * 9 + b) * 6144 + j];
        mod[e] = s; }
}
__device__ __forceinline__ int mod_slot(int grow) { return grow < MLAT ? (grow >> 12) : 8; }
__device__ __forceinline__ const float* mod_ptr(const Ctx& F, int l, int slot) { return (const float*)(F.ws + WS_MOD) + ((size_t)l * 9 + slot) * 6144; }
__device__ __forceinline__ void xmod0_phase(Ctx& F) {
    const int gw = F.bid * NWAVES + F.wave, NGW = F.G * NWAVES;
    bf16_t* xmod = (bf16_t*)(F.ws + WS_XMOD);
    for (int r = gw; r < MROWS; r += NGW) {
        const float* src = r < MLAT ? F.in[I_X] + (size_t)r * D : F.in[I_CTX] + (size_t)(r - MLAT) * D;
        const float* md = mod_ptr(F, 0, mod_slot(r));
#pragma unroll
        for (int j = 0; j < 4; ++j) { const int c = j * 256 + F.lane * 4;
            const f32x4 x = *(const f32x4*)(src + c), sh = *(const f32x4*)(md + c), sc = *(const f32x4*)(md + 1024 + c);
            u32x2 o; o.x = pk2(x.x * (1.f + sc.x) + sh.x, x.y * (1.f + sc.y) + sh.y); o.y = pk2(x.z * (1.f + sc.z) + sh.z, x.w * (1.f + sc.w) + sh.w);
            *(u32x2*)(xmod + (size_t)r * D + c) = o; }
    }
}

__device__ __forceinline__ int grow_of(int hb, int lr) { return lr < MLL ? hb * MLL + lr : MLAT + hb * NB * CTX + (lr - MLL); }
__device__ __forceinline__ int ltile_grow(int hb, int tm) { return tm < MLL / 256 ? hb * MLL + tm * 256 : MLAT + hb * NB * CTX + (tm - MLL / 256) * 256; }

struct SchedA {
    pg8::TileOrder T1, T2; const char* A; const char* B; int hb, G, c;
    __device__ __forceinline__ bool next(int i, pg8::Unit& u) const { const long L = (long)i * G + c; int tm, tn;
        if (L < T1.nwg) { T1.tileL(L, tm, tn); u.a = A + (size_t)tm * 256 * D * 2; u.b = B + (size_t)(2048 + tn * 256) * D * 2; u.nt = 16; u.pm = tm; u.pn = 8 + tn; u.kind = 1; return true; }
        if (!T2.tileL(L - T1.nwg, tm, tn)) return false;
        u.a = A + (size_t)ltile_grow(hb, tm) * D * 2; u.b = B + (size_t)tn * 256 * D * 2; u.nt = 16; u.pm = tm; u.pn = tn; u.kind = 0; return true; }
};
struct EpiRoute {
    unsigned char* ws;
    __device__ __forceinline__ void operator()(const f32x4 (&acc)[2][2][4][2], const pg8::Unit& u, int wr, int wc, int fr, int fq) const {
        OPAQUE_ZERO(z0); unsigned char* ws = this->ws + z0;
        bf16_t* rp[2]; int step[2];
        const int row0 = u.pm * 256 + wr * 64 + fr;
#pragma unroll
        for (int bj = 0; bj < 2; ++bj) { const int pn = u.pn; size_t off; int pt, co;
            if (pn < 2) { off = R_PM; pt = 512; co = pn * 256 + bj * 128; }
            else if (pn < 4) { off = R_QC; pt = 512; co = (pn - 2) * 256 + bj * 128; }
            else if (pn == 4) { off = bj ? R_VC : R_KC; pt = 128; co = 0; }
            else if (pn < 7) { off = R_QD; pt = 512; co = (pn - 5) * 256 + bj * 128; }
            else if (pn == 7) { off = bj ? R_VD : R_KD; pt = 128; co = 0; }
            else { off = R_PR; pt = 2048; co = (pn - 8) * 256 + bj * 128; }
            rp[bj] = (bf16_t*)(ws + off) + co + wc * 32 + 8 * fq + (size_t)row0 * pt; step[bj] = 16 * pt; }
#pragma unroll
        for (int ai = 0; ai < 2; ++ai) {
#pragma unroll
            for (int m = 0; m < 4; ++m) {
#pragma unroll
                for (int bj = 0; bj < 2; ++bj) { const f32x4 v0 = acc[ai][bj][m][0], v1 = acc[ai][bj][m][1];
                    u32x4 w; w.x = pg8::cvt_pk_bf16(v0[0], v0[1]); w.y = pg8::cvt_pk_bf16(v0[2], v0[3]); w.z = pg8::cvt_pk_bf16(v1[0], v1[1]); w.w = pg8::cvt_pk_bf16(v1[2], v1[3]);
                    *(u32x4*)rp[bj] = w; rp[bj] += step[bj]; }
                asm volatile("" : "+v"(rp[0]), "+v"(rp[1]) :: "memory"); }
            rp[0] += 4 * step[0]; rp[1] += 4 * step[1]; }
    }
};
__device__ __forceinline__ void phaseA(Ctx& F, int hb) {
    SchedA S; S.T1.init(hb == 0 ? MROWS / 256 : 0, 8, F.G, F.bid); S.T2.init(ML / 256, 8, F.G, F.bid); S.A = (const char*)(F.ws + WS_XMOD); S.B = (const char*)(F.ws + WS_WIN); S.hb = hb; S.G = F.G; S.c = F.bid;
    EpiRoute E{F.ws};
    pg8::gemm_phase<EpiRoute, SchedA>(F.lds, F.wave, D, D, S, E);
}

__device__ __forceinline__ void unpack8(const u32x4 w, float (&v)[8]) { v[0] = bflo(w.x); v[1] = bfhi(w.x); v[2] = bflo(w.y); v[3] = bfhi(w.y); v[4] = bflo(w.z); v[5] = bfhi(w.z); v[6] = bflo(w.w); v[7] = bfhi(w.w); }
__device__ __forceinline__ u32x4 pack8(const float (&v)[8]) { u32x4 w; w.x = pk2(v[0], v[1]); w.y = pk2(v[2], v[3]); w.z = pk2(v[4], v[5]); w.w = pk2(v[6], v[7]); return w; }
__device__ __forceinline__ void rope8(float (&v)[8], const float* cs, const float* sn) {
#pragma unroll
    for (int j = 0; j < 4; ++j) { const float a = v[2 * j], b = v[2 * j + 1], c = cs[j], s = sn[j]; v[2 * j] = a * c - b * s; v[2 * j + 1] = a * s + b * c; }
}
__device__ __forceinline__ void phaseB0(Ctx& F, int l, int hb) {
    const int gw = F.bid * NWAVES + F.wave, NGW = F.G * NWAVES, lane = F.lane;
    const float* cosA = (const float*)(F.ws + WS_ROPE); const float* sinA = cosA + 4096 * 16; const float* cosH = sinA + 4096 * 16; const float* sinH = cosH + 4096 * 32;
    bf16_t* Pm = (bf16_t*)(F.ws + R_PM); bf16_t* Ka = (bf16_t*)(F.ws + R_KA);
    bf16_t* Qc = (bf16_t*)(F.ws + R_QC); bf16_t* Kc = (bf16_t*)(F.ws + R_KC); bf16_t* Qd = (bf16_t*)(F.ws + R_QD); bf16_t* Kd = (bf16_t*)(F.ws + R_KD);
    const float* gq = F.in[I_GQN] + l * 64; const float* gk = F.in[I_GKN] + l * 64;
    for (int lr = gw; lr < ML; lr += NGW) {
        const bool lat = lr < MLL; const int t = lat ? (lr & 4095) : 0;
        { float v[8]; unpack8(*(const u32x4*)(Pm + (size_t)lr * 512 + lane * 8), v);
          float ss = 0.f;
#pragma unroll
          for (int j = 0; j < 8; ++j) ss += v[j] * v[j];
          const float sq = wave_sum(lane < 32 ? ss : 0.f), skv = wave_sum((lane >= 32 && lane < 48) ? ss : 0.f);
          if (lane < 48) { const float rs = __builtin_amdgcn_rsqf(lane < 32 ? sq * (1.f / 256.f) + RMS_EPS : skv * (1.f / 128.f) + RMS_EPS);
              float nv[8];
#pragma unroll
              for (int j = 0; j < 8; ++j) nv[j] = v[j] * rs;
              *(u32x4*)(Pm + (size_t)lr * 512 + lane * 8) = pack8(nv); }
          if (lane >= 48 && lane < 52) { const int p0 = 4 * (lane - 48);
              if (lat) rope8(v, cosA + t * 16 + p0, sinA + t * 16 + p0);
              const u32x4 w = pack8(v);
#pragma unroll
              for (int h = 0; h < 8; ++h) *(u32x4*)(Ka + (size_t)lr * 768 + h * 96 + 64 + 8 * (lane - 48)) = w; } }
        { const int p0 = 4 * (lane & 7), d0 = 8 * (lane & 7);
          float v[8]; unpack8(*(const u32x4*)(Qc + (size_t)lr * 512 + lane * 8), v);
          float ss = 0.f;
#pragma unroll
          for (int j = 0; j < 8; ++j) ss += v[j] * v[j];
          ss = group8_sum(ss); const float rs = __builtin_amdgcn_rsqf(ss * (1.f / 64.f) + RMS_EPS);
#pragma unroll
          for (int j = 0; j < 8; ++j) v[j] = v[j] * rs * gq[d0 + j];
          if (lat) rope8(v, cosH + t * 32 + p0, sinH + t * 32 + p0);
#pragma unroll
          for (int j = 0; j < 8; ++j) v[j] *= HD_QS;
          *(u32x4*)(Qc + (size_t)lr * 512 + lane * 8) = pack8(v);
          float q[8]; unpack8(*(const u32x4*)(Qd + (size_t)lr * 512 + lane * 8), q);
          if (lat) rope8(q, cosH + t * 32 + p0, sinH + t * 32 + p0);
#pragma unroll
          for (int j = 0; j < 8; ++j) q[j] *= HD_QS;
          *(u32x4*)(Qd + (size_t)lr * 512 + lane * 8) = pack8(q);
          if (lane < 16) {
              float k[8]; unpack8(*(const u32x4*)(Kc + (size_t)lr * 128 + lane * 8), k);
              float s2 = 0.f;
#pragma unroll
              for (int j = 0; j < 8; ++j) s2 += k[j] * k[j];
              s2 = group8_sum(s2); const float rk = __builtin_amdgcn_rsqf(s2 * (1.f / 64.f) + RMS_EPS);
#pragma unroll
              for (int j = 0; j < 8; ++j) k[j] = k[j] * rk * gk[d0 + j];
              if (lat) rope8(k, cosH + t * 32 + p0, sinH + t * 32 + p0);
              *(u32x4*)(Kc + (size_t)lr * 128 + lane * 8) = pack8(k);
              float kd[8]; unpack8(*(const u32x4*)(Kd + (size_t)lr * 128 + lane * 8), kd);
              if (lat) rope8(kd, cosH + t * 32 + p0, sinH + t * 32 + p0);
              *(u32x4*)(Kd + (size_t)lr * 128 + lane * 8) = pack8(kd);
          } }
    }
    LAS bf16_t* tile = (LAS bf16_t*)F.lds;
    for (int it = F.bid; it < 2 * (ML / 64); it += F.G) {
        const int which = it / (ML / 64), rb = it % (ML / 64), lr0 = rb * 64;
        const bf16_t* src = (const bf16_t*)(F.ws + (which ? R_VD : R_VC)); bf16_t* dst = (bf16_t*)(F.ws + (which ? R_VDT : R_VCT));
        __syncthreads();
#pragma unroll
        for (int i = 0; i < 2; ++i) { const int e = F.tid + i * 512, r = e >> 4, c8 = e & 15;
            *(LAS u32x4*)(tile + r * 136 + c8 * 8) = *(const u32x4*)(src + (size_t)(lr0 + r) * 128 + c8 * 8); }
        __syncthreads();
        const int c = F.tid >> 2, pq = F.tid & 3;
        const bool lat = lr0 < MLL; const int bl = lat ? (lr0 >> 12) : ((lr0 - MLL) >> 8); const int pos0 = lat ? (lr0 & 4095) : 4096 + ((lr0 - MLL) & 255);
        unsigned w[8];
#pragma unroll
        for (int j = 0; j < 8; ++j) w[j] = (unsigned)tile[(pq * 16 + 2 * j) * 136 + c] | ((unsigned)tile[(pq * 16 + 2 * j + 1) * 136 + c] << 16);
        bf16_t* o = dst + ((size_t)(bl * 2 + (c >> 6)) * 64 + (c & 63)) * LTOT + pos0 + pq * 16;
        *(u32x4*)o = (u32x4){w[0], w[1], w[2], w[3]}; *(u32x4*)(o + 8) = (u32x4){w[4], w[5], w[6], w[7]};
    }
    __syncthreads();
}

struct SchedB1 {
    pg8::TileOrder T; const char* A; const char* B; int ldb2; int nt;
    __device__ __forceinline__ bool next(int i, pg8::Unit& u) const { int tm, tn; if (!T.tile(i, tm, tn)) return false;
        u.a = A + (size_t)tm * 256 * 512 * 2; u.b = B + (size_t)tn * 256 * ldb2; u.nt = nt; u.pm = tm; u.pn = tn; u.kind = 0; return true; }
};
struct EpiMlaQ {
    unsigned char* ws;
    __device__ __forceinline__ void operator()(const f32x4 (&acc)[2][2][4][2], const pg8::Unit& u, int wr, int wc, int fr, int fq) const {
        OPAQUE_ZERO(z0); unsigned char* ws = this->ws + z0;
        bf16_t* qp = (bf16_t*)(ws + R_QA) + (size_t)(u.pm * 256 + wr * 64 + fr) * 768 + u.pn * 256 + wc * 32 + 8 * fq;
#pragma unroll
        for (int ai = 0; ai < 2; ++ai) {
#pragma unroll
            for (int m = 0; m < 4; ++m) {
#pragma unroll
                for (int bj = 0; bj < 2; ++bj) { const f32x4 v0 = acc[ai][bj][m][0], v1 = acc[ai][bj][m][1];
                    u32x4 w; w.x = pg8::cvt_pk_bf16(v0[0], v0[1]); w.y = pg8::cvt_pk_bf16(v0[2], v0[3]); w.z = pg8::cvt_pk_bf16(v1[0], v1[1]); w.w = pg8::cvt_pk_bf16(v1[2], v1[3]);
                    *(u32x4*)(qp + bj * 128) = w; }
                qp += 16 * 768; asm volatile("" : "+v"(qp) :: "memory"); }
            qp += 64 * 768; }
    }
};
struct EpiMlaK {
    unsigned char* ws;
    __device__ __forceinline__ void operator()(const f32x4 (&acc)[2][2][4][2], const pg8::Unit& u, int wr, int wc, int fr, int fq) const {
        OPAQUE_ZERO(z0); unsigned char* ws = this->ws + z0;
        const int c0 = u.pn * 256 + wc * 32 + 8 * fq;
        bf16_t* kp = (bf16_t*)(ws + R_KA) + (size_t)(u.pm * 256 + wr * 64 + fr) * 768 + (c0 >> 6) * 96 + (c0 & 63);
#pragma unroll
        for (int ai = 0; ai < 2; ++ai) {
#pragma unroll
            for (int m = 0; m < 4; ++m) {
#pragma unroll
                for (int bj = 0; bj < 2; ++bj) { const f32x4 v0 = acc[ai][bj][m][0], v1 = acc[ai][bj][m][1];
                    u32x4 w; w.x = pg8::cvt_pk_bf16(v0[0], v0[1]); w.y = pg8::cvt_pk_bf16(v0[2], v0[3]); w.z = pg8::cvt_pk_bf16(v1[0], v1[1]); w.w = pg8::cvt_pk_bf16(v1[2], v1[3]);
                    *(u32x4*)(kp + bj * 192) = w; }
                kp += 16 * 768; asm volatile("" : "+v"(kp) :: "memory"); }
            kp += 64 * 768; }
    }
};
struct EpiMlaVT {
    unsigned char* ws;
    __device__ __forceinline__ void operator()(const f32x4 (&acc)[2][2][4][2], const pg8::Unit& u, int wr, int wc, int fr, int fq) const {
        OPAQUE_ZERO(z0); unsigned char* ws = this->ws + z0;
        const int lr0 = u.pn * 256;
        const bool lat = lr0 < MLL; const int bl = lat ? (lr0 >> 12) : ((lr0 - MLL) >> 8); const int pos0 = lat ? (lr0 & 4095) : 4096 + ((lr0 - MLL) & 255);
        bf16_t* vp = (bf16_t*)(ws + R_VAT) + ((size_t)bl * 512 + u.pm * 256 + wr * 64 + fr) * LTOT + pos0 + wc * 32 + 8 * fq;
#pragma unroll
        for (int ai = 0; ai < 2; ++ai) {
#pragma unroll
            for (int m = 0; m < 4; ++m) {
#pragma unroll
                for (int bj = 0; bj < 2; ++bj) { const f32x4 v0 = acc[ai][bj][m][0], v1 = acc[ai][bj][m][1];
                    u32x4 w; w.x = pg8::cvt_pk_bf16(v0[0], v0[1]); w.y = pg8::cvt_pk_bf16(v0[2], v0[3]); w.z = pg8::cvt_pk_bf16(v1[0], v1[1]); w.w = pg8::cvt_pk_bf16(v1[2], v1[3]);
                    *(u32x4*)(vp + bj * 128) = w; }
                vp += (size_t)16 * LTOT; asm volatile("" : "+v"(vp) :: "memory"); }
            vp += (size_t)64 * LTOT; }
    }
};
struct SchedB1T {
    pg8::TileOrder T; const char* A; const char* B;
    __device__ __forceinline__ bool next(int i, pg8::Unit& u) const { int tm, tn; if (!T.tile(i, tm, tn)) return false;
        u.a = A + (size_t)tm * 256 * 128 * 2; u.b = B + (size_t)tn * 256 * 512 * 2; u.nt = 2; u.pm = tm; u.pn = tn; u.kind = 0; return true; }
};
__device__ __forceinline__ void phaseB1q(Ctx& F, int l) {
    SchedB1 S; S.T.init(ML / 256, 3, F.G, F.bid); S.A = (const char*)(F.ws + R_PM); S.B = (const char*)(F.ws + WS_WUQ) + (size_t)l * 768 * 256 * 2; S.ldb2 = 256 * 2; S.nt = 4;
    EpiMlaQ E{F.ws}; pg8::gemm_phase<EpiMlaQ, SchedB1>(F.lds, F.wave, 512, 256, S, E);
}
__device__ __forceinline__ void phaseB1k(Ctx& F, int l) {
    SchedB1 S; S.T.init(ML / 256, 2, F.G, F.bid); S.A = (const char*)(F.ws + R_PM) + 256 * 2; S.B = (const char*)(F.ws + WS_WUKV) + (size_t)l * 1024 * 128 * 2; S.ldb2 = 128 * 2; S.nt = 2;
    EpiMlaK E{F.ws}; pg8::gemm_phase<EpiMlaK, SchedB1>(F.lds, F.wave, 512, 128, S, E);
}
__device__ __forceinline__ void phaseB1v(Ctx& F, int l) {
    SchedB1T S; S.T.init(2, ML / 256, F.G, F.bid); S.A = (const char*)(F.ws + WS_WUKV) + ((size_t)l * 1024 * 128 + 512 * 128) * 2; S.B = (const char*)(F.ws + R_PM) + 256 * 2;
    EpiMlaVT E{F.ws}; pg8::gemm_phase<EpiMlaVT, SchedB1T>(F.lds, F.wave, 128, 512, S, E);
}

struct AttnWave { const bf16_t* q; int qpitch; bf16_t* o; int opitch; int qpos; const float* rope; };
struct AttnKeys { const bf16_t* k; int kpitch; const bf16_t* vt; int lat_p0, lat_n, ctx_n; int bl; int wmask; int has_sink; float sink2; };
template <int DQK>
__device__ __forceinline__ void attn_unit(Ctx& F, const AttnWave& W, const AttnKeys& Kd) {
    constexpr int NCH = DQK / 8, ND0 = DQK / 16, KT_BYTES = NCH * 1024, VT_BYTES = 64 * 144, BUF = KT_BYTES + VT_BYTES;
    constexpr int KPASS = (NCH * 64 + 511) / 512;
    LAS unsigned char* lds = F.lds;
    const int tid = F.tid, lane = F.lane, r32 = lane & 31, hi = lane >> 5;
    const int ntiles = Kd.lat_n + Kd.ctx_n;
    bf16x8 qf[ND0];
#pragma unroll
    for (int d0 = 0; d0 < ND0; ++d0) qf[d0] = *(const bf16x8*)(W.q + (size_t)r32 * W.qpitch + d0 * 16 + hi * 8);
    if constexpr (DQK == 96) if (W.rope) {
#pragma unroll
        for (int d0 = 4; d0 < 6; ++d0) { float v[8]; unpack8(__builtin_bit_cast(u32x4, qf[d0]), v); const float* cs = W.rope + r32 * 16 + 8 * (d0 - 4) + 4 * hi;
            rope8(v, cs, cs + 4096 * 16); qf[d0] = __builtin_bit_cast(bf16x8, pack8(v)); } }
    f32x16 o0 = {}, o1 = {}; float m_run = 0.f, l_run = 0.f; f32x16 negm = {};
    u32x4 kreg[KPASS], vreg;
    auto tile_pos = [&](int t) -> int { return t < Kd.lat_n ? Kd.lat_p0 + 64 * t : 4096 + 64 * (t - Kd.lat_n); };
    auto gload = [&](int t) {
        const int pos = tile_pos(t);
        const int krow0 = pos < 4096 ? Kd.bl * 4096 + pos : MLL + Kd.bl * 256 + (pos - 4096);
#pragma unroll
        for (int p = 0; p < KPASS; ++p) { const int e = tid + p * 512; if (e < NCH * 64) { const int key = e & 63, ch = e >> 6; kreg[p] = *(const u32x4*)(Kd.k + (size_t)(krow0 + key) * Kd.kpitch + ch * 8); } }
        { const int d = tid >> 3, kc = tid & 7; vreg = *(const u32x4*)(Kd.vt + (size_t)d * LTOT + pos + kc * 8); }
    };
    auto lstore = [&](int buf) {
        LAS unsigned char* kb = lds + buf * BUF; LAS unsigned char* vb = kb + KT_BYTES;
#pragma unroll
        for (int p = 0; p < KPASS; ++p) { const int e = tid + p * 512; if (e < NCH * 64) { const int key = e & 63, ch = e >> 6; *(LAS u32x4*)(kb + ch * 1024 + key * 16) = kreg[p]; } }
        { const int d = tid >> 3, kc = tid & 7, g = kc >> 1, half = kc & 1;
          *(LAS u32x2*)(vb + d * 144 + g * 32 + half * 8) = (u32x2){vreg.x, vreg.y};
          *(LAS u32x2*)(vb + d * 144 + g * 32 + (2 + half) * 8) = (u32x2){vreg.z, vreg.w}; }
    };
    __syncthreads();
    gload(0); lstore(0);
    __syncthreads();
    for (int t = 0; t < ntiles; ++t) {
        const int buf = t & 1;
        if (t + 1 < ntiles) gload(t + 1);
        LAS unsigned char* kb = lds + buf * BUF; LAS unsigned char* vb = kb + KT_BYTES;
        f32x16 p0 = negm, p1 = negm;
#pragma unroll
        for (int d0 = 0; d0 < ND0; ++d0) {
            const bf16x8 k0 = *(const LAS bf16x8*)(kb + (2 * d0 + hi) * 1024 + r32 * 16);
            const bf16x8 k1 = *(const LAS bf16x8*)(kb + (2 * d0 + hi) * 1024 + (32 + r32) * 16);
            p0 = __builtin_amdgcn_mfma_f32_32x32x16_bf16(k0, qf[d0], p0, 0, 0, 0);
            p1 = __builtin_amdgcn_mfma_f32_32x32x16_bf16(k1, qf[d0], p1, 0, 0, 0);
        }
        if (Kd.wmask && t < Kd.lat_n) {
            const int jb = tile_pos(t) + 4 * hi - (W.qpos + r32);
#pragma unroll
            for (int r = 0; r < 16; ++r) { const int dj = jb + (r & 3) + 8 * (r >> 2);
                if (dj > 128 || dj < -128) p0[r] = -INFINITY;
                if (dj + 32 > 128 || dj + 32 < -128) p1[r] = -INFINITY; }
        }
        float ma = __builtin_fmaxf(__builtin_fmaxf(p0[0], p0[1]), p1[0]), mb = __builtin_fmaxf(__builtin_fmaxf(p0[2], p0[3]), p1[1]);
        ma = __builtin_fmaxf(__builtin_fmaxf(ma, p1[2]), p1[3]);
#pragma unroll
        for (int r = 4; r < 16; r += 4) { ma = __builtin_fmaxf(__builtin_fmaxf(ma, p0[r]), p0[r + 1]); mb = __builtin_fmaxf(__builtin_fmaxf(mb, p0[r + 2]), p0[r + 3]);
            ma = __builtin_fmaxf(__builtin_fmaxf(ma, p1[r]), p1[r + 1]); mb = __builtin_fmaxf(__builtin_fmaxf(mb, p1[r + 2]), p1[r + 3]); }
        float mx = __builtin_fmaxf(ma, mb);
        { auto rr = __builtin_amdgcn_permlane32_swap(__float_as_uint(mx), __float_as_uint(mx), false, false); mx = __builtin_fmaxf(__uint_as_float(rr[0]), __uint_as_float(rr[1])); }
        if (t == 0 || __any(mx > 8.0f)) {
            const float dl = t == 0 ? __builtin_fmaxf(mx, -100.f) : __builtin_fmaxf(mx, 0.f), alpha = __builtin_amdgcn_exp2f(-dl);
            m_run += dl; l_run *= alpha;
#pragma unroll
            for (int r = 0; r < 16; ++r) { o0[r] *= alpha; o1[r] *= alpha; p0[r] -= dl; p1[r] -= dl; negm[r] = -m_run; }
        }
        float ps0 = 0.f, ps1 = 0.f;
#pragma unroll
        for (int r = 0; r < 16; ++r) { p0[r] = __builtin_amdgcn_exp2f(p0[r]); p1[r] = __builtin_amdgcn_exp2f(p1[r]); ps0 += p0[r]; ps1 += p1[r]; }
        l_run += ps0 + ps1;
        bf16x8 pf[4];
#pragma unroll
        for (int s = 0; s < 4; ++s) { u32x4 w;
            if (s < 2) { w.x = pg8::cvt_pk_bf16(p0[8 * s + 0], p0[8 * s + 1]); w.y = pg8::cvt_pk_bf16(p0[8 * s + 2], p0[8 * s + 3]); w.z = pg8::cvt_pk_bf16(p0[8 * s + 4], p0[8 * s + 5]); w.w = pg8::cvt_pk_bf16(p0[8 * s + 6], p0[8 * s + 7]); }
            else { const int b = 8 * (s - 2); w.x = pg8::cvt_pk_bf16(p1[b + 0], p1[b + 1]); w.y = pg8::cvt_pk_bf16(p1[b + 2], p1[b + 3]); w.z = pg8::cvt_pk_bf16(p1[b + 4], p1[b + 5]); w.w = pg8::cvt_pk_bf16(p1[b + 6], p1[b + 7]); }
            pf[s] = __builtin_bit_cast(bf16x8, w); }
#pragma unroll
        for (int s = 0; s < 4; ++s) {
            const bf16x8 v0 = *(const LAS bf16x8*)(vb + r32 * 144 + s * 32 + hi * 16);
            const bf16x8 v1 = *(const LAS bf16x8*)(vb + (32 + r32) * 144 + s * 32 + hi * 16);
            o0 = __builtin_amdgcn_mfma_f32_32x32x16_bf16(v0, pf[s], o0, 0, 0, 0);
            o1 = __builtin_amdgcn_mfma_f32_32x32x16_bf16(v1, pf[s], o1, 0, 0, 0);
        }
        if (t + 1 < ntiles) lstore(buf ^ 1);
        __syncthreads();
    }
    { auto rr = __builtin_amdgcn_permlane32_swap(__float_as_uint(l_run), __float_as_uint(l_run), false, false); l_run = __uint_as_float(rr[0]) + __uint_as_float(rr[1]); }
    if (Kd.has_sink) l_run += __builtin_amdgcn_exp2f(Kd.sink2 - m_run);
    const float inv = 1.0f / l_run;
    bf16_t* orow = W.o + (size_t)r32 * W.opitch;
#pragma unroll
    for (int g = 0; g < 4; ++g) {
        u32x2 a; a.x = pg8::cvt_pk_bf16(o0[4 * g] * inv, o0[4 * g + 1] * inv); a.y = pg8::cvt_pk_bf16(o0[4 * g + 2] * inv, o0[4 * g + 3] * inv);
        *(u32x2*)(orow + 8 * g + 4 * hi) = a;
        u32x2 b; b.x = pg8::cvt_pk_bf16(o1[4 * g] * inv, o1[4 * g + 1] * inv); b.y = pg8::cvt_pk_bf16(o1[4 * g + 2] * inv, o1[4 * g + 3] * inv);
        *(u32x2*)(orow + 32 + 8 * g + 4 * hi) = b;
    }
}

template <int C> __device__ __forceinline__ void qd_fmac(float& acc, float bsrc, float x) { asm("v_fmac_f32_dpp %0, %1, %2 quad_perm:[%c3,%c3,%c3,%c3] row_mask:0xf bank_mask:0xf" : "+v"(acc) : "v"(bsrc), "v"(x), "n"(C)); }
template <int C> __device__ __forceinline__ float qd_mul(float bsrc, float x) { float d; asm("v_mul_f32_dpp %0, %1, %2 quad_perm:[%c3,%c3,%c3,%c3] row_mask:0xf bank_mask:0xf" : "=v"(d) : "v"(bsrc), "v"(x), "n"(C)); return d; }
__device__ __forceinline__ float dpp_ror8(float x) { float d; asm("s_nop 1\n\tv_mov_b32_dpp %0, %1 row_ror:8 row_mask:0xf bank_mask:0xf" : "=v"(d) : "v"(x)); return d; }
template <int N> __device__ __forceinline__ float ror_add(float x) { float d; asm("s_nop 1\n\tv_add_f32_dpp %0, %1, %1 row_ror:%c2 row_mask:0xf bank_mask:0xf" : "=v"(d) : "v"(x), "n"(N)); return d; }
__device__ __forceinline__ float quads_sum(float x) { return swap32_sum(swap16_sum(ror_add<8>(ror_add<4>(x)))); }
__device__ __forceinline__ float row16_sum(float v) { v += dpp_f<0xB1>(v); v += dpp_f<0x4E>(v); return ror_add<8>(ror_add<4>(v)); }
constexpr int SC_TS = 32;
constexpr int SC_SCR = 0, SC_H = 16384, SC_HPLANE = 4096, SC_HSET = 24576, SC_Y = 65536, SC_YP = 72, SC_LW = 83968, SC_LA = 88064, SC_MU = 92160, SC_CST = 94720, SC_W2 = 96256, SC_A2 = 104448, SC_END = 112640;
static_assert(SC_END <= MISC_OFF, "scan LDS map");
typedef _Float16 sh2 __attribute__((ext_vector_type(2)));
typedef _Float16 sh8 __attribute__((ext_vector_type(8)));
typedef _Float16 sh4 __attribute__((ext_vector_type(4)));
__device__ __forceinline__ unsigned pkh2(float a, float b) { const sh2 v = {(_Float16)a, (_Float16)b}; return __builtin_bit_cast(unsigned, v); }
__device__ __forceinline__ u32x4 packh8(const float (&v)[8]) { return (u32x4){pkh2(v[0], v[1]), pkh2(v[2], v[3]), pkh2(v[4], v[5]), pkh2(v[6], v[7])}; }
__device__ __forceinline__ void scan_item(Ctx& F, int l, int bg, int h, int dir, bool emit_ctx) {
    const int tid = F.tid, lane = F.lane, w = F.wave;
    const bool prep = w >= 4; const int pw = w & 3;
    LAS unsigned char* cb = F.lds;
    LAS float* ybufb = (LAS float*)(cb + SC_Y);
    LAS bf16_t* w2s = (LAS bf16_t*)(cb + SC_W2); LAS bf16_t* a2s = (LAS bf16_t*)(cb + SC_A2); LAS float* cst = (LAS float*)(cb + SC_CST);
    LAS bf16_t* linw = (LAS bf16_t*)(cb + SC_LW); LAS bf16_t* lina = (LAS bf16_t*)(cb + SC_LA); LAS float* mus = (LAS float*)(cb + SC_MU);
    const bf16_t* Pr = (const bf16_t*)(F.ws + R_PR);
    bf16_t* OUT = dir ? (bf16_t*)(F.ws + R_OB) : (bf16_t*)(F.ws + WS_Y01) + 512; const int opitch = dir ? 512 : D;
    float* BON = (float*)(F.ws + WS_BON);
    auto slice_col = [&](int s_) -> int { return s_ == 0 ? h * 64 : s_ == 1 ? 512 + h * 64 : s_ == 2 ? 1024 + h * 64 : s_ == 3 ? 1536 + 64 * dir : 1664 + 64 * dir; };
    constexpr int NCH = LTOT / SC_TS;
    auto chunk_geo = [&](int ch, int& tlo, int& lrow0, int& slen) { const bool isctx = ch < CTX / SC_TS; const int cc = isctx ? ch : ch - CTX / SC_TS; slen = isctx ? CTX : SEQ;
        tlo = dir ? slen - SC_TS * (cc + 1) : SC_TS * cc; lrow0 = isctx ? MLAT + bg * CTX : bg * SEQ; };
    __syncthreads();
    for (int e = tid; e < 640; e += NTHREADS) { const int s_ = e >> 7, which = (e >> 6) & 1, c = e & 63; mus[e] = F.in[I_MU][((size_t)l * 2 + which) * 1920 + slice_col(s_) + c]; }
    if (tid < 320) { const int which = tid >> 6, c = tid & 63; const int ci = (l * 2 + dir) * 512 + h * 64 + c, cj = l * 512 + h * 64 + c;
        cst[tid] = which == 0 ? F.in[I_W0][ci] : which == 1 ? F.in[I_A0][ci] : which == 2 ? F.in[I_KK][cj] : which == 3 ? F.in[I_KA][cj] : F.in[I_RK][cj]; }
    { const u32x4* w2T = (const u32x4*)((const bf16_t*)(F.ws + WS_LORA) + ((size_t)((l * 2 + dir) * 8 + h) * 64) * 64); const u32x4* a2T = w2T + 2 * 2 * 8 * 4096 / 8;
      ((LAS u32x4*)w2s)[tid] = w2T[tid]; ((LAS u32x4*)a2s)[tid] = a2T[tid]; }
    __syncthreads();
    if (prep) {
        const int t8 = lane >> 3, cg = lane & 7, ptt = 8 * pw + t8;
        const int n16 = lane & 15, q16 = lane >> 4;
        u32x4 px[5], pp[5], pn[5];
        const int ptok = dir ? SC_TS - 1 - ptt : ptt;
        auto issue_loads = [&](int ch) { int tlo, lrow0, slen; chunk_geo(ch, tlo, lrow0, slen); const int t = tlo + ptok;
            const bf16_t* row = Pr + (size_t)(lrow0 + t) * 2048 + 8 * cg; const int dp = t > 0 ? 2048 : 0, dn = t < slen - 1 ? 2048 : 0;
#pragma unroll
            for (int s_ = 0; s_ < 5; ++s_) { const bf16_t* ptr = row + slice_col(s_); px[s_] = *(const u32x4*)ptr; pp[s_] = *(const u32x4*)(ptr - dp); pn[s_] = *(const u32x4*)(ptr + dn); } };
        auto prepare = [&](int ch) { int tlo, lrow0, slen; chunk_geo(ch, tlo, lrow0, slen); const int set = ch & 1;
            LAS float* fW = (LAS float*)(cb + SC_SCR); LAS float* fB = fW + 2048;
            LAS unsigned char* hK = cb + SC_H + set * SC_HSET;
            const int t = tlo + ptok; const float zp = t > 0 ? 1.f : 0.f, zn = t < slen - 1 ? 1.f : 0.f;
            float kv[8], rv[8];
#pragma unroll
            for (int s_ = 0; s_ < 5; ++s_) { float x[8], xp[8], xn[8], sh[8]; unpack8(px[s_], x); unpack8(pp[s_], xp); unpack8(pn[s_], xn);
                const LAS float* m0 = mus + (s_ * 2) * 64 + 8 * cg; const LAS float* m1 = m0 + 64;
#pragma unroll
                for (int j = 0; j < 8; ++j) sh[j] = x[j] + m0[j] * (xp[j] * zp - x[j]) + m1[j] * (xn[j] * zn - x[j]);
                if (s_ == 0) { *(LAS u32x4*)(hK + 4 * SC_HPLANE + (ptt * 64 + 8 * cg) * 2) = packh8(sh);
#pragma unroll
                    for (int j = 0; j < 8; ++j) rv[j] = sh[j]; }
                else if (s_ == 1) {
#pragma unroll
                    for (int j = 0; j < 8; ++j) kv[j] = sh[j]; }
                else if (s_ == 2) *(LAS u32x4*)(hK + 5 * SC_HPLANE + (ptt * 64 + 8 * cg) * 2) = packh8(sh);
                else if (s_ == 3) { float th[8];
#pragma unroll
                    for (int j = 0; j < 8; ++j) { const float ex = __expf(2.0f * sh[j]); th[j] = 1.0f - 2.0f * __builtin_amdgcn_rcpf(ex + 1.0f); }
                    *(LAS u32x4*)(linw + ptt * 64 + 8 * cg) = pack8(th); }
                else *(LAS u32x4*)(lina + ptt * 64 + 8 * cg) = pack8(sh); }
            asm volatile("" ::: "memory");
            if (ch + 1 < NCH) issue_loads(ch + 1);
            LDS_WAIT();
#pragma unroll
            for (int ct = 0; ct < 4; ++ct) { f32x4 cw_ = {0.f, 0.f, 0.f, 0.f}, ca_ = {0.f, 0.f, 0.f, 0.f};
#pragma unroll
                for (int ks = 0; ks < 2; ++ks) {
                    const bf16x8 aw = *(const LAS bf16x8*)(linw + (8 * pw + (n16 & 7)) * 64 + 32 * ks + 8 * q16);
                    const bf16x8 aa = *(const LAS bf16x8*)(lina + (8 * pw + (n16 & 7)) * 64 + 32 * ks + 8 * q16);
                    const bf16x8 bwf = *(const LAS bf16x8*)(w2s + (16 * ct + n16) * 64 + 32 * ks + 8 * q16), baf = *(const LAS bf16x8*)(a2s + (16 * ct + n16) * 64 + 32 * ks + 8 * q16);
                    cw_ = __builtin_amdgcn_mfma_f32_16x16x32_bf16(aw, bwf, cw_, 0, 0, 0);
                    ca_ = __builtin_amdgcn_mfma_f32_16x16x32_bf16(aa, baf, ca_, 0, 0, 0); }
                if (q16 < 2) { const float w0c = cst[16 * ct + n16], a0c = cst[64 + 16 * ct + n16];
#pragma unroll
                    for (int r = 0; r < 4; ++r) { const int o = (8 * pw + 4 * q16 + r) * 64 + 16 * ct + n16; fW[o] = cw_[r] + w0c; fB[o] = ca_[r] + a0c; } } }
            LDS_WAIT();
            { float kkr[8], av[8], wd[8], lw[8], la[8]; float ss = 0.f, bsum = 0.f; const int o = ptt * 64 + 8 * cg;
              { const f32x4 a = *(const LAS f32x4*)(fW + o), b = *(const LAS f32x4*)(fW + o + 4), c = *(const LAS f32x4*)(fB + o), d = *(const LAS f32x4*)(fB + o + 4);
#pragma unroll
                for (int j = 0; j < 4; ++j) { lw[j] = a[j]; lw[4 + j] = b[j]; la[j] = c[j]; la[4 + j] = d[j]; } }
#pragma unroll
              for (int j = 0; j < 8; ++j) { kkr[j] = kv[j] * cst[128 + 8 * cg + j]; ss += kkr[j] * kkr[j];
                  wd[j] = __expf(-0.6065306597126334f * __builtin_amdgcn_rcpf(1.0f + __expf(-lw[j]))); av[j] = __builtin_amdgcn_rcpf(1.0f + __expf(-la[j])); }
              ss = group8_sum(ss); const float inv = __builtin_amdgcn_rcpf(fmaxf(__builtin_amdgcn_sqrtf(ss), 1e-12f));
              float kk[8], kb[8], kd[8];
#pragma unroll
              for (int j = 0; j < 8; ++j) { kk[j] = kkr[j] * inv; kb[j] = kk[j] * av[j]; kd[j] = kv[j] * (1.0f + (av[j] - 1.0f) * cst[192 + 8 * cg + j]); bsum += rv[j] * kd[j] * cst[256 + 8 * cg + j]; }
              float ew[8];
#pragma unroll
              for (int j = 0; j < 8; ++j) ew[j] = 1.0f - wd[j];
              *(LAS u32x4*)(hK + o * 2) = packh8(kk); *(LAS u32x4*)(hK + SC_HPLANE + o * 2) = packh8(ew); *(LAS u32x4*)(hK + 2 * SC_HPLANE + o * 2) = packh8(kb); *(LAS u32x4*)(hK + 3 * SC_HPLANE + o * 2) = packh8(kd);
              bsum = group8_sum(bsum);
              if (cg == 0) BON[((size_t)(lrow0 + t) * 8 + h) * 2 + dir] = bsum; } };
        auto outp = [&](int ch) { int tlo, lrow0, slen; chunk_geo(ch, tlo, lrow0, slen); const bool isctx = ch < CTX / SC_TS; const LAS float* ybuf = ybufb + (ch & 1) * (32 * SC_YP);
            if (!isctx || emit_ctx) {
                const f32x4 ya = *(const LAS f32x4*)(ybuf + ptt * SC_YP + 8 * cg), yb = *(const LAS f32x4*)(ybuf + ptt * SC_YP + 8 * cg + 4);
                *(u32x4*)(OUT + (size_t)(lrow0 + tlo + ptok) * opitch + h * 64 + 8 * cg) = (u32x4){pk2(ya[0], ya[1]), pk2(ya[2], ya[3]), pk2(yb[0], yb[1]), pk2(yb[2], yb[3])}; } };
        issue_loads(0);
        for (int ch = -1; ch < NCH; ++ch) {
            if (ch > 0) outp(ch - 1);
            if (ch + 1 < NCH) prepare(ch + 1);
            LDS_BARRIER();
        }
        outp(NCH - 1);
    } else {
        sh2 Sa[4], Sb[4];
#pragma unroll
        for (int c = 0; c < 4; ++c) { Sa[c] = (sh2){(_Float16)0.f, (_Float16)0.f}; Sb[c] = Sa[c]; }
        const int g = lane & 7, ra = 16 * pw + (lane >> 3);
        LDS_BARRIER();
        for (int ch = 0; ch < NCH; ++ch) {
            const int set = ch & 1; const LAS sh8* fH = (const LAS sh8*)(cb + SC_H + set * SC_HSET) + g; const LAS _Float16* vbuf = (const LAS _Float16*)(cb + SC_H + set * SC_HSET + 5 * SC_HPLANE) + ra;
            LAS float* ybuf = ybufb + set * (32 * SC_YP) + g * SC_YP + ra;
            asm volatile("" : "+v"(fH), "+v"(vbuf), "+v"(ybuf));
            float yk_a = 0.f, yk_b = 0.f;
#define SC_LOAD(T, K_, E_, B_, D_, R_, VA, VB) do { const LAS sh8* q_ = fH + (T) * 8; K_ = q_[0]; E_ = q_[256]; B_ = q_[512]; D_ = q_[768]; R_ = q_[1024]; VA = vbuf[(T) * 64]; VB = vbuf[(T) * 64 + 8]; } while (0)
            sh8 k4, e4, b4, d4, r4; _Float16 va, vb;
            SC_LOAD(0, k4, e4, b4, d4, r4, va, vb);
#pragma unroll 8
            for (int st = 0; st < SC_TS; ++st) {
                const int tn = (st + 1 < SC_TS) ? st + 1 : st;
                sh8 k4n, e4n, b4n, d4n, r4n; _Float16 van, vbn;
                SC_LOAD(tn, k4n, e4n, b4n, d4n, r4n, van, vbn);
                float sa_ = 0.f, sb_ = 0.f;
#pragma unroll
                for (int c = 0; c < 4; ++c) { const sh2 kc = {k4[2 * c], k4[2 * c + 1]}; sa_ = __builtin_amdgcn_fdot2(Sa[c], kc, sa_, false); sb_ = __builtin_amdgcn_fdot2(Sb[c], kc, sb_, false); }
                const sh2 va2 = {va, va}, vb2 = {vb, vb};
#pragma unroll
                for (int c = 0; c < 4; ++c) { const sh2 ec = {e4[2 * c], e4[2 * c + 1]}, dc = {d4[2 * c], d4[2 * c + 1]};
                    Sa[c] = Sa[c] - Sa[c] * ec; Sb[c] = Sb[c] - Sb[c] * ec; Sa[c] = dc * va2 + Sa[c]; Sb[c] = dc * vb2 + Sb[c]; }
                const float nsa = -group8_sum(sa_), nsb = -group8_sum(sb_);
                const sh2 na2 = {(_Float16)nsa, (_Float16)nsa}, nb2 = {(_Float16)nsb, (_Float16)nsb};
#pragma unroll
                for (int c = 0; c < 4; ++c) { const sh2 bc = {b4[2 * c], b4[2 * c + 1]}; Sa[c] = bc * na2 + Sa[c]; Sb[c] = bc * nb2 + Sb[c]; }
                float ya_ = 0.f, yb_ = 0.f;
#pragma unroll
                for (int c = 0; c < 4; ++c) { const sh2 rc = {r4[2 * c], r4[2 * c + 1]}; ya_ = __builtin_amdgcn_fdot2(Sa[c], rc, ya_, false); yb_ = __builtin_amdgcn_fdot2(Sb[c], rc, yb_, false); }
                const float y_a = group8_sum(ya_), y_b = group8_sum(yb_);
                yk_a = g == (st & 7) ? y_a : yk_a; yk_b = g == (st & 7) ? y_b : yk_b;
                if ((st & 7) == 7) { ybuf[(st - 7) * SC_YP] = yk_a; ybuf[(st - 7) * SC_YP + 8] = yk_b; }
                k4 = k4n; e4 = e4n; b4 = b4n; d4 = d4n; r4 = r4n; va = van; vb = vbn;
            }
#undef SC_LOAD
            LDS_BARRIER();
        }
    }
    __syncthreads();
}

__device__ __forceinline__ void phaseC(Ctx& F0, int l, int hb, int rep = 0) {
    Ctx F = F0;
    volatile LAS unsigned* MISC = (volatile LAS unsigned*)(F.lds + MISC_OFF);
    unsigned* head = (unsigned*)(F.ws + WS_CTL) + CW_QUEUE + 64 * ((l * NHALF + hb) * 4 + rep);
    const bool do_ctx = (l < DEPTH - 1);
    const int N_SCAN = hb == 0 ? BATCH * 8 * 2 : 0;
    constexpr int N_MLA = NB * 8 * 16, N_GQA = NB * 2 * 64, N_WIN = NB * 2 * 64, N_CX = NB * 8 + NB * 2 * 4 + NB * 2 * 4;
    const int total = N_SCAN + N_MLA + N_GQA + N_WIN + (do_ctx ? N_CX : 0);
    const int wave = F.wave;
    for (;;) {
        __syncthreads();
        if (F.tid == 0) MISC[16] = __hip_atomic_fetch_add(head, 1u, __ATOMIC_RELAXED, __HIP_MEMORY_SCOPE_AGENT);
        __syncthreads();
        int it = (int)MISC[16];
        if (it >= total) break;
        { OPAQUE_ZERO(zq); int ln; asm volatile("v_mbcnt_lo_u32_b32 %0, -1, 0\n\tv_mbcnt_hi_u32_b32 %0, -1, %0" : "=v"(ln));
          F.ws = F0.ws + zq; F.in = F0.in + zq; F.lane = ln; F.tid = F0.wave * 64 + ln; }
        bf16_t* Y01 = (bf16_t*)(F.ws + WS_Y01); bf16_t* Y23 = (bf16_t*)(F.ws + WS_Y23);
        if (it < N_SCAN) { if (rep != 1) scan_item(F, l, it >> 4, (it >> 1) & 7, it & 1, do_ctx); continue; } it -= N_SCAN;
        bool mla, win = false, cx = false; int bl, hh, qb;
        if (it < N_MLA) { mla = true; bl = it >> 7; hh = (it >> 4) & 7; qb = it & 15; }
        else if ((it -= N_MLA) < N_GQA + N_WIN) { mla = false; win = it >= N_GQA; if (win) it -= N_GQA; bl = it >> 7; hh = (it >> 6) & 1; qb = it & 63; }
        else if ((it -= N_GQA + N_WIN) < NB * 8) { mla = true; cx = true; bl = it >> 3; hh = it & 7; qb = 0; }
        else { it -= NB * 8; mla = false; cx = true; win = it >= NB * 8; if (win) it -= NB * 8; bl = it >> 3; hh = (it >> 2) & 1; qb = it & 3; }
        if (mla) { const int h = hh, t0 = qb * 256 + wave * 32; const int lr = cx ? MLL + bl * 256 + wave * 32 : bl * 4096 + t0;
            AttnWave W{(const bf16_t*)(F.ws + R_QA) + (size_t)lr * 768 + h * 96, 768, Y01 + (size_t)grow_of(hb, lr) * D + h * 64, D, 0, cx ? nullptr : (const float*)(F.ws + WS_ROPE) + (size_t)t0 * 16};
            AttnKeys K{(const bf16_t*)(F.ws + R_KA) + h * 96, 768, (const bf16_t*)(F.ws + R_VAT) + (size_t)(bl * 8 + h) * 64 * LTOT, 0, cx ? 0 : 64, 4, bl, 0, 0, 0.f};
            attn_unit<96>(F, W, K); }
        else { const int kvh = hh, hq = 4 * kvh + (wave >> 1); const int t0 = qb * 64 + (wave & 1) * 32, lr = cx ? MLL + bl * 256 + t0 : bl * 4096 + t0;
            AttnWave W{(const bf16_t*)(F.ws + (win ? R_QD : R_QC)) + (size_t)lr * 512 + hq * 64, 512, Y23 + (size_t)grow_of(hb, lr) * D + (win ? 512 : 0) + hq * 64, D, t0, nullptr};
            AttnKeys K{(const bf16_t*)(F.ws + (win ? R_KD : R_KC)) + kvh * 64, 128, (const bf16_t*)(F.ws + (win ? R_VDT : R_VCT)) + (size_t)(bl * 2 + kvh) * 64 * LTOT, 0, cx ? 0 : 64, 4, bl, 0, win ? 1 : 0, win ? F.in[I_SINK][l * 8 + hq] * LOG2E : 0.f};
            if (win && !cx) { int p0 = qb * 64 - 128, n = 5; if (p0 < 0) { n -= (-p0) / 64; p0 = 0; } if (p0 + 64 * n > SEQ) n = (SEQ - p0) / 64; K.lat_p0 = p0; K.lat_n = n; K.wmask = 1; }
            attn_unit<64>(F, W, K); }
    }
}

__device__ __forceinline__ void phaseD(Ctx& F, int l) {
    const bool do_ctx = (l < DEPTH - 1); const int nrows = do_ctx ? MROWS : MLAT;
    LAS bf16_t* sgb = (LAS bf16_t*)F.lds;
    LAS float* vs = (LAS float*)(F.lds + 4096);
    LAS float* on = vs + 16 * 512;
    LAS float* bn = on + 16 * 512;
    const bf16_t* Pr = (const bf16_t*)(F.ws + R_PR); const bf16_t* OF = (const bf16_t*)(F.ws + WS_Y01) + 512; const bf16_t* OB = (const bf16_t*)(F.ws + R_OB);
    const float* BON = (const float*)(F.ws + WS_BON); bf16_t* Y01 = (bf16_t*)(F.ws + WS_Y01);
    const float* mu0 = F.in[I_MU] + (size_t)l * 2 * 1920, * mu1 = mu0 + 1920;
    const int lane = F.lane, w = F.wave, n16 = lane & 15, kg = lane >> 4;
    bf16x8 bf[4][4];
    { const bf16_t* g2T = (const bf16_t*)(F.ws + WS_LORA) + 2 * (2 * 2 * 8 * 4096) + (size_t)l * 512 * 128;
#pragma unroll
      for (int ct = 0; ct < 4; ++ct)
#pragma unroll
          for (int ks = 0; ks < 4; ++ks) bf[ct][ks] = *(const bf16x8*)(g2T + (size_t)(64 * w + 16 * ct + n16) * 128 + 32 * ks + 8 * kg); }
    float lg[4], lb[4];
#pragma unroll
    for (int ct = 0; ct < 4; ++ct) { lg[ct] = F.in[I_LNG][l * 512 + 64 * w + 16 * ct + n16]; lb[ct] = F.in[I_LNB][l * 512 + 64 * w + 16 * ct + n16]; }
    for (int r0 = F.bid * 16; r0 < nrows; r0 += F.G * 16) {
        __syncthreads();
#pragma unroll
        for (int rr = 0; rr < 2; ++rr) { const int li = 2 * w + rr, lr = r0 + li; const bool lat = lr < MLAT; const int t = lat ? (lr & 4095) : ((lr - MLAT) & 255), slen = lat ? SEQ : CTX;
          const bf16_t* p = Pr + (size_t)lr * 2048;
          auto shifted = [&](int col, float (&sh)[8]) { float x[8], xp[8], xn[8]; unpack8(*(const u32x4*)(p + col), x);
              unpack8(*(const u32x4*)(p + col - (t > 0 ? 2048 : 0)), xp); unpack8(*(const u32x4*)(p + col + (t < slen - 1 ? 2048 : 0)), xn);
              const float zp = t > 0 ? 1.f : 0.f, zn = t < slen - 1 ? 1.f : 0.f;
#pragma unroll
              for (int j = 0; j < 8; ++j) sh[j] = x[j] + mu0[col + j] * (xp[j] * zp - x[j]) + mu1[col + j] * (xn[j] * zn - x[j]); };
          float sh[8];
          shifted(1024 + lane * 8, sh);
          *(LAS f32x4*)(vs + li * 512 + lane * 8) = (f32x4){sh[0], sh[1], sh[2], sh[3]}; *(LAS f32x4*)(vs + li * 512 + lane * 8 + 4) = (f32x4){sh[4], sh[5], sh[6], sh[7]};
          if (lane < 16) { shifted(1792 + lane * 8, sh);
#pragma unroll
              for (int j = 0; j < 8; ++j) sh[j] = sigmoidf_(sh[j]);
              *(LAS u32x4*)(sgb + li * 128 + lane * 8) = pack8(sh); }
          float a[8], b[8]; unpack8(*(const u32x4*)(OF + (size_t)lr * D + lane * 8), a); unpack8(*(const u32x4*)(OB + (size_t)lr * 512 + lane * 8), b);
          float s_ = 0.f;
#pragma unroll
          for (int j = 0; j < 8; ++j) { a[j] += b[j]; s_ += a[j]; }
          const float mean = group8_sum(s_) * (1.f / 64.f); float q = 0.f;
#pragma unroll
          for (int j = 0; j < 8; ++j) { a[j] -= mean; q += a[j] * a[j]; }
          const float rstd = __builtin_amdgcn_rsqf(group8_sum(q) * (1.f / 64.f) + GN_EPS);
          *(LAS f32x4*)(on + li * 512 + lane * 8) = (f32x4){a[0] * rstd, a[1] * rstd, a[2] * rstd, a[3] * rstd}; *(LAS f32x4*)(on + li * 512 + lane * 8 + 4) = (f32x4){a[4] * rstd, a[5] * rstd, a[6] * rstd, a[7] * rstd};
          if (lane < 8) { const size_t gi = ((size_t)lr * 8 + lane) * 2; bn[li * 8 + lane] = BON[gi] + BON[gi + 1]; } }
        __syncthreads();
        f32x4 acc[4];
#pragma unroll
        for (int ct = 0; ct < 4; ++ct) acc[ct] = (f32x4){0.f, 0.f, 0.f, 0.f};
#pragma unroll
        for (int ks = 0; ks < 4; ++ks) { const bf16x8 af = *(const LAS bf16x8*)(sgb + n16 * 128 + 32 * ks + 8 * kg);
#pragma unroll
            for (int ct = 0; ct < 4; ++ct) acc[ct] = __builtin_amdgcn_mfma_f32_16x16x32_bf16(af, bf[ct][ks], acc[ct], 0, 0, 0); }
#pragma unroll
        for (int ct = 0; ct < 4; ++ct) { const int n = 64 * w + 16 * ct + n16;
#pragma unroll
            for (int r = 0; r < 4; ++r) { const int li = 4 * kg + r;
                const float y = (on[li * 512 + n] * lg[ct] + lb[ct] + bn[li * 8 + w] * vs[li * 512 + n]) * acc[ct][r];
                Y01[(size_t)(r0 + li) * D + 512 + n] = (bf16_t)f2bf(y); } }
    }
    __syncthreads();
}

constexpr size_t R_ACC = WS_R + 100 * MiB;
constexpr size_t R_CTXP = WS_R + 170 * MiB;
struct SchedE {
    pg8::TileOrder T; unsigned char* ws; int ctxjobs, c;
    __device__ __forceinline__ bool next(int i, pg8::Unit& u) const { int tm, tn, sub, br; bool cj = false;
        if (T.tile(i >> 3, tm, tn)) { sub = i & 7; br = sub >> 1; }
        else { if (!ctxjobs || i < 16 || i > 17 || c >= 128) return false; const int tile = c >> 2; br = c & 3; tm = MLAT / 256 + (tile >> 2); tn = tile & 3; sub = 2 * br + (i & 1); cj = true; }
        u.pm = tm; u.pn = tn; u.kind = sub | (cj ? 8 : 0);
        if (!(sub & 1)) { u.a = (const char*)(ws + WS_XMOD) + (size_t)tm * 256 * D * 2; u.b = (const char*)(ws + WS_WIN) + (size_t)(4096 + br * 1024 + tn * 256) * D * 2; u.nt = 16; }
        else { u.a = (const char*)(ws + (br < 2 ? WS_Y01 : WS_Y23)) + (size_t)tm * 256 * D * 2 + (br & 1) * 512 * 2;
               u.b = (const char*)(ws + WS_WBR) + (size_t)(br >> 1) * D * D * 2 + (size_t)tn * 256 * D * 2 + (br & 1) * 512 * 2; u.nt = 8; }
        return true; }
};
__device__ __forceinline__ float sig255(float x) { return __builtin_amdgcn_rcpf(__builtin_fmaf(__expf(-x), 1.0f / 255.0f, 1.0f / 255.0f)); }
struct EpiMerge {
    unsigned char* ws; int bid; int tid0;
    __device__ __forceinline__ void operator()(const f32x4 (&acc)[2][2][4][2], const pg8::Unit& u, int wr, int wc, int fr, int fq) const {
        OPAQUE_ZERO(z0); unsigned char* ws = this->ws + z0;
        int tid = tid0; asm volatile("" : "+v"(tid));
        u32x4* sp = (u32x4*)(ws + R_ESCR + (size_t)bid * ESCR_PER_BLOCK) + tid; u32x4* pp = (u32x4*)(ws + R_ESCR + (size_t)bid * ESCR_PER_BLOCK + 131072) + tid;
        if (!(u.kind & 1)) {
#pragma unroll
            for (int ai = 0; ai < 2; ++ai)
#pragma unroll
                for (int m = 0; m < 4; ++m) { u32x4 w;
#pragma unroll
                    for (int bj = 0; bj < 2; ++bj) { const f32x4 v0 = acc[ai][bj][m][0], v1 = acc[ai][bj][m][1]; unsigned a_ = 0u, b_ = 0u;
#pragma unroll
                        for (int j = 0; j < 4; ++j) { a_ = __builtin_amdgcn_cvt_pk_u8_f32(sig255(v0[j]), j, a_); b_ = __builtin_amdgcn_cvt_pk_u8_f32(sig255(v1[j]), j, b_); }
                        w[2 * bj] = a_; w[2 * bj + 1] = b_; }
                    *sp = w; sp += 512; asm volatile("" : "+v"(sp) :: "memory"); }
        } else {
            const int br = (u.kind & 7) >> 1; const bool cj = (u.kind & 8) != 0;
            float* cp = (float*)(ws + R_CTXP) + ((size_t)br * MCTX + (u.pm * 256 - MLAT) + wr * 64 + fr) * D + u.pn * 256 + wc * 32 + 8 * fq;
            bf16_t* op = (bf16_t*)(ws + R_ACC) + (size_t)(u.pm * 256 + wr * 64 + fr) * D + u.pn * 256 + wc * 32 + 8 * fq;
#pragma unroll
            for (int ai = 0; ai < 2; ++ai)
#pragma unroll
                for (int m = 0; m < 4; ++m) { const u32x4 gs = *sp;
#pragma unroll
                    for (int bj = 0; bj < 2; ++bj) { const unsigned ga = gs[2 * bj], gb = gs[2 * bj + 1];
                        f32x4 v0 = acc[ai][bj][m][0], v1 = acc[ai][bj][m][1];
#pragma unroll
                        for (int j = 0; j < 4; ++j) { v0[j] *= (float)((ga >> (8 * j)) & 0xffu); v1[j] *= (float)((gb >> (8 * j)) & 0xffu); }
                        if (cj) { float* q = cp + (size_t)(ai * 128 + m * 16) * D + bj * 128; *(f32x4*)q = v0 * (1.0f / 255.0f); *(f32x4*)(q + 4) = v1 * (1.0f / 255.0f); }
                        else if (br > 0) { float q_[8]; unpack8(*pp, q_); v0 += (f32x4){q_[0], q_[1], q_[2], q_[3]}; v1 += (f32x4){q_[4], q_[5], q_[6], q_[7]}; }
                        if (cj) {}
                        else if (br < 3) { u32x4 w; w.x = pg8::cvt_pk_bf16(v0[0], v0[1]); w.y = pg8::cvt_pk_bf16(v0[2], v0[3]); w.z = pg8::cvt_pk_bf16(v1[0], v1[1]); w.w = pg8::cvt_pk_bf16(v1[2], v1[3]); *pp = w; }
                        else { v0 = v0 * (1.0f / 255.0f); v1 = v1 * (1.0f / 255.0f);
                            u32x4 w; w.x = pg8::cvt_pk_bf16(v0[0], v0[1]); w.y = pg8::cvt_pk_bf16(v0[2], v0[3]); w.z = pg8::cvt_pk_bf16(v1[0], v1[1]); w.w = pg8::cvt_pk_bf16(v1[2], v1[3]);
                            *(u32x4*)(op + (size_t)(ai * 128 + m * 16) * D + bj * 128) = w; }
                        pp += 512; asm volatile("" : "+v"(pp) :: "memory"); }
                    sp += 512; asm volatile("" : "+v"(sp) :: "memory"); }
        }
    }
};
__device__ __forceinline__ void phaseE(Ctx& F, int l) {
    SchedE S; S.T.init(MLAT / 256, 4, F.G, F.bid); S.ws = F.ws; S.ctxjobs = (l < DEPTH - 1) ? 1 : 0; S.c = F.bid;
    EpiMerge E{F.ws, F.bid, F.tid};
    pg8::gemm_phase<EpiMerge, SchedE>(F.lds, F.wave, D, D, S, E);
}
__device__ __forceinline__ void phaseE2(Ctx& F) {
    const int gt = F.bid * NTHREADS + F.tid, NGT = F.G * NTHREADS;
    const float* cp = (const float*)(F.ws + R_CTXP); bf16_t* acc = (bf16_t*)(F.ws + R_ACC) + (size_t)MLAT * D;
    for (int e = gt; e < MCTX * D / 8; e += NGT) { float v[8];
#pragma unroll
        for (int j = 0; j < 8; ++j) v[j] = 0.f;
#pragma unroll
        for (int br = 0; br < 4; ++br) { const f32x4 a = *(const f32x4*)(cp + (size_t)br * MCTX * D + (size_t)e * 8), b = *(const f32x4*)(cp + (size_t)br * MCTX * D + (size_t)e * 8 + 4);
#pragma unroll
            for (int j = 0; j < 4; ++j) { v[j] += a[j]; v[4 + j] += b[j]; } }
        *(u32x4*)(acc + (size_t)e * 8) = pack8(v); }
}

__device__ __forceinline__ float* stream_row(const Ctx& F, int grow) { return grow < MLAT ? F.out + (size_t)grow * D : (float*)(F.ws + WS_XSC) + (size_t)(grow - MLAT) * D; }
struct SchedF {
    pg8::TileOrder T; const char* A; const char* B; int nt;
    __device__ __forceinline__ bool next(int i, pg8::Unit& u) const { int tm, tn; if (!T.tile(i, tm, tn)) return false;
        u.a = A + (size_t)tm * 256 * D * 2; u.b = B + (size_t)tn * 256 * D * 2; u.nt = nt; u.pm = tm; u.pn = tn; u.kind = 0; return true; }
};
struct EpiOut {
    Ctx F; int l;
    __device__ __forceinline__ void operator()(const f32x4 (&acc)[2][2][4][2], const pg8::Unit& u, int wr, int wc, int fr, int fq) const {
        int row = u.pm * 256 + wr * 64 + fr; const int c0 = u.pn * 256 + wc * 32 + 8 * fq;
#pragma unroll
        for (int ai = 0; ai < 2; ++ai) {
#pragma unroll
            for (int m = 0; m < 4; ++m) { float* so = stream_row(F, row) + c0;
                const float* xi = (l == 0) ? (row < MLAT ? F.in[I_X] + (size_t)row * D : F.in[I_CTX] + (size_t)(row - MLAT) * D) + c0 : so;
                const float* gt = mod_ptr(F, l, mod_slot(row)) + 2048 + c0;
#pragma unroll
                for (int bj = 0; bj < 2; ++bj)
#pragma unroll
                    for (int n = 0; n < 2; ++n) { const int c = bj * 128 + 4 * n;
                        const f32x4 x = *(const f32x4*)(xi + c), g = *(const f32x4*)(gt + c);
                        *(f32x4*)(so + c) = x * ALPHA + g * acc[ai][bj][m][n]; }
                row += 16; asm volatile("" : "+v"(row) :: "memory"); }
            row += 64; }
    }
};
__device__ __forceinline__ void phaseF(Ctx& F, int l) {
    SchedF S; S.T.init((l < DEPTH - 1 ? MROWS : MLAT) / 256, 4, F.G, F.bid); S.A = (const char*)(F.ws + R_ACC); S.B = (const char*)(F.ws + WS_WOUT); S.nt = 16;
    EpiOut E{F, l};
    pg8::gemm_phase<EpiOut, SchedF>(F.lds, F.wave, D, D, S, E);
}
__device__ __forceinline__ void ln_row(f32x4 (&v)[4], const float* g, const float* b, int lane) {
    float s = 0.f;
#pragma unroll
    for (int j = 0; j < 4; ++j) s += (v[j].x + v[j].y) + (v[j].z + v[j].w);
    const float mean = wave_sum(s) * (1.f / D); float s2 = 0.f;
#pragma unroll
    for (int j = 0; j < 4; ++j) { v[j] = v[j] - mean; s2 += (v[j].x * v[j].x + v[j].y * v[j].y) + (v[j].z * v[j].z + v[j].w * v[j].w); }
    const float rstd = __builtin_amdgcn_rsqf(wave_sum(s2) * (1.f / D) + LN_EPS);
#pragma unroll
    for (int j = 0; j < 4; ++j) { const int c = j * 256 + lane * 4; v[j] = v[j] * rstd * *(const f32x4*)(g + c) + *(const f32x4*)(b + c); }
}
__device__ __forceinline__ void phaseF2(Ctx& F, int l) {
    const int gw = F.bid * NWAVES + F.wave, NGW = F.G * NWAVES; const int nrows = l < DEPTH - 1 ? MROWS : MLAT;
    bf16_t* hmod = (bf16_t*)(F.ws + WS_XMOD);
    for (int r = gw; r < nrows; r += NGW) {
        float* so = stream_row(F, r); const float* md = mod_ptr(F, l, mod_slot(r));
        f32x4 v[4];
#pragma unroll
        for (int j = 0; j < 4; ++j) v[j] = *(const f32x4*)(so + j * 256 + F.lane * 4);
        ln_row(v, F.in[I_LN1G] + l * D, F.in[I_LN1B] + l * D, F.lane);
#pragma unroll
        for (int j = 0; j < 4; ++j) { const int c = j * 256 + F.lane * 4; *(f32x4*)(so + c) = v[j];
            const f32x4 sh = *(const f32x4*)(md + 3072 + c), sc = *(const f32x4*)(md + 4096 + c);
            u32x2 o; o.x = pk2(v[j].x * (1.f + sc.x) + sh.x, v[j].y * (1.f + sc.y) + sh.y); o.y = pk2(v[j].z * (1.f + sc.z) + sh.z, v[j].w * (1.f + sc.w) + sh.w);
            *(u32x2*)(hmod + (size_t)r * D + c) = o; }
    }
}

struct EpiScores {
    _Float16* SC;
    __device__ __forceinline__ void operator()(const f32x4 (&acc)[2][2][4][2], const pg8::Unit& u, int wr, int wc, int fr, int fq) const {
        OPAQUE_ZERO(z0); _Float16* sp = SC + z0 + (size_t)(u.pm * 256 + wr * 64 + fr) * 2048 + u.pn * 256 + wc * 32 + 8 * fq;
#pragma unroll
        for (int ai = 0; ai < 2; ++ai) {
#pragma unroll
            for (int m = 0; m < 4; ++m) {
#pragma unroll
                for (int bj = 0; bj < 2; ++bj) { const f32x4 v0 = acc[ai][bj][m][0], v1 = acc[ai][bj][m][1];
                    *(u32x4*)(sp + bj * 128) = (u32x4){pkh2(v0[0], v0[1]), pkh2(v0[2], v0[3]), pkh2(v1[0], v1[1]), pkh2(v1[2], v1[3])}; }
                sp += 16 * 2048; asm volatile("" : "+v"(sp) :: "memory"); }
            sp += 64 * 2048; }
    }
};
__device__ __forceinline__ void phaseG(Ctx& F, int l) {
    SchedF S; S.T.init((l < DEPTH - 1 ? MROWS : MLAT) / 256, 8, F.G, F.bid); S.A = (const char*)(F.ws + WS_XMOD); S.B = (const char*)(F.ws + WS_WPK); S.nt = 16;
    EpiScores E{(_Float16*)(F.ws + WS_SC)};
    pg8::gemm_phase<EpiScores, SchedF>(F.lds, F.wave, D, D, S, E);
}

__device__ __forceinline__ unsigned fkey(float f) { const unsigned u = __float_as_uint(f); return (u & 0x80000000u) ? ~u : (u | 0x80000000u); }
__device__ __forceinline__ float kval(unsigned k) { const unsigned u = (k & 0x80000000u) ? (k & 0x7fffffffu) : ~k; return __uint_as_float(u); }
__device__ __forceinline__ void ce_desc(unsigned& a, unsigned& b) { const unsigned hi_ = a > b ? a : b, lo_ = a > b ? b : a; a = hi_; b = lo_; }
__device__ __forceinline__ void bitonic_merge16(unsigned (&a)[16]) {
#pragma unroll
    for (int j = 8; j > 0; j >>= 1) {
#pragma unroll
        for (int i = 0; i < 16; ++i) { const int l_ = i ^ j; if (l_ > i) ce_desc(a[i], a[l_]); } }
}
__device__ __forceinline__ void sort16_desc(unsigned (&a)[16]) {
#pragma unroll
    for (int k = 2; k <= 16; k <<= 1) {
#pragma unroll
        for (int j = k >> 1; j > 0; j >>= 1) {
#pragma unroll
            for (int i = 0; i < 16; ++i) { const int l_ = i ^ j; if (l_ > i) { if ((i & k) == 0) ce_desc(a[i], a[l_]); else ce_desc(a[l_], a[i]); } } } }
}
constexpr int ST_I[50] = {0,0,0,0,0,0,0,0,0,0,0,0,0,0,0,0, 1,1,1,1,1,1,1,1, 2,2,2,2,2, 3,3,3,3, 4,4,4, 5,5, 6,6, 7,7, 8, 9, 10, 11, 12, 13, 14, 15};
constexpr int ST_J[50] = {0,1,2,3,4,5,6,7,8,9,10,11,12,13,14,15, 0,1,2,3,4,5,6,7, 0,1,2,3,4, 0,1,2,3, 0,1,2, 0,1, 0,1, 0,1, 0, 0, 0, 0, 0, 0, 0, 0};
__device__ __forceinline__ unsigned fp6_code(float x) {
    const float a = fminf(fabsf(x), 7.5f);
    int e = (int)((__float_as_uint(a) >> 23) & 0xffu) - 127; e = e < 0 ? 0 : e;
    const unsigned q = (unsigned)(int)__builtin_rintf(__builtin_ldexpf(a, 3 - e));
    return (q + ((unsigned)e << 3)) | ((__float_as_uint(x) >> 26) & 32u);
}
__device__ __forceinline__ void phaseH(Ctx& F, int l) {
    const int gt = F.bid * NTHREADS + F.tid, NGT = F.G * NTHREADS; const int nrows = l < DEPTH - 1 ? MROWS : MLAT;
    { const float* pu = F.in[I_PU] + (size_t)l * 16384 * 1024; const float* pv = F.in[I_PV] + (size_t)l * 16384 * 1024; unsigned char* tu = F.ws + WS_TU;
      for (int task = gt; task < 16384 * 64; task += NGT) { const int c8 = task & 7, sl = (task >> 3) & 3, part = (task >> 5) & 1, e = task >> 6;
          const float* s = (part ? pv : pu) + (size_t)e * 1024 + 256 * sl + 4 * c8; const float sc = part ? PEER_SV : PEER_SU;
          unsigned dw[6];
#pragma unroll
          for (int hf = 0; hf < 2; ++hf) { unsigned c[16];
#pragma unroll
              for (int j = 0; j < 4; ++j) { const f32x4 a = *(const f32x4*)(s + 32 * (4 * hf + j)) * sc;
#pragma unroll
                  for (int k = 0; k < 4; ++k) c[4 * j + k] = fp6_code(a[k]); }
              dw[3 * hf] = c[0] | (c[1] << 6) | (c[2] << 12) | (c[3] << 18) | (c[4] << 24) | (c[5] << 30);
              dw[3 * hf + 1] = (c[5] >> 2) | (c[6] << 4) | (c[7] << 10) | (c[8] << 16) | (c[9] << 22) | (c[10] << 28);
              dw[3 * hf + 2] = (c[10] >> 4) | (c[11] << 2) | (c[12] << 8) | (c[13] << 14) | (c[14] << 20) | (c[15] << 26); }
          unsigned char* row = tu + (size_t)part * PEER_TBL + (size_t)sl * PEER_SLICE + (size_t)e * 192;
          *(u32x4*)(row + c8 * 16) = (u32x4){dw[0], dw[1], dw[2], dw[3]};
          *(u32x2*)(row + 128 + c8 * 8) = (u32x2){dw[4], dw[5]}; } }
    const _Float16* SC = (const _Float16*)(F.ws + WS_SC); int* IDX = (int*)(F.ws + WS_IDX); float* WGT = (float*)(F.ws + WS_WGT);
    LAS float* stg = (LAS float*)(F.lds + 65536);
    const int tid = F.tid;
    __syncthreads();
    for (int base = F.bid * NTHREADS; base < nrows * 16; base += NGT) {
        const int task = base + tid, row = task >> 4, g = task & 15;
        const _Float16* src = SC + (size_t)base * 128;
        sh4 pre[4];
#pragma unroll
        for (int i = 0; i < 4; ++i) { const int idx = i * 512 + tid; pre[i] = *(const sh4*)(src + (size_t)(idx >> 2) * 128 + (idx & 3) * 4); }
        unsigned t[16];
#pragma unroll
        for (int ps = 0; ps < 8; ++ps) {
            LAS float* sb = stg + (ps & 1) * (512 * 17);
#pragma unroll
            for (int i = 0; i < 4; ++i) { const int idx = i * 512 + tid; LAS float* d = sb + (idx >> 2) * 17 + (idx & 3) * 4; d[0] = (float)pre[i][0]; d[1] = (float)pre[i][1]; d[2] = (float)pre[i][2]; d[3] = (float)pre[i][3]; }
            if (ps + 1 < 8) {
#pragma unroll
                for (int i = 0; i < 4; ++i) { const int idx = i * 512 + tid; pre[i] = *(const sh4*)(src + (size_t)(idx >> 2) * 128 + (ps + 1) * 16 + (idx & 3) * 4); } }
            LDS_BARRIER();
            unsigned b[16];
#pragma unroll
            for (int k = 0; k < 16; ++k) b[k] = (fkey(sb[tid * 17 + k]) & ~127u) | (unsigned)(127 - (ps * 16 + k));
            sort16_desc(b);
            if (ps == 0) {
#pragma unroll
                for (int k = 0; k < 16; ++k) t[k] = b[k]; }
            else {
#pragma unroll
                for (int k = 0; k < 16; ++k) t[k] = t[k] > b[15 - k] ? t[k] : b[15 - k];
                bitonic_merge16(t); }
        }
        unsigned o[16];
#pragma unroll
        for (int i = 0; i < 16; ++i) o[i] = dpp_u<0xB1>(t[i]);
        const bool odd = g & 1; const unsigned omask = odd ? 0xffffffffu : 0u;
        float v1[16], v2[16];
        LAS int* L1 = (LAS int*)F.lds + F.tid; LAS int* L2 = L1 + 16 * 512;
#pragma unroll
        for (int i = 0; i < 16; ++i) { const unsigned dx = (t[i] ^ o[i]) & omask; const unsigned a = t[i] ^ dx, b = o[i] ^ dx;
            v1[i] = kval(a & ~127u); v2[i] = kval(b & ~127u); L1[i * 512] = 127 - (int)(a & 127u); L2[i * 512] = 127 - (int)(b & 127u); }
        unsigned bk[16];
#define STAIR_KEY(N) ((fkey(v1[ST_I[N]] + v2[ST_J[N]]) & ~255u) | (unsigned)(ST_I[N] * 16 + ST_J[N]))
#pragma unroll
        for (int k = 0; k < 16; ++k) bk[k] = STAIR_KEY(k);
        sort16_desc(bk);
#pragma unroll
        for (int blk = 1; blk < 3; ++blk) { unsigned b[16];
#pragma unroll
            for (int k = 0; k < 16; ++k) b[k] = STAIR_KEY(16 * blk + k);
            sort16_desc(b);
#pragma unroll
            for (int k = 0; k < 16; ++k) bk[k] = bk[k] > b[15 - k] ? bk[k] : b[15 - k];
            bitonic_merge16(bk); }
#pragma unroll
        for (int n = 48; n < 50; ++n) { unsigned x = STAIR_KEY(n);
#pragma unroll
            for (int q = 0; q < 16; ++q) { const unsigned hi_ = bk[q] > x ? bk[q] : x; x = bk[q] > x ? x : bk[q]; bk[q] = hi_; } }
#undef STAIR_KEY
        float den = 0.f; float w[16]; const float smax = kval(bk[0] & ~255u);
#pragma unroll
        for (int q = 0; q < 16; ++q) { w[q] = __expf(kval(bk[q] & ~255u) - smax); den += w[q]; }
        const float inv = 1.0f / den;
        if (!odd) { const int h = g >> 1; int* io = IDX + (size_t)row * 128 + h * 16; float* wo = WGT + (size_t)row * 128 + h * 16;
#pragma unroll
            for (int q4 = 0; q4 < 4; ++q4) { int e[4];
#pragma unroll
                for (int j = 0; j < 4; ++j) { const unsigned k = bk[4 * q4 + j]; e[j] = L1[((k >> 4) & 15u) * 512] * 128 + L2[(k & 15u) * 512]; }
                *(int4*)(io + 4 * q4) = make_int4(e[0], e[1], e[2], e[3]);
                *(f32x4*)(wo + 4 * q4) = (f32x4){w[4 * q4] * inv, w[4 * q4 + 1] * inv, w[4 * q4 + 2] * inv, w[4 * q4 + 3] * inv}; } }
    }
}

__device__ __forceinline__ void unpack16(const u32x4 a, const u32x4 b, float (&v)[16]) {
    v[0] = bflo(a.x); v[1] = bfhi(a.x); v[2] = bflo(a.y); v[3] = bfhi(a.y); v[4] = bflo(a.z); v[5] = bfhi(a.z); v[6] = bflo(a.w); v[7] = bfhi(a.w);
    v[8] = bflo(b.x); v[9] = bfhi(b.x); v[10] = bflo(b.y); v[11] = bfhi(b.y); v[12] = bflo(b.z); v[13] = bfhi(b.z); v[14] = bflo(b.w); v[15] = bfhi(b.w); }
__device__ __forceinline__ f32x2 gelu_pk(f32x2 v) {
    const f32x2 av = __builtin_elementwise_abs(v), d = av * 0.2316418882f + 1.0f;
    f32x2 t; t.x = __builtin_amdgcn_rcpf(d.x); t.y = __builtin_amdgcn_rcpf(d.y);
    f32x2 q = t * 0.5307027145f + (-0.7265760135f); q = q * t + 0.7107068705f; q = q * t + (-0.142248368f); q = q * t + 0.127414796f; q = q * t;
    const f32x2 s = (v * v) * (-0.72134752044f);
    f32x2 e; e.x = __builtin_amdgcn_exp2f(s.x); e.y = __builtin_amdgcn_exp2f(s.y);
    const f32x2 m = v * (q * e), r = v - m;
    f32x2 o; o.x = v.x < 0.f ? m.x : r.x; o.y = v.y < 0.f ? m.y : r.y; return o;
}
typedef unsigned u32x6 __attribute__((ext_vector_type(6)));
typedef unsigned u32x16 __attribute__((ext_vector_type(16)));
typedef float f32x32 __attribute__((ext_vector_type(32)));
typedef __bf16 hbf16x32 __attribute__((ext_vector_type(32)));
typedef __bf16 hbf16x2 __attribute__((ext_vector_type(2)));
__device__ __forceinline__ float gelu1(float v) {
    const float av = fabsf(v), t = __builtin_amdgcn_rcpf(av * 0.2316418882f + 1.0f);
    float q = t * 0.5307027145f + (-0.7265760135f); q = q * t + 0.7107068705f; q = q * t + (-0.142248368f); q = q * t + 0.127414796f; q = q * t;
    const float e = __builtin_amdgcn_exp2f((v * v) * (-0.72134752044f));
    const float m = v * (q * e);
    return v < 0.f ? m : v - m;
}
__device__ __forceinline__ void grid_bar_in_phase(Ctx& F) {
    XcdBarrier b_; b_.bar = (unsigned*)(F.ws + WS_CTL) + CW_BAR; b_.x = xb_xcc_id(); b_.st = (volatile LAS unsigned*)(F.lds + MISC_OFF) + 8; xcd_barrier(b_, F.tid == 0);
}
__device__ __forceinline__ f32x4 ldbf4(const bf16_t* p) { const u32x2 w = *(const u32x2*)p; return (f32x4){bflo(w.x), bfhi(w.x), bflo(w.y), bfhi(w.y)}; }
__device__ __forceinline__ void phaseI(Ctx& F, int l) {
    const int gw = F.bid * NWAVES + F.wave, NGW = F.G * NWAVES, lane = F.lane; const int nrows = l < DEPTH - 1 ? MROWS : MLAT;
    const bf16_t* hmod = (const bf16_t*)(F.ws + WS_XMOD); const unsigned char* TUu = F.ws + WS_TU; const unsigned char* TUv = TUu + PEER_TBL;
    const int* IDX = (const int*)(F.ws + WS_IDX); const float* WGT = (const float*)(F.ws + WS_WGT);
    bf16_t* xmod = (bf16_t*)(F.ws + WS_XMOD); bf16_t* FFNB = (bf16_t*)(F.ws + WS_FFN);
    const int c8 = lane & 7, eg = lane >> 3; const bool lb0 = (lane & 1) != 0, lb1 = (lane & 2) != 0, lb2 = (lane & 4) != 0; const int il = (lb2 ? 4 : 0) + (lb0 ? 2 : 0) + (lb1 ? 1 : 0);
    LAS float* pre = (LAS float*)F.lds + F.wave * (17 * 128);
    const int ntok = (nrows - gw + NGW - 1) / NGW;
#define PI_LOADS(TB, QA, QB, ID) do { unsigned o_[8]; \
            _Pragma("unroll") for (int i = 0; i < 8; ++i) o_[i] = (unsigned)__builtin_amdgcn_ds_bpermute(4 * (8 * i + eg), (int)(ID)); \
            _Pragma("unroll") for (int i = 0; i < 8; ++i) { QA[i] = *(const u32x4*)(TB + (o_[i] + (unsigned)c8 * 16u)); QB[i] = *(const u32x2*)(TB + (o_[i] + (unsigned)c8 * 8u) + 128); } \
            __builtin_amdgcn_sched_barrier(0); } while (0)
    for (int sl = 0; sl < 4; ++sl) {
        const unsigned char* tb = TUu + (size_t)sl * PEER_SLICE;
        unsigned hh[16], hhn[16];
        unsigned id0, id1, id0n = 0u, id1n = 0u;
#define PI_META_U(R, H, I0, I1) do { const bf16_t* hp = hmod + (size_t)(R) * D + 256 * sl + 4 * c8; \
            _Pragma("unroll") for (int j = 0; j < 8; ++j) { const u32x2 w = *(const u32x2*)(hp + 32 * j); H[2 * j] = w.x; H[2 * j + 1] = w.y; } \
            I0 = (unsigned)IDX[(size_t)(R) * 128 + lane] * 192u; I1 = (unsigned)IDX[(size_t)(R) * 128 + 64 + lane] * 192u; } while (0)
#define PI_CONSUME_U(QA, QB, KEEP) do { float t_[8]; \
            _Pragma("unroll") for (int i = 0; i < 8; ++i) { \
                const u32x6 u6 = {QA[i].x, QA[i].y, QA[i].z, QA[i].w, QB[i].x, QB[i].y}; \
                const hbf16x32 ub = __builtin_amdgcn_cvt_scalef32_pk32_bf16_fp6(u6, 1.0f); \
                float q_[4] = {0.f, 0.f, 0.f, 0.f};        \
                _Pragma("unroll") for (int m = 0; m < 16; ++m) { hbf16x2 a_; a_[0] = ub[2 * m]; a_[1] = ub[2 * m + 1]; q_[m & 3] = __builtin_amdgcn_fdot2_f32_bf16(a_, __builtin_bit_cast(hbf16x2, hh[m]), q_[m & 3], false); } \
                t_[i] = (q_[0] + q_[1]) + (q_[2] + q_[3]); __builtin_amdgcn_sched_barrier(0); } \
              \
            float a_[4]; _Pragma("unroll") for (int k = 0; k < 4; ++k) { const float kp = lb2 ? t_[4 + k] : t_[k], sd = lb2 ? t_[k] : t_[4 + k]; a_[k] = kp + dpp_f<0x141>(sd); } \
            float b_[2]; _Pragma("unroll") for (int k = 0; k < 2; ++k) { const float kp = lb0 ? a_[2 + k] : a_[k], sd = lb0 ? a_[k] : a_[2 + k]; b_[k] = kp + dpp_f<0xB1>(sd); } \
            { const float kp = lb1 ? b_[1] : b_[0], sd = lb1 ? b_[0] : b_[1]; KEEP = kp + dpp_f<0x4E>(sd); } } while (0)
        PI_META_U(gw, hh, id0, id1);
        u32x4 qaA[8], qaB[8]; u32x2 qbA[8], qbB[8];
        PI_LOADS(tb, qaA, qbA, id0);
        for (int kt = 0; kt < ntok; ++kt) {
            const bool has_next = kt + 1 < ntok;
            if (has_next) PI_META_U(gw + (kt + 1) * NGW, hhn, id0n, id1n);
            __builtin_amdgcn_sched_barrier(0);
            PI_LOADS(tb, qaB, qbB, id1);
            float ka, kb;
            PI_CONSUME_U(qaA, qbA, ka);
            if (has_next) PI_LOADS(tb, qaA, qbA, id0n);
            PI_CONSUME_U(qaB, qbB, kb);
            LAS float* pp = pre + kt * 128 + 8 * il + eg;
            if (sl == 0) { pp[0] = ka; pp[64] = kb; } else { pp[0] += ka; pp[64] += kb; }
            id0 = id0n; id1 = id1n;
#pragma unroll
            for (int m = 0; m < 16; ++m) hh[m] = hhn[m];
        }
#undef PI_META_U
#undef PI_CONSUME_U
    }
    { int kt = 0;
      for (int r = gw; r < nrows; r += NGW, ++kt) { LAS float* pp = pre + kt * 128 + lane;
          const float w0 = WGT[(size_t)r * 128 + lane], w1 = WGT[(size_t)r * 128 + 64 + lane];
          pp[0] = gelu1(pp[0] * (1.0f / PEER_SU)) * w0 * (1.0f / PEER_SV); pp[64] = gelu1(pp[64] * (1.0f / PEER_SU)) * w1 * (1.0f / PEER_SV); } }
    for (int sl = 0; sl < 4; ++sl) {
        const unsigned char* tb = TUv + (size_t)sl * PEER_SLICE;
        unsigned id0 = (unsigned)IDX[(size_t)gw * 128 + lane] * 192u, id1 = (unsigned)IDX[(size_t)gw * 128 + 64 + lane] * 192u, id0n = 0u, id1n = 0u;
        u32x4 qaA[8], qaB[8]; u32x2 qbA[8], qbB[8];
        PI_LOADS(tb, qaA, qbA, id0);
#define PI_ACC16(X) X(0) X(1) X(2) X(3) X(4) X(5) X(6) X(7) X(8) X(9) X(10) X(11) X(12) X(13) X(14) X(15)
#define PI_FMA(J) asm("v_pk_fma_f32 %0, %1, %2, %0" : "+v"(acc[J]) : "v"(__builtin_shufflevector(vf, vf, 2 * (J), 2 * (J) + 1)), "v"(cf2));
#define PI_CONSUME_V(QA, QB, CF) do { _Pragma("unroll") for (int i = 0; i < 8; ++i) { \
                const float cf = __uint_as_float((unsigned)__builtin_amdgcn_ds_bpermute(4 * (8 * i + eg), (int)__float_as_uint(CF))); \
                const u32x6 v6 = {QA[i].x, QA[i].y, QA[i].z, QA[i].w, QB[i].x, QB[i].y}; \
                const f32x32 vf = __builtin_amdgcn_cvt_scalef32_pk32_f32_fp6(v6, 1.0f); \
                const f32x2 cf2 = {cf, cf}; \
                PI_ACC16(PI_FMA) \
                __builtin_amdgcn_sched_barrier(0); } } while (0)
        for (int kt = 0; kt < ntok; ++kt) {
            const int r = gw + kt * NGW; const bool has_next = kt + 1 < ntok;
            if (has_next) { id0n = (unsigned)IDX[(size_t)(r + NGW) * 128 + lane] * 192u; id1n = (unsigned)IDX[(size_t)(r + NGW) * 128 + 64 + lane] * 192u; }
            const float cfa = pre[kt * 128 + lane], cfb = pre[kt * 128 + 64 + lane];
            __builtin_amdgcn_sched_barrier(0);
            PI_LOADS(tb, qaB, qbB, id1);
            f32x2 acc[16];
#pragma unroll
            for (int j = 0; j < 16; ++j) acc[j] = (f32x2){0.f, 0.f};
            PI_CONSUME_V(qaA, qbA, cfa);
            if (has_next) PI_LOADS(tb, qaA, qbA, id0n);
            PI_CONSUME_V(qaB, qbB, cfb);
            float h16[16];
            { const bool b3 = (lane & 8) != 0;
#pragma unroll
              for (int k = 0; k < 16; ++k) { const float lo_ = acc[k >> 1][k & 1], hi_ = acc[8 + (k >> 1)][k & 1]; const float keep = b3 ? hi_ : lo_, send = b3 ? lo_ : hi_;
                  h16[k] = keep + dpp_ror8(send); } }
            float h8[8];
#pragma unroll
            for (int k = 0; k < 8; ++k) { auto rr = __builtin_amdgcn_permlane16_swap(__float_as_uint(h16[k]), __float_as_uint(h16[8 + k]), false, false); h8[k] = __uint_as_float(rr[0]) + __uint_as_float(rr[1]); }
            float h4[4];
#pragma unroll
            for (int k = 0; k < 4; ++k) { auto rr = __builtin_amdgcn_permlane32_swap(__float_as_uint(h8[k]), __float_as_uint(h8[4 + k]), false, false); h4[k] = __uint_as_float(rr[0]) + __uint_as_float(rr[1]); }
            const int cb = 32 * (((lane >> 3) & 1) * 4 + ((lane >> 4) & 1) * 2 + ((lane >> 5) & 1)) + 4 * c8;
            if (sl < 3) *(u32x2*)(FFNB + (size_t)r * D + 256 * sl + cb) = (u32x2){pk2(h4[0], h4[1]), pk2(h4[2], h4[3])};
            else {
                float* so = stream_row(F, r) + cb; const float* md = mod_ptr(F, l, mod_slot(r)) + 5120 + cb; const bf16_t* ff = FFNB + (size_t)r * D + cb;
                float u[16]; float s = 0.f;
#pragma unroll
                for (int q = 0; q < 4; ++q) { const f32x4 x = *(const f32x4*)(so + 256 * q), g = *(const f32x4*)(md + 256 * q), a = q < 3 ? ldbf4(ff + 256 * q) : (f32x4){h4[0], h4[1], h4[2], h4[3]};
#pragma unroll
                    for (int j = 0; j < 4; ++j) { u[4 * q + j] = ALPHA * x[j] + g[j] * a[j]; s += u[4 * q + j]; } }
                const float mean = wave_sum(s) * (1.f / D); float s2 = 0.f;
#pragma unroll
                for (int j = 0; j < 16; ++j) { u[j] -= mean; s2 += u[j] * u[j]; }
                const float rstd = __builtin_amdgcn_rsqf(wave_sum(s2) * (1.f / D) + LN_EPS);
                const float* g2 = F.in[I_LN2G] + l * D + cb; const float* b2 = F.in[I_LN2B] + l * D + cb;
#pragma unroll
                for (int q = 0; q < 4; ++q) { const f32x4 gg = *(const f32x4*)(g2 + 256 * q), bb = *(const f32x4*)(b2 + 256 * q);
#pragma unroll
                    for (int j = 0; j < 4; ++j) u[4 * q + j] = u[4 * q + j] * rstd * gg[j] + bb[j];
                    *(f32x4*)(so + 256 * q) = (f32x4){u[4 * q], u[4 * q + 1], u[4 * q + 2], u[4 * q + 3]}; }
                if (l < DEPTH - 1) { const float* mn = mod_ptr(F, l + 1, mod_slot(r)) + cb; bf16_t* xp = xmod + (size_t)r * D + cb;
#pragma unroll
                    for (int q = 0; q < 4; ++q) { const f32x4 sc = *(const f32x4*)(mn + 1024 + 256 * q), sh = *(const f32x4*)(mn + 256 * q);
                        *(u32x2*)(xp + 256 * q) = (u32x2){pk2(u[4 * q] * (1.f + sc[0]) + sh[0], u[4 * q + 1] * (1.f + sc[1]) + sh[1]), pk2(u[4 * q + 2] * (1.f + sc[2]) + sh[2], u[4 * q + 3] * (1.f + sc[3]) + sh[3])}; } }
            }
            id0 = id0n; id1 = id1n;
        }
#undef PI_CONSUME_V
#undef PI_FMA
#undef PI_ACC16
    }
#undef PI_LOADS
}

enum { PH_PRO = 0, PH_PRO2, PH_XMOD0, PH_WCONV, PH_A, PH_B0, PH_B1, PH_C, PH_D, PH_E, PH_F, PH_F2, PH_G, PH_H, PH_I, PH_COUNT };
__device__ __forceinline__ Ctx make_ctx(const Args& a, unsigned char* lds, int wave0) {
    Ctx F; F.lds = (LAS unsigned char*)lds;
    int lane; asm volatile("v_mbcnt_lo_u32_b32 %0, -1, 0\n\tv_mbcnt_hi_u32_b32 %0, -1, %0" : "=v"(lane));
    OPAQUE_ZERO(z);
    F.lane = lane; F.wave = wave0 + (int)z; F.tid = F.wave * 64 + lane; F.G = gridDim.x; F.bid = (int)blockIdx.x + (int)z;
    F.in = a.in + z; F.out = a.out + z; F.ws = a.ws + z; return F;
}
__global__ void __launch_bounds__(NTHREADS, 2) __attribute__((amdgpu_waves_per_eu(2, 2))) k_all(Args a) {
    extern __shared__ __attribute__((aligned(16))) unsigned char lds[];
    const int wave0 = __builtin_amdgcn_readfirstlane((int)threadIdx.x >> 6);
    volatile LAS unsigned* MISC = (volatile LAS unsigned*)((LAS unsigned char*)lds + MISC_OFF);
    if (threadIdx.x < 64) MISC[threadIdx.x] = 0u;
    __syncthreads();
    (void)xcd_barrier_post((unsigned*)(a.ws + WS_CTL) + CW_BAR, MISC + 8);
#define GRID_BAR() do { XcdBarrier b_; b_.bar = (unsigned*)(a.ws + WS_CTL) + CW_BAR; b_.x = xb_xcc_id(); b_.st = (volatile LAS unsigned*)((LAS unsigned char*)lds + MISC_OFF) + 8; int ln_; asm volatile("v_mbcnt_lo_u32_b32 %0, -1, 0\n\tv_mbcnt_hi_u32_b32 %0, -1, %0" : "=v"(ln_)); xcd_barrier(b_, wave0 == 0 && ln_ == 0); } while (0)
#define PH(call) do { Ctx F = make_ctx(a, lds, wave0); call; } while (0)
    PH(pro_phase(F)); PH(wconv_phase(F, 0)); GRID_BAR();
    if (PROBE_REP & 512) { PH(pro_phase(F)); PH(wconv_phase(F, 0)); GRID_BAR(); }
    PH(pro2_phase(F)); GRID_BAR();
    PH(xmod0_phase(F)); GRID_BAR();
#define MIXER(l, hb) \
            PH(phaseA(F, hb)); GRID_BAR(); \
            PH(phaseB0(F, l, hb)); GRID_BAR(); \
            PH(phaseB1q(F, l)); PH(phaseB1k(F, l)); PH(phaseB1v(F, l)); GRID_BAR(); \
            PH(phaseC(F, l, hb, 0)); GRID_BAR(); \
            if (PROBE_REP & 2) { PH(phaseC(F, l, hb, 1)); GRID_BAR(); } \
            if (hb == 0) { PH(phaseD(F, l)); GRID_BAR(); }
#define LAYER(l) \
        MIXER(l, 0) MIXER(l, 1) \
        PH(phaseE(F, l)); GRID_BAR(); \
        if (PROBE_REP & 8) { PH(phaseE(F, l)); GRID_BAR(); } \
        if (l + 1 < DEPTH) { PH(phaseE2(F)); GRID_BAR(); } \
        PH(phaseF(F, l)); GRID_BAR(); \
        PH(phaseF2(F, l)); GRID_BAR(); \
        PH(phaseG(F, l)); GRID_BAR(); \
        if (PROBE_REP & 16) { PH(phaseG(F, l)); GRID_BAR(); } \
        if (PROBE_REP & 64) { PH(phaseH(F, l)); GRID_BAR(); } \
        PH(phaseH(F, l)); __syncthreads(); if (l + 1 < DEPTH) PH(wconv_phase(F, l + 1)); GRID_BAR(); \
        PH(phaseI(F, l)); if (l + 1 < DEPTH) GRID_BAR();
    LAYER(0) LAYER(1)
#undef LAYER
#undef MIXER
#undef PH
#undef GRID_BAR
}

extern "C" void kernel_launch(void* const* d_in, const int* in_sizes, int n_in, void* d_out, int out_size, void* d_ws, size_t ws_size, hipStream_t stream) {
    if (n_in != 35 || ws_size < WS_END) { fprintf(stderr, "kernel_launch: need 35 inputs and >= %zu B of workspace (got %d, %zu)\n", (size_t)WS_END, n_in, ws_size); return; }
    static int grid = 0;
    if (!grid) {
        int dev = 0, cus = 0, per_cu = 0;
        (void)hipGetDevice(&dev); (void)hipDeviceGetAttribute(&cus, hipDeviceAttributeMultiprocessorCount, dev);
        (void)hipFuncSetAttribute((const void*)k_all, hipFuncAttributeMaxDynamicSharedMemorySize, LDS_BYTES);
        if (hipOccupancyMaxActiveBlocksPerMultiprocessor(&per_cu, (const void*)k_all, NTHREADS, LDS_BYTES) != hipSuccess || per_cu < 1) fprintf(stderr, "kernel_launch: occupancy query says %d blocks per CU\n", per_cu);
        (void)hipGetLastError();
        grid = 256;
        if (cus != 256) fprintf(stderr, "kernel_launch: note: built for a 256-CU device, this one reports %d CUs\n", cus);
    }
    (void)hipMemsetAsync((char*)d_ws + WS_CTL, 0, CTL_BYTES, stream);
    Args a{};
    for (int i = 0; i < 35; ++i) a.in[i] = (const float*)d_in[i];
    a.out = (float*)d_out; a.ws = (unsigned char*)d_ws;
    hipLaunchKernelGGL(k_all, dim3(grid), dim3(NTHREADS), LDS_BYTES, stream, a);
}
```

```cpp
#include <hip/hip_runtime.h>
#include <cstdio>
#include <cstdint>

#define LAS __attribute__((address_space(3)))
#define GAS __attribute__((address_space(1)))
typedef unsigned short bf16_t;
typedef short bf16x8 __attribute__((ext_vector_type(8)));
typedef float f32x2 __attribute__((ext_vector_type(2)));
typedef float f32x4 __attribute__((ext_vector_type(4)));
typedef float f32x16 __attribute__((ext_vector_type(16)));
typedef unsigned u32x2 __attribute__((ext_vector_type(2)));
typedef unsigned u32x4 __attribute__((ext_vector_type(4)));

#define PROBE_REP 0
constexpr int D = 1024, BATCH = 8, SEQ = 4096, CTX = 256, LTOT = SEQ + CTX, DEPTH = 2;
constexpr int MLAT = BATCH * SEQ, MCTX = BATCH * CTX, MROWS = MLAT + MCTX;
constexpr int NB = 4, NHALF = BATCH / NB;
constexpr int ML = NB * LTOT;
constexpr int MLL = NB * SEQ;
constexpr int IN_W = 7968;
constexpr float LN_EPS = 1e-5f, RMS_EPS = 1e-6f, GN_EPS = 64e-5f;
constexpr float ALPHA = 1.4142135623730951f;
constexpr float LOG2E = 1.4426950408889634f;
constexpr float MLA_QS = 0.10206207261596577f * LOG2E;
constexpr float HD_QS = 0.125f * LOG2E;

constexpr size_t MiB = 1u << 20;
constexpr size_t WS_CTL = 0, CTL_BYTES = 1 * MiB;
constexpr size_t WS_MOD = 1 * MiB;
constexpr size_t WS_ROPE = WS_MOD + 512 * 1024;
constexpr size_t WS_LORA = 3 * MiB;
constexpr size_t WS_BON = 4 * MiB;
constexpr size_t WS_RS = 6 * MiB + 512 * 1024;
constexpr size_t WS_WUQ = 7 * MiB;
constexpr size_t WS_WUKV = 8 * MiB;
constexpr size_t WS_WIN = 9 * MiB;
constexpr size_t WS_WBR = 25 * MiB;
constexpr size_t WS_WOUT = 29 * MiB;
constexpr size_t WS_WPK = 31 * MiB;
constexpr size_t WS_XSC = 35 * MiB;
constexpr size_t WS_XMOD = 43 * MiB;
constexpr size_t WS_Y01 = 111 * MiB;
constexpr size_t WS_Y23 = 179 * MiB;
constexpr size_t WS_R = 247 * MiB;
constexpr size_t R_PR = WS_R;
constexpr size_t R_OB = R_PR + (size_t)MROWS * 2048 * 2;
constexpr size_t R_PM = R_OB;
constexpr size_t R_VC = R_PM + (size_t)ML * 512 * 2;
constexpr size_t R_VD = R_VC + (size_t)ML * 128 * 2;
static_assert(R_VD + (size_t)ML * 128 * 2 <= R_OB + (size_t)MROWS * 512 * 2, "Pm/Vc/Vd overlay OB");
constexpr size_t R_QA = R_OB + (size_t)MROWS * 512 * 2;
constexpr size_t R_KA = R_QA + (size_t)ML * 768 * 2;
constexpr size_t R_VAT = R_KA + (size_t)ML * 768 * 2;
constexpr size_t R_QC = R_VAT + (size_t)ML * 512 * 2;
constexpr size_t R_KC = R_QC + (size_t)ML * 512 * 2;
constexpr size_t R_VCT = R_KC + (size_t)ML * 128 * 2;
constexpr size_t R_QD = R_VCT + (size_t)ML * 128 * 2;
constexpr size_t R_KD = R_QD + (size_t)ML * 512 * 2;
constexpr size_t R_VDT = R_KD + (size_t)ML * 128 * 2;
constexpr size_t R_END = R_VDT + (size_t)ML * 128 * 2;
constexpr size_t WS_MODP = WS_R + 250 * MiB;
constexpr size_t WS_END = 539 * MiB;
static_assert(R_END <= WS_END && WS_MODP + 2 * 16 * 9 * 6144 * 4 <= WS_END, "ws map");
constexpr size_t R_ESCR = WS_R, ESCR_PER_BLOCK = 384 * 1024;
constexpr size_t WS_SC = WS_Y01;
constexpr size_t WS_TU = WS_SC + (size_t)MROWS * 2048 * 4;
constexpr size_t WS_TV = WS_TU + (size_t)16384 * 1024;
constexpr size_t WS_IDX = WS_TV + (size_t)16384 * 1024;
constexpr size_t PEER_TBL = (size_t)16384 * 768;
constexpr size_t PEER_SLICE = (size_t)16384 * 192;
constexpr size_t WS_FFN = WS_SC;
constexpr float PEER_SU = 64.f, PEER_SV = 4.f;
constexpr size_t WS_WGT = WS_IDX + (size_t)MROWS * 128 * 4;
static_assert(WS_WGT + (size_t)MROWS * 128 * 4 <= WS_END, "ws map peer");
constexpr int CW_QUEUE = 64;
constexpr int CW_BAR = 4096;

__device__ __forceinline__ unsigned f2bf(float f) { unsigned u = __builtin_bit_cast(unsigned, f); return (u + 0x7fffu + ((u >> 16) & 1u)) >> 16; }
__device__ __forceinline__ unsigned pk2(float lo, float hi) { unsigned r; asm("v_cvt_pk_bf16_f32 %0, %1, %2" : "=v"(r) : "v"(lo), "v"(hi)); return r; }
__device__ __forceinline__ float bf2f(unsigned h) { return __builtin_bit_cast(float, h << 16); }
__device__ __forceinline__ float bflo(unsigned w) { return __builtin_bit_cast(float, w << 16); }
__device__ __forceinline__ float bfhi(unsigned w) { return __builtin_bit_cast(float, w & 0xffff0000u); }
template <int CTRL> __device__ __forceinline__ float dpp_f(float v) { return __builtin_bit_cast(float, __builtin_amdgcn_update_dpp(0, __builtin_bit_cast(int, v), CTRL, 0xf, 0xf, true)); }
template <int CTRL> __device__ __forceinline__ unsigned dpp_u(unsigned v) { return (unsigned)__builtin_amdgcn_update_dpp(0, (int)v, CTRL, 0xf, 0xf, true); }
__device__ __forceinline__ float swap16_sum(float v) { auto r = __builtin_amdgcn_permlane16_swap(__float_as_uint(v), __float_as_uint(v), false, false); return __uint_as_float(r[0]) + __uint_as_float(r[1]); }
__device__ __forceinline__ float swap32_sum(float v) { auto r = __builtin_amdgcn_permlane32_swap(__float_as_uint(v), __float_as_uint(v), false, false); return __uint_as_float(r[0]) + __uint_as_float(r[1]); }
__device__ __forceinline__ float group8_sum(float v) { v += dpp_f<0xB1>(v); v += dpp_f<0x4E>(v); v += dpp_f<0x141>(v); return v; }
__device__ __forceinline__ float wave_sum(float v) { v = group8_sum(v); v += dpp_f<0x140>(v); v = swap16_sum(v); return swap32_sum(v); }
__device__ __forceinline__ float sigmoidf_(float x) { return __builtin_amdgcn_rcpf(1.0f + __expf(-x)); }
template <class T> __device__ __forceinline__ T* uniform_launder(T* p) {
    const unsigned long long v = (unsigned long long)p;
    unsigned lo = __builtin_amdgcn_readfirstlane((unsigned)v), hi = __builtin_amdgcn_readfirstlane((unsigned)(v >> 32));
    asm volatile("" : "+s"(lo), "+s"(hi));
    return (T*)(((unsigned long long)hi << 32) | lo);
}
#define OPAQUE_ZERO(z) size_t z; asm volatile("s_mov_b64 %0, 0" : "=s"(z))
#define LDS_WAIT() asm volatile("s_waitcnt lgkmcnt(0)" ::: "memory")
#define LDS_BARRIER() asm volatile("s_waitcnt lgkmcnt(0)\n\ts_barrier" ::: "memory")
#define VM_WAIT() asm volatile("s_waitcnt vmcnt(0)" ::: "memory")

#define XB_TMO      128
#define XB_XCNT(j)  (256  + 64 * (j))
#define XB_XSUB(j)  (1280 + 64 * (j))
#define XB_XGEN(j)  (2304 + 64 * (j))
#define XB_TOP      3328
#define XB_TOPGEN   3392
#define XCD_BAR_WORDS 3456
#define XB_SPIN_CAP (1u << 22)
__device__ __forceinline__ unsigned xb_ld(unsigned* p)              { return __hip_atomic_load(p, __ATOMIC_RELAXED, __HIP_MEMORY_SCOPE_AGENT); }
__device__ __forceinline__ unsigned xb_add(unsigned* p, unsigned v) { return __hip_atomic_fetch_add(p, v, __ATOMIC_RELAXED, __HIP_MEMORY_SCOPE_AGENT); }
__device__ __forceinline__ unsigned xb_xcc_id() { return (unsigned)__builtin_amdgcn_s_getreg((3 << 11) | 20) & 0xFu; }
#define XB_SPIN(cond, bar) do { unsigned _sp = 0; while (cond) { __builtin_amdgcn_s_sleep(1); \
    if ((++_sp & 255u) == 0u) { if (xb_ld(&(bar)[XB_TMO])) break; if (_sp > XB_SPIN_CAP) { atomicAdd(&(bar)[XB_TMO], 1u); break; } } } } while (0)
struct XcdBarrier { unsigned* bar; unsigned x; volatile LAS unsigned* st; };
__device__ __forceinline__ XcdBarrier xcd_barrier_post(unsigned* bar, volatile LAS unsigned* st) {
    XcdBarrier b; b.bar = bar; b.x = xb_xcc_id(); b.st = st;
    if (threadIdx.x == 0) (void)xb_add(&bar[XB_XCNT(b.x)], 1u);
    return b;
}
__device__ __forceinline__ void xcd_barrier_complete(unsigned* bar, unsigned x, unsigned& nloc, unsigned& nx) {
    const unsigned G = gridDim.x * gridDim.y * gridDim.z;
    unsigned sum, cnt, mine, sp = 0u;
    for (;;) {
        sum = 0u; cnt = 0u; mine = 0u;
#pragma unroll
        for (unsigned j = 0; j < 16; ++j) { const unsigned c = xb_ld(&bar[XB_XCNT(j)]); sum += c; cnt += (c > 0u) ? 1u : 0u; mine = (j == x) ? c : mine; }
        if (sum == G) break;
        __builtin_amdgcn_s_sleep(1);
        if ((++sp & 255u) == 0u) { if (xb_ld(&bar[XB_TMO])) break; if (sp > XB_SPIN_CAP) { atomicAdd(&bar[XB_TMO], 1u); break; } }
    }
    nloc = mine > 0u ? mine : 1u; nx = cnt > 0u ? cnt : 1u;
}
__device__ __forceinline__ void xcd_barrier(const XcdBarrier& b, const bool leader) {
    asm volatile("s_waitcnt vmcnt(0)" ::: "memory");
    __syncthreads();
    if (leader) {
        size_t z_; asm volatile("s_mov_b64 %0, 0" : "=s"(z_)); unsigned* bar = b.bar + z_;
        __builtin_amdgcn_s_waitcnt(0);
        unsigned nloc = b.st[0], nx = b.st[1];
        if (nloc == 0u) { xcd_barrier_complete(bar, b.x, nloc, nx); b.st[0] = nloc; b.st[1] = nx; }
        const unsigned old = xb_add(&bar[XB_XSUB(b.x)], 1u);
        const unsigned gen = old / nloc;
        if (old + 1u == (gen + 1u) * nloc) {
            __builtin_amdgcn_fence(__ATOMIC_RELEASE, "agent");
            asm volatile("s_waitcnt vmcnt(0)" ::: "memory");
            const unsigned og = xb_add(&bar[XB_TOP], 1u);
            const unsigned tg = og / nx;
            if (og + 1u == (tg + 1u) * nx) xb_add(&bar[XB_TOPGEN], 1u);
            else XB_SPIN(xb_ld(&bar[XB_TOPGEN]) == tg, bar);
            __builtin_amdgcn_fence(__ATOMIC_ACQUIRE, "agent");
            xb_add(&bar[XB_XGEN(b.x)], 1u);
            asm volatile("s_waitcnt vmcnt(0)" ::: "memory");
        } else {
            XB_SPIN(xb_ld(&bar[XB_XGEN(b.x)]) == gen, bar);
            __builtin_amdgcn_fence(__ATOMIC_ACQUIRE, "agent");
            asm volatile("s_waitcnt vmcnt(0)" ::: "memory");
        }
    }
    __syncthreads();
}

namespace pg8 {
constexpr int BM = 256, BK = 64, HALF = 128, HTB = HALF * BK * 2, STAGE_BYTES = 8 * HTB, NXCD = 8, WGM = 8;
__host__ __device__ __forceinline__ int lds_byte(int r, int c) { const int st = (r >> 4) * 2 + (c >> 5), rr = r & 15, cc = c & 31, ob = rr * 64 + cc * 2; return st * 1024 + (ob ^ (((ob >> 9) & 1) << 5)); }
__host__ __device__ __forceinline__ void stage_rc(int b, int& R, int& C) { const int st = b / 1024, sb = b % 1024, swz = sb ^ (((sb >> 9) & 1) << 5); R = (st >> 1) * 16 + swz / 64; C = (st & 1) * 32 + (swz % 64) / 2; }
__host__ __device__ __forceinline__ int perm32(int rho) { const int n = rho >> 4, i = rho & 15; return 8 * (i >> 2) + 4 * n + (i & 3); }

struct Unit { const char* a; const char* b; int nt; int pm, pn, kind; };

struct TileOrder {
    int nM, nN, nwg, G, c;
    __device__ void init(int nM_, int nN_, int G_, int c_) { nM = nM_; nN = nN_; nwg = nM * nN; G = G_; c = c_; }
    __device__ bool tile(int i, int& tm, int& tn) const { return tileL((long)i * G + c, tm, tn); }
    __device__ bool tileL(const long L, int& tm, int& tn) const {
        if (L < 0 || L >= nwg) return false;
        int wgid = (int)L; { const int q = nwg / NXCD, r = nwg % NXCD, xcd = wgid % NXCD, off = wgid / NXCD; wgid = (xcd < r ? xcd * (q + 1) : r * (q + 1) + (xcd - r) * q) + off; }
        const int nig = WGM * nN, gid = wgid / nig, fm = gid * WGM, gsz = (nM - fm) < WGM ? (nM - fm) : WGM;
        tm = fm + ((wgid % nig) % gsz); tn = (wgid % nig) / gsz; return true;
    }
};

__device__ __forceinline__ unsigned cvt_pk_bf16(float lo, float hi) { unsigned r; asm volatile("v_cvt_pk_bf16_f32 %0, %1, %2" : "=v"(r) : "v"(lo), "v"(hi)); return r; }

template <class Epi, class Sched>
__device__ __forceinline__ void gemm_phase(LAS unsigned char* lds, const int wave_id, const int lda, const int ldb, const Sched& S, const Epi& E) {
    int tid_; asm volatile("v_mbcnt_lo_u32_b32 %0, -1, 0\n\tv_mbcnt_hi_u32_b32 %0, -1, %0" : "=v"(tid_)); tid_ += wave_id * 64;
    const int tid = tid_, wid = __builtin_amdgcn_readfirstlane(tid >> 6), lane = tid & 63, wr = wid >> 2, wc = wid & 3, fr = lane & 15, fq = lane >> 4;
    unsigned voffA[2], voffB[2];
#pragma unroll
    for (int i = 0; i < 2; ++i) { int R, C; stage_rc(tid * 16 + i * 8192, R, C); const int Rb = (R & ~31) + perm32(R & 31);
        voffA[i] = (unsigned)(R * lda + C) * 2u; voffB[i] = (unsigned)(Rb * ldb + C) * 2u; }
    const size_t kstep = (size_t)(BK * 2);
    const size_t hstepA = (size_t)HALF * lda * 2, hstepB = (size_t)HALF * ldb * 2;
    const unsigned ldsw = (unsigned)wid * 1024u;
    const int aoff = lds_byte(wr * 64 + fr, fq * 8), boff = lds_byte(wc * 32 + fr, fq * 8);
#define PG8_SA(b, h) (((b) * 2 + (h)) * HTB)
#define PG8_SB(b, h) ((4 + (b) * 2 + (h)) * HTB)
#define PG8_STAGE(bufoff, gbase, voff) do { _Pragma("unroll") for (int _i = 0; _i < 2; ++_i) \
        __builtin_amdgcn_global_load_lds((const unsigned*)((const char*)(gbase) + (voff)[_i]), (LAS unsigned*)(lds + (bufoff) + ldsw + _i * 8192), 16, 0, 0); } while (0)
#define PG8_LDA(dst, b, h) do { _Pragma("unroll") for (int m = 0; m < 4; ++m) _Pragma("unroll") for (int k = 0; k < 2; ++k) dst[m][k] = *(const LAS bf16x8*)(lds + PG8_SA(b, h) + aoff + m * 2048 + k * 1024); } while (0)
#define PG8_LDB(dst, b, h) do { _Pragma("unroll") for (int n = 0; n < 2; ++n) _Pragma("unroll") for (int k = 0; k < 2; ++k) dst[n][k] = *(const LAS bf16x8*)(lds + PG8_SB(b, h) + boff + n * 2048 + k * 1024); } while (0)
#define PG8_MMA(ai, bj, At, Bt) do { __builtin_amdgcn_s_setprio(1); _Pragma("unroll") for (int m = 0; m < 4; ++m) _Pragma("unroll") for (int n = 0; n < 2; ++n) _Pragma("unroll") for (int k = 0; k < 2; ++k) \
        acc[ai][bj][m][n] = __builtin_amdgcn_mfma_f32_16x16x32_bf16(Bt[n][k], At[m][k], acc[ai][bj][m][n], 0, 0, 0); __builtin_amdgcn_s_setprio(0); } while (0)
#define PG8_WAIT_V(n) asm volatile("s_waitcnt vmcnt(" #n ")" ::: "memory")
#define PG8_WAIT_L(n) asm volatile("s_waitcnt lgkmcnt(" #n ")" ::: "memory")
#define PG8_BAR __builtin_amdgcn_s_barrier()
#define PG8_SCHED __builtin_amdgcn_sched_barrier(0)
    Unit cur, nxt; int ui = 0;
    if (!S.next(0, cur)) return;
    f32x4 acc[2][2][4][2];
#pragma unroll
    for (int a = 0; a < 2; ++a)
#pragma unroll
        for (int b = 0; b < 2; ++b)
#pragma unroll
            for (int m = 0; m < 4; ++m)
#pragma unroll
                for (int n = 0; n < 2; ++n) acc[a][b][m][n] = (f32x4){0.f, 0.f, 0.f, 0.f};
    bf16x8 At[4][2], B0[2][2], B1[2][2];
    const char* cA = cur.a; const char* cB = cur.b;
    PG8_STAGE(PG8_SB(0, 0), cB, voffB); PG8_STAGE(PG8_SB(0, 1), cB + hstepB, voffB); PG8_STAGE(PG8_SA(0, 0), cA, voffA); PG8_STAGE(PG8_SA(0, 1), cA + hstepA, voffA);
    if (wr == 1) PG8_BAR;
    PG8_WAIT_V(2); PG8_BAR;
    PG8_STAGE(PG8_SB(1, 0), cB + kstep, voffB); PG8_STAGE(PG8_SA(1, 0), cA + kstep, voffA); PG8_STAGE(PG8_SB(1, 1), cB + hstepB + kstep, voffB);
    PG8_WAIT_V(6); PG8_BAR;
    for (;;) {
        const bool has_next = S.next(ui + 1, nxt);
        const char* nA = has_next ? nxt.a : cA; const char* nB = has_next ? nxt.b : cB;
        const int nt = cur.nt;
        for (int t = 0; t < nt; t += 2) {
            const bool last = (t == nt - 2);
            const char* a1 = cA + (size_t)(t + 1) * kstep;
            const char* a2 = last ? nA : cA + (size_t)(t + 2) * kstep; const char* b2 = last ? nB : cB + (size_t)(t + 2) * kstep;
            const char* a3 = a2 + kstep; const char* b3 = b2 + kstep;
            PG8_LDB(B0, 0, 0); PG8_LDB(B1, 0, 1); PG8_SCHED; PG8_LDA(At, 0, 0); PG8_STAGE(PG8_SA(1, 1), a1 + hstepA, voffA);
            PG8_WAIT_V(8); PG8_WAIT_L(0); PG8_BAR; PG8_MMA(0, 0, At, B0); PG8_MMA(0, 1, At, B1); PG8_BAR; PG8_SCHED;
            PG8_LDA(At, 0, 1); PG8_STAGE(PG8_SB(0, 0), b2, voffB); PG8_STAGE(PG8_SB(0, 1), b2 + hstepB, voffB); PG8_STAGE(PG8_SA(0, 0), a2, voffA);
            PG8_WAIT_V(8); PG8_WAIT_L(0); PG8_BAR; PG8_MMA(1, 0, At, B0); PG8_MMA(1, 1, At, B1); PG8_BAR; PG8_SCHED;
            PG8_LDB(B0, 1, 0); PG8_LDB(B1, 1, 1); PG8_SCHED; PG8_LDA(At, 1, 0); PG8_STAGE(PG8_SA(0, 1), a2 + hstepA, voffA);
            PG8_WAIT_V(8); PG8_WAIT_L(0); PG8_BAR; PG8_MMA(0, 0, At, B0); PG8_MMA(0, 1, At, B1); PG8_BAR; PG8_SCHED;
            PG8_LDA(At, 1, 1); PG8_STAGE(PG8_SB(1, 0), b3, voffB); PG8_STAGE(PG8_SB(1, 1), b3 + hstepB, voffB); PG8_STAGE(PG8_SA(1, 0), a3, voffA);
            PG8_WAIT_V(8); PG8_WAIT_L(0); PG8_BAR; PG8_MMA(1, 0, At, B0); PG8_MMA(1, 1, At, B1); PG8_BAR; PG8_SCHED;
        }
        if (wr == 0) PG8_BAR;
        { int t2; asm volatile("v_mbcnt_lo_u32_b32 %0, -1, 0\n\tv_mbcnt_hi_u32_b32 %0, -1, %0" : "=v"(t2)); t2 += wave_id * 64;
          const int wid2 = __builtin_amdgcn_readfirstlane(t2 >> 6), lane2 = t2 & 63; E(acc, cur, wid2 >> 2, wid2 & 3, lane2 & 15, lane2 >> 4); }
        if (!has_next) break;
#pragma unroll
        for (int a = 0; a < 2; ++a)
#pragma unroll
            for (int b = 0; b < 2; ++b)
#pragma unroll
                for (int m = 0; m < 4; ++m)
#pragma unroll
                    for (int n = 0; n < 2; ++n) acc[a][b][m][n] = (f32x4){0.f, 0.f, 0.f, 0.f};
        cur = nxt; cA = nA; cB = nB; ++ui;
        if (wr == 1) PG8_BAR;
    }
    PG8_WAIT_V(0);
    PG8_BAR;
#undef PG8_SA
#undef PG8_SB
#undef PG8_STAGE
#undef PG8_LDA
#undef PG8_LDB
#undef PG8_MMA
#undef PG8_WAIT_V
#undef PG8_WAIT_L
#undef PG8_BAR
#undef PG8_SCHED
}
}

constexpr int NWAVES = 8, NTHREADS = 512;
constexpr int RING_BYTES = 131072;
constexpr int MISC_OFF = 147456 - 256;
constexpr int LDS_BYTES = 147456;

struct Args { const float* in[35]; float* out; unsigned char* ws; int ph_lo, ph_hi; };
enum { I_X = 0, I_C, I_CTX, I_CCTX, I_ADAW, I_ADAB, I_WIN, I_QNORM, I_KVNORM, I_WUQ, I_WUKV, I_MU, I_W0, I_W2, I_A0, I_A2, I_G2, I_KK, I_KA, I_RK, I_LNG, I_LNB,
       I_GQN, I_GKN, I_SINK, I_WBR, I_WOUT, I_LN1G, I_LN1B, I_PWQ, I_PKEYS, I_PU, I_PV, I_LN2G, I_LN2B };

struct Ctx {
    LAS unsigned char* lds;
    const float* const* in; float* out; unsigned char* ws;
    int tid, lane, wave, G, bid;
};

__device__ __forceinline__ void transpose_item(const float* W, int N, int k0, int nsrc0, bf16_t* WT, int ldo, int drow0, int dcol0, const float* ks, float sc, LAS float* scr, int lane) {
#pragma unroll 8
    for (int i = 0; i < 32; ++i) { const int kk = 2 * i + (lane >> 5);
        float v = 0.f; if (nsrc0 >= 0) { v = W[(size_t)(k0 + kk) * N + nsrc0 + (lane & 31)] * sc; if (ks) v *= ks[k0 + kk]; }
        scr[kk * 33 + (lane & 31)] = v; }
    LDS_WAIT(); asm volatile("" ::: "memory");
    const int c = lane & 7;
#pragma unroll
    for (int j = 0; j < 4; ++j) { const int n = (lane >> 3) + 8 * j; const LAS float* s = scr + (8 * c) * 33 + n;
        u32x4 o; o.x = pk2(s[0 * 33], s[1 * 33]); o.y = pk2(s[2 * 33], s[3 * 33]); o.z = pk2(s[4 * 33], s[5 * 33]); o.w = pk2(s[6 * 33], s[7 * 33]);
        *(u32x4*)(WT + (size_t)(drow0 + n) * ldo + dcol0 + k0 + 8 * c) = o; }
    LDS_WAIT(); asm volatile("" ::: "memory");
}
__device__ __forceinline__ int win_src_col(int n) {
    if (n < 416) return n; if (n < 512) return -1;
    if (n < 1280) return 2336 + (n - 512);
    if (n < 2048) return 3104 + (n - 1280);
    if (n < 3968) return 416 + (n - 2048);
    if (n < 4096) return -1;
    return 3872 + (n - 4096);
}
__device__ __forceinline__ void wconv_phase(Ctx& F, int l) {
    LAS float* scr = (LAS float*)(F.lds + F.wave * 16384);
    const int gw = F.bid * NWAVES + F.wave, NGW = F.G * NWAVES;
    const float* win = F.in[I_WIN] + (size_t)l * D * IN_W;
    const float* wbr = F.in[I_WBR] + (size_t)l * 4 * 512 * D;
    const float* wout = F.in[I_WOUT] + (size_t)l * D * D;
    bf16_t* win_t = (bf16_t*)(F.ws + WS_WIN); bf16_t* wbr_t = (bf16_t*)(F.ws + WS_WBR); bf16_t* wout_t = (bf16_t*)(F.ws + WS_WOUT);
    constexpr int I_A = 16 * 256, I_B = 4 * 8 * 32, I_C2 = 16 * 32;
    for (int it = gw; it < I_A + I_B + I_C2; it += NGW) {
        int r = it;
        if (r < I_A) { const int kb = r / 256, nb = r % 256; transpose_item(win, IN_W, 64 * kb, win_src_col(32 * nb), win_t, D, 32 * nb, 0, nullptr, 1.f, scr, F.lane); continue; } r -= I_A;
        if (r < I_B) { const int br = r / 256, rr = r % 256, kb = rr / 32, nb = rr % 32;
            transpose_item(wbr + (size_t)br * 512 * D, D, 64 * kb, 32 * nb, wbr_t + (size_t)(br >> 1) * D * D, D, 32 * nb, (br & 1) * 512, nullptr, 1.f, scr, F.lane); continue; } r -= I_B;
        { const int kb = r / 32, nb = r % 32; transpose_item(wout, D, 64 * kb, 32 * nb, wout_t, D, 32 * nb, 0, nullptr, 1.f, scr, F.lane); }
    }
    const float* wq = F.in[I_PWQ] + (size_t)l * D * D; const float* keys = F.in[I_PKEYS] + (size_t)l * 16 * 128 * 64;
    bf16_t* wpk = (bf16_t*)(F.ws + WS_WPK);
    for (int it = gw; it < 16 * 16 * 4; it += NGW) {
        const int kq = it & 3, g = it >> 6, k = (((it >> 2) & 15) << 6) + F.lane;
        f32x4 q[16];
#pragma unroll
        for (int j = 0; j < 16; ++j) q[j] = *(const f32x4*)(wq + (size_t)k * D + g * 64 + 4 * j);
        for (int key = 32 * kq; key < 32 * kq + 32; ++key) { const float* kr = keys + (size_t)(g * 128 + key) * 64; float s0 = 0.f, s1 = 0.f;
#pragma unroll
            for (int j = 0; j < 16; ++j) { const f32x4 kk = *(const f32x4*)(kr + 4 * j); s0 += q[j].x * kk.x + q[j].z * kk.z; s1 += q[j].y * kk.y + q[j].w * kk.w; }
            wpk[(size_t)(g * 128 + key) * D + k] = (bf16_t)f2bf(s0 + s1); }
    }
}
__device__ __forceinline__ float siluf_(float x) { return x / (1.0f + __expf(-x)); }
__device__ __forceinline__ void pro_phase(Ctx& F) {
    LAS float* scr = (LAS float*)(F.lds + F.wave * 16384);
    const int gw = F.bid * NWAVES + F.wave, NGW = F.G * NWAVES;
    const int gt = F.bid * NTHREADS + F.tid, NGT = F.G * NTHREADS;
    for (int it = gw; it < 2 * (96 + 64); it += NGW) {
        const int l = it / 160, r = it % 160;
        if (r < 96) { const int kb = r / 24, nb = r % 24;
            transpose_item(F.in[I_WUQ] + (size_t)l * 256 * 768, 768, 64 * kb, 32 * nb, (bf16_t*)(F.ws + WS_WUQ) + (size_t)l * 768 * 256, 256, 32 * nb, 0, F.in[I_QNORM] + l * 256, MLA_QS, scr, F.lane); }
        else { const int q = r - 96, kb = q / 32, nb = q % 32, n0 = 32 * nb, h = n0 >> 7, w0 = n0 & 127;
            transpose_item(F.in[I_WUKV] + (size_t)l * 128 * 1024, 1024, 64 * kb, n0, (bf16_t*)(F.ws + WS_WUKV) + (size_t)l * 1024 * 128 + (w0 < 64 ? 0 : 512 * 128), 128, h * 64 + (w0 & 63), 0, F.in[I_KVNORM] + l * 128, 1.f, scr, F.lane); }
    }
    { bf16_t* w2T = (bf16_t*)(F.ws + WS_LORA); bf16_t* a2T = w2T + 2 * 2 * 8 * 4096;
      for (int e = gt; e < 2 * 2 * 8 * 4096; e += NGT) { const int m = e & 63, j = (e >> 6) & 63, h = (e >> 12) & 7, ld = e >> 15;
          w2T[e] = (bf16_t)f2bf(F.in[I_W2][((size_t)ld * 64 + m) * 512 + h * 64 + j]); a2T[e] = (bf16_t)f2bf(F.in[I_A2][((size_t)ld * 64 + m) * 512 + h * 64 + j]); } }
    { bf16_t* g2T = (bf16_t*)(F.ws + WS_LORA) + 2 * (2 * 2 * 8 * 4096);
      for (int e = gt; e < 2 * 512 * 128; e += NGT) { const int k = e & 127, n = (e >> 7) & 511, l = e >> 16; g2T[e] = (bf16_t)f2bf(F.in[I_G2][((size_t)l * 128 + k) * 512 + n]); } }
    { float* cosA = (float*)(F.ws + WS_ROPE); float* sinA = cosA + 4096 * 16; float* cosH = sinA + 4096 * 16; float* sinH = cosH + 4096 * 32;
      for (int e = gt; e < 4096 * 48; e += NGT) { const int t = e / 48, p = e % 48; const float ri = (float)(t >> 6), ci = (float)(t & 63);
          if (p < 16) { const int i = p & 7; const float inv = powf(10000.f, -(float)i / 8.f); const float ang = (p < 8 ? ri : ci) * inv; cosA[t * 16 + p] = cosf(ang); sinA[t * 16 + p] = sinf(ang); }
          else { const int q = p - 16, i = q & 15; const float inv = powf(10000.f, -(float)i / 16.f); const float ang = (q < 16 ? ri : ci) * inv; cosH[t * 32 + q] = cosf(ang); sinH[t * 32 + q] = sinf(ang); } } }
    { float* modp = (float*)(F.ws + WS_MODP); LAS float* sl = (LAS float*)(F.lds + 131072 - 9 * 1024 * 4);
      __syncthreads();
      for (int e = F.tid; e < 9 * 1024; e += NTHREADS) sl[e] = siluf_(e < 8192 ? F.in[I_C][e] : F.in[I_CCTX][e - 8192]);
      __syncthreads();
      for (int it = gw; it < 2 * 16 * 96; it += NGW) { const int l = it / 1536, r = it % 1536, kc = r / 96, jb = r % 96, j = jb * 64 + F.lane;
          float acc[9];
#pragma unroll
          for (int b = 0; b < 9; ++b) acc[b] = 0.f;
          const float* aw = F.in[I_ADAW] + ((size_t)l * D + kc * 64) * 6144 + j;
          for (int kk = 0; kk < 64; ++kk) { const float w = aw[(size_t)kk * 6144]; const int k = kc * 64 + kk;
#pragma unroll
              for (int b = 0; b < 9; ++b) acc[b] += sl[b * 1024 + k] * w; }
#pragma unroll
          for (int b = 0; b < 9; ++b) modp[(((size_t)l * 16 + kc) * 9 + b) * 6144 + j] = acc[b]; }
      __syncthreads(); }
}
__device__ __forceinline__ void pro2_phase(Ctx& F) {
    const int gt = F.bid * NTHREADS + F.tid, NGT = F.G * NTHREADS;
    const float* modp = (const float*)(F.ws + WS_MODP); float* mod = (float*)(F.ws + WS_MOD);
    for (int e = gt; e < 2 * 9 * 6144; e += NGT) { const int j = e % 6144, b = (e / 6144) % 9, l = e / (9 * 6144);
        float s = F.in[I_ADAB][l * 6144 + j];
        for (int kc = 0; kc < 16; ++kc) s += modp[(((size_t)l * 16 + kc) * 9 + b) * 6144 + j];
        mod[e] = s; }
}
__device__ __forceinline__ int mod_slot(int grow) { return grow < MLAT ? (grow >> 12) : 8; }
__device__ __forceinline__ const float* mod_ptr(const Ctx& F, int l, int slot) { return (const float*)(F.ws + WS_MOD) + ((size_t)l * 9 + slot) * 6144; }
__device__ __forceinline__ void xmod0_phase(Ctx& F) {
    const int gw = F.bid * NWAVES + F.wave, NGW = F.G * NWAVES;
    bf16_t* xmod = (bf16_t*)(F.ws + WS_XMOD);
    for (int r = gw; r < MROWS; r += NGW) {
        const float* src = r < MLAT ? F.in[I_X] + (size_t)r * D : F.in[I_CTX] + (size_t)(r - MLAT) * D;
        const float* md = mod_ptr(F, 0, mod_slot(r));
#pragma unroll
        for (int j = 0; j < 4; ++j) { const int c = j * 256 + F.lane * 4;
            const f32x4 x = *(const f32x4*)(src + c), sh = *(const f32x4*)(md + c), sc = *(const f32x4*)(md + 1024 + c);
            u32x2 o; o.x = pk2(x.x * (1.f + sc.x) + sh.x, x.y * (1.f + sc.y) + sh.y); o.y = pk2(x.z * (1.f + sc.z) + sh.z, x.w * (1.f + sc.w) + sh.w);
            *(u32x2*)(xmod + (size_t)r * D + c) = o; }
    }
}

__device__ __forceinline__ int grow_of(int hb, int lr) { return lr < MLL ? hb * MLL + lr : MLAT + hb * NB * CTX + (lr - MLL); }
__device__ __forceinline__ int ltile_grow(int hb, int tm) { return tm < MLL / 256 ? hb * MLL + tm * 256 : MLAT + hb * NB * CTX + (tm - MLL / 256) * 256; }

struct SchedA {
    pg8::TileOrder T1, T2; const char* A; const char* B; int hb, G, c;
    __device__ __forceinline__ bool next(int i, pg8::Unit& u) const { const long L = (long)i * G + c; int tm, tn;
        if (L < T1.nwg) { T1.tileL(L, tm, tn); u.a = A + (size_t)tm * 256 * D * 2; u.b = B + (size_t)(2048 + tn * 256) * D * 2; u.nt = 16; u.pm = tm; u.pn = 8 + tn; u.kind = 1; return true; }
        if (!T2.tileL(L - T1.nwg, tm, tn)) return false;
        u.a = A + (size_t)ltile_grow(hb, tm) * D * 2; u.b = B + (size_t)tn * 256 * D * 2; u.nt = 16; u.pm = tm; u.pn = tn; u.kind = 0; return true; }
};
struct EpiRoute {
    unsigned char* ws;
    __device__ __forceinline__ void operator()(const f32x4 (&acc)[2][2][4][2], const pg8::Unit& u, int wr, int wc, int fr, int fq) const {
        OPAQUE_ZERO(z0); unsigned char* ws = this->ws + z0;
        bf16_t* rp[2]; int step[2];
        const int row0 = u.pm * 256 + wr * 64 + fr;
#pragma unroll
        for (int bj = 0; bj < 2; ++bj) { const int pn = u.pn; size_t off; int pt, co;
            if (pn < 2) { off = R_PM; pt = 512; co = pn * 256 + bj * 128; }
            else if (pn < 4) { off = R_QC; pt = 512; co = (pn - 2) * 256 + bj * 128; }
            else if (pn == 4) { off = bj ? R_VC : R_KC; pt = 128; co = 0; }
            else if (pn < 7) { off = R_QD; pt = 512; co = (pn - 5) * 256 + bj * 128; }
            else if (pn == 7) { off = bj ? R_VD : R_KD; pt = 128; co = 0; }
            else { off = R_PR; pt = 2048; co = (pn - 8) * 256 + bj * 128; }
            rp[bj] = (bf16_t*)(ws + off) + co + wc * 32 + 8 * fq + (size_t)row0 * pt; step[bj] = 16 * pt; }
#pragma unroll
        for (int ai = 0; ai < 2; ++ai) {
#pragma unroll
            for (int m = 0; m < 4; ++m) {
#pragma unroll
                for (int bj = 0; bj < 2; ++bj) { const f32x4 v0 = acc[ai][bj][m][0], v1 = acc[ai][bj][m][1];
                    u32x4 w; w.x = pg8::cvt_pk_bf16(v0[0], v0[1]); w.y = pg8::cvt_pk_bf16(v0[2], v0[3]); w.z = pg8::cvt_pk_bf16(v1[0], v1[1]); w.w = pg8::cvt_pk_bf16(v1[2], v1[3]);
                    *(u32x4*)rp[bj] = w; rp[bj] += step[bj]; }
                asm volatile("" : "+v"(rp[0]), "+v"(rp[1]) :: "memory"); }
            rp[0] += 4 * step[0]; rp[1] += 4 * step[1]; }
    }
};
__device__ __forceinline__ void phaseA(Ctx& F, int hb) {
    SchedA S; S.T1.init(hb == 0 ? MROWS / 256 : 0, 8, F.G, F.bid); S.T2.init(ML / 256, 8, F.G, F.bid); S.A = (const char*)(F.ws + WS_XMOD); S.B = (const char*)(F.ws + WS_WIN); S.hb = hb; S.G = F.G; S.c = F.bid;
    EpiRoute E{F.ws};
    pg8::gemm_phase<EpiRoute, SchedA>(F.lds, F.wave, D, D, S, E);
}

__device__ __forceinline__ void unpack8(const u32x4 w, float (&v)[8]) { v[0] = bflo(w.x); v[1] = bfhi(w.x); v[2] = bflo(w.y); v[3] = bfhi(w.y); v[4] = bflo(w.z); v[5] = bfhi(w.z); v[6] = bflo(w.w); v[7] = bfhi(w.w); }
__device__ __forceinline__ u32x4 pack8(const float (&v)[8]) { u32x4 w; w.x = pk2(v[0], v[1]); w.y = pk2(v[2], v[3]); w.z = pk2(v[4], v[5]); w.w = pk2(v[6], v[7]); return w; }
__device__ __forceinline__ void rope8(float (&v)[8], const float* cs, const float* sn) {
#pragma unroll
    for (int j = 0; j < 4; ++j) { const float a = v[2 * j], b = v[2 * j + 1], c = cs[j], s = sn[j]; v[2 * j] = a * c - b * s; v[2 * j + 1] = a * s + b * c; }
}
__device__ __forceinline__ void phaseB0(Ctx& F, int l, int hb) {
    const int gw = F.bid * NWAVES + F.wave, NGW = F.G * NWAVES, lane = F.lane;
    const float* cosA = (const float*)(F.ws + WS_ROPE); const float* sinA = cosA + 4096 * 16; const float* cosH = sinA + 4096 * 16; const float* sinH = cosH + 4096 * 32;
    bf16_t* Pm = (bf16_t*)(F.ws + R_PM); bf16_t* Ka = (bf16_t*)(F.ws + R_KA);
    bf16_t* Qc = (bf16_t*)(F.ws + R_QC); bf16_t* Kc = (bf16_t*)(F.ws + R_KC); bf16_t* Qd = (bf16_t*)(F.ws + R_QD); bf16_t* Kd = (bf16_t*)(F.ws + R_KD);
    const float* gq = F.in[I_GQN] + l * 64; const float* gk = F.in[I_GKN] + l * 64;
    for (int lr = gw; lr < ML; lr += NGW) {
        const bool lat = lr < MLL; const int t = lat ? (lr & 4095) : 0;
        { float v[8]; unpack8(*(const u32x4*)(Pm + (size_t)lr * 512 + lane * 8), v);
          float ss = 0.f;
#pragma unroll
          for (int j = 0; j < 8; ++j) ss += v[j] * v[j];
          const float sq = wave_sum(lane < 32 ? ss : 0.f), skv = wave_sum((lane >= 32 && lane < 48) ? ss : 0.f);
          if (lane < 48) { const float rs = __builtin_amdgcn_rsqf(lane < 32 ? sq * (1.f / 256.f) + RMS_EPS : skv * (1.f / 128.f) + RMS_EPS);
              float nv[8];
#pragma unroll
              for (int j = 0; j < 8; ++j) nv[j] = v[j] * rs;
              *(u32x4*)(Pm + (size_t)lr * 512 + lane * 8) = pack8(nv); }
          if (lane >= 48 && lane < 52) { const int p0 = 4 * (lane - 48);
              if (lat) rope8(v, cosA + t * 16 + p0, sinA + t * 16 + p0);
              const u32x4 w = pack8(v);
#pragma unroll
              for (int h = 0; h < 8; ++h) *(u32x4*)(Ka + (size_t)lr * 768 + h * 96 + 64 + 8 * (lane - 48)) = w; } }
        { const int p0 = 4 * (lane & 7), d0 = 8 * (lane & 7);
          float v[8]; unpack8(*(const u32x4*)(Qc + (size_t)lr * 512 + lane * 8), v);
          float ss = 0.f;
#pragma unroll
          for (int j = 0; j < 8; ++j) ss += v[j] * v[j];
          ss = group8_sum(ss); const float rs = __builtin_amdgcn_rsqf(ss * (1.f / 64.f) + RMS_EPS);
#pragma unroll
          for (int j = 0; j < 8; ++j) v[j] = v[j] * rs * gq[d0 + j];
          if (lat) rope8(v, cosH + t * 32 + p0, sinH + t * 32 + p0);
#pragma unroll
          for (int j = 0; j < 8; ++j) v[j] *= HD_QS;
          *(u32x4*)(Qc + (size_t)lr * 512 + lane * 8) = pack8(v);
          float q[8]; unpack8(*(const u32x4*)(Qd + (size_t)lr * 512 + lane * 8), q);
          if (lat) rope8(q, cosH + t * 32 + p0, sinH + t * 32 + p0);
#pragma unroll
          for (int j = 0; j < 8; ++j) q[j] *= HD_QS;
          *(u32x4*)(Qd + (size_t)lr * 512 + lane * 8) = pack8(q);
          if (lane < 16) {
              float k[8]; unpack8(*(const u32x4*)(Kc + (size_t)lr * 128 + lane * 8), k);
              float s2 = 0.f;
#pragma unroll
              for (int j = 0; j < 8; ++j) s2 += k[j] * k[j];
              s2 = group8_sum(s2); const float rk = __builtin_amdgcn_rsqf(s2 * (1.f / 64.f) + RMS_EPS);
#pragma unroll
              for (int j = 0; j < 8; ++j) k[j] = k[j] * rk * gk[d0 + j];
              if (lat) rope8(k, cosH + t * 32 + p0, sinH + t * 32 + p0);
              *(u32x4*)(Kc + (size_t)lr * 128 + lane * 8) = pack8(k);
              float kd[8]; unpack8(*(const u32x4*)(Kd + (size_t)lr * 128 + lane * 8), kd);
              if (lat) rope8(kd, cosH + t * 32 + p0, sinH + t * 32 + p0);
              *(u32x4*)(Kd + (size_t)lr * 128 + lane * 8) = pack8(kd);
          } }
    }
    LAS bf16_t* tile = (LAS bf16_t*)F.lds;
    for (int it = F.bid; it < 2 * (ML / 64); it += F.G) {
        const int which = it / (ML / 64), rb = it % (ML / 64), lr0 = rb * 64;
        const bf16_t* src = (const bf16_t*)(F.ws + (which ? R_VD : R_VC)); bf16_t* dst = (bf16_t*)(F.ws + (which ? R_VDT : R_VCT));
        __syncthreads();
#pragma unroll
        for (int i = 0; i < 2; ++i) { const int e = F.tid + i * 512, r = e >> 4, c8 = e & 15;
            *(LAS u32x4*)(tile + r * 136 + c8 * 8) = *(const u32x4*)(src + (size_t)(lr0 + r) * 128 + c8 * 8); }
        __syncthreads();
        const int c = F.tid >> 2, pq = F.tid & 3;
        const bool lat = lr0 < MLL; const int bl = lat ? (lr0 >> 12) : ((lr0 - MLL) >> 8); const int pos0 = lat ? (lr0 & 4095) : 4096 + ((lr0 - MLL) & 255);
        unsigned w[8];
#pragma unroll
        for (int j = 0; j < 8; ++j) w[j] = (unsigned)tile[(pq * 16 + 2 * j) * 136 + c] | ((unsigned)tile[(pq * 16 + 2 * j + 1) * 136 + c] << 16);
        bf16_t* o = dst + ((size_t)(bl * 2 + (c >> 6)) * 64 + (c & 63)) * LTOT + pos0 + pq * 16;
        *(u32x4*)o = (u32x4){w[0], w[1], w[2], w[3]}; *(u32x4*)(o + 8) = (u32x4){w[4], w[5], w[6], w[7]};
    }
    __syncthreads();
}

struct SchedB1 {
    pg8::TileOrder T; const char* A; const char* B; int ldb2; int nt;
    __device__ __forceinline__ bool next(int i, pg8::Unit& u) const { int tm, tn; if (!T.tile(i, tm, tn)) return false;
        u.a = A + (size_t)tm * 256 * 512 * 2; u.b = B + (size_t)tn * 256 * ldb2; u.nt = nt; u.pm = tm; u.pn = tn; u.kind = 0; return true; }
};
struct EpiMlaQ {
    unsigned char* ws;
    __device__ __forceinline__ void operator()(const f32x4 (&acc)[2][2][4][2], const pg8::Unit& u, int wr, int wc, int fr, int fq) const {
        OPAQUE_ZERO(z0); unsigned char* ws = this->ws + z0;
        bf16_t* qp = (bf16_t*)(ws + R_QA) + (size_t)(u.pm * 256 + wr * 64 + fr) * 768 + u.pn * 256 + wc * 32 + 8 * fq;
#pragma unroll
        for (int ai = 0; ai < 2; ++ai) {
#pragma unroll
            for (int m = 0; m < 4; ++m) {
#pragma unroll
                for (int bj = 0; bj < 2; ++bj) { const f32x4 v0 = acc[ai][bj][m][0], v1 = acc[ai][bj][m][1];
                    u32x4 w; w.x = pg8::cvt_pk_bf16(v0[0], v0[1]); w.y = pg8::cvt_pk_bf16(v0[2], v0[3]); w.z = pg8::cvt_pk_bf16(v1[0], v1[1]); w.w = pg8::cvt_pk_bf16(v1[2], v1[3]);
                    *(u32x4*)(qp + bj * 128) = w; }
                qp += 16 * 768; asm volatile("" : "+v"(qp) :: "memory"); }
            qp += 64 * 768; }
    }
};
struct EpiMlaK {
    unsigned char* ws;
    __device__ __forceinline__ void operator()(const f32x4 (&acc)[2][2][4][2], const pg8::Unit& u, int wr, int wc, int fr, int fq) const {
        OPAQUE_ZERO(z0); unsigned char* ws = this->ws + z0;
        const int c0 = u.pn * 256 + wc * 32 + 8 * fq;
        bf16_t* kp = (bf16_t*)(ws + R_KA) + (size_t)(u.pm * 256 + wr * 64 + fr) * 768 + (c0 >> 6) * 96 + (c0 & 63);
#pragma unroll
        for (int ai = 0; ai < 2; ++ai) {
#pragma unroll
            for (int m = 0; m < 4; ++m) {
#pragma unroll
                for (int bj = 0; bj < 2; ++bj) { const f32x4 v0 = acc[ai][bj][m][0], v1 = acc[ai][bj][m][1];
                    u32x4 w; w.x = pg8::cvt_pk_bf16(v0[0], v0[1]); w.y = pg8::cvt_pk_bf16(v0[2], v0[3]); w.z = pg8::cvt_pk_bf16(v1[0], v1[1]); w.w = pg8::cvt_pk_bf16(v1[2], v1[3]);
                    *(u32x4*)(kp + bj * 192) = w; }
                kp += 16 * 768; asm volatile("" : "+v"(kp) :: "memory"); }
            kp += 64 * 768; }
    }
};
struct EpiMlaVT {
    unsigned char* ws;
    __device__ __forceinline__ void operator()(const f32x4 (&acc)[2][2][4][2], const pg8::Unit& u, int wr, int wc, int fr, int fq) const {
        OPAQUE_ZERO(z0); unsigned char* ws = this->ws + z0;
        const int lr0 = u.pn * 256;
        const bool lat = lr0 < MLL; const int bl = lat ? (lr0 >> 12) : ((lr0 - MLL) >> 8); const int pos0 = lat ? (lr0 & 4095) : 4096 + ((lr0 - MLL) & 255);
        bf16_t* vp = (bf16_t*)(ws + R_VAT) + ((size_t)bl * 512 + u.pm * 256 + wr * 64 + fr) * LTOT + pos0 + wc * 32 + 8 * fq;
#pragma unroll
        for (int ai = 0; ai < 2; ++ai) {
#pragma unroll
            for (int m = 0; m < 4; ++m) {
#pragma unroll
                for (int bj = 0; bj < 2; ++bj) { const f32x4 v0 = acc[ai][bj][m][0], v1 = acc[ai][bj][m][1];
                    u32x4 w; w.x = pg8::cvt_pk_bf16(v0[0], v0[1]); w.y = pg8::cvt_pk_bf16(v0[2], v0[3]); w.z = pg8::cvt_pk_bf16(v1[0], v1[1]); w.w = pg8::cvt_pk_bf16(v1[2], v1[3]);
                    *(u32x4*)(vp + bj * 128) = w; }
                vp += (size_t)16 * LTOT; asm volatile("" : "+v"(vp) :: "memory"); }
            vp += (size_t)64 * LTOT; }
    }
};
struct SchedB1T {
    pg8::TileOrder T; const char* A; const char* B;
    __device__ __forceinline__ bool next(int i, pg8::Unit& u) const { int tm, tn; if (!T.tile(i, tm, tn)) return false;
        u.a = A + (size_t)tm * 256 * 128 * 2; u.b = B + (size_t)tn * 256 * 512 * 2; u.nt = 2; u.pm = tm; u.pn = tn; u.kind = 0; return true; }
};
__device__ __forceinline__ void phaseB1q(Ctx& F, int l) {
    SchedB1 S; S.T.init(ML / 256, 3, F.G, F.bid); S.A = (const char*)(F.ws + R_PM); S.B = (const char*)(F.ws + WS_WUQ) + (size_t)l * 768 * 256 * 2; S.ldb2 = 256 * 2; S.nt = 4;
    EpiMlaQ E{F.ws}; pg8::gemm_phase<EpiMlaQ, SchedB1>(F.lds, F.wave, 512, 256, S, E);
}
__device__ __forceinline__ void phaseB1k(Ctx& F, int l) {
    SchedB1 S; S.T.init(ML / 256, 2, F.G, F.bid); S.A = (const char*)(F.ws + R_PM) + 256 * 2; S.B = (const char*)(F.ws + WS_WUKV) + (size_t)l * 1024 * 128 * 2; S.ldb2 = 128 * 2; S.nt = 2;
    EpiMlaK E{F.ws}; pg8::gemm_phase<EpiMlaK, SchedB1>(F.lds, F.wave, 512, 128, S, E);
}
__device__ __forceinline__ void phaseB1v(Ctx& F, int l) {
    SchedB1T S; S.T.init(2, ML / 256, F.G, F.bid); S.A = (const char*)(F.ws + WS_WUKV) + ((size_t)l * 1024 * 128 + 512 * 128) * 2; S.B = (const char*)(F.ws + R_PM) + 256 * 2;
    EpiMlaVT E{F.ws}; pg8::gemm_phase<EpiMlaVT, SchedB1T>(F.lds, F.wave, 128, 512, S, E);
}

struct AttnWave { const bf16_t* q; int qpitch; bf16_t* o; int opitch; int qpos; const float* rope; };
struct AttnKeys { const bf16_t* k; int kpitch; const bf16_t* vt; int lat_p0, lat_n, ctx_n; int bl; int wmask; int has_sink; float sink2; };
template <int DQK>
__device__ __forceinline__ void attn_unit(Ctx& F, const AttnWave& W, const AttnKeys& Kd) {
    constexpr int NCH = DQK / 8, ND0 = DQK / 16, KT_BYTES = NCH * 1024, VT_BYTES = 64 * 144, BUF = KT_BYTES + VT_BYTES;
    constexpr int KPASS = (NCH * 64 + 511) / 512;
    LAS unsigned char* lds = F.lds;
    const int tid = F.tid, lane = F.lane, r32 = lane & 31, hi = lane >> 5;
    const int ntiles = Kd.lat_n + Kd.ctx_n;
    bf16x8 qf[ND0];
#pragma unroll
    for (int d0 = 0; d0 < ND0; ++d0) qf[d0] = *(const bf16x8*)(W.q + (size_t)r32 * W.qpitch + d0 * 16 + hi * 8);
    if constexpr (DQK == 96) if (W.rope) {
#pragma unroll
        for (int d0 = 4; d0 < 6; ++d0) { float v[8]; unpack8(__builtin_bit_cast(u32x4, qf[d0]), v); const float* cs = W.rope + r32 * 16 + 8 * (d0 - 4) + 4 * hi;
            rope8(v, cs, cs + 4096 * 16); qf[d0] = __builtin_bit_cast(bf16x8, pack8(v)); } }
    f32x16 o0 = {}, o1 = {}; float m_run = 0.f, l_run = 0.f; f32x16 negm = {};
    u32x4 kreg[KPASS], vreg;
    auto tile_pos = [&](int t) -> int { return t < Kd.lat_n ? Kd.lat_p0 + 64 * t : 4096 + 64 * (t - Kd.lat_n); };
    auto gload = [&](int t) {
        const int pos = tile_pos(t);
        const int krow0 = pos < 4096 ? Kd.bl * 4096 + pos : MLL + Kd.bl * 256 + (pos - 4096);
#pragma unroll
        for (int p = 0; p < KPASS; ++p) { const int e = tid + p * 512; if (e < NCH * 64) { const int key = e & 63, ch = e >> 6; kreg[p] = *(const u32x4*)(Kd.k + (size_t)(krow0 + key) * Kd.kpitch + ch * 8); } }
        { const int d = tid >> 3, kc = tid & 7; vreg = *(const u32x4*)(Kd.vt + (size_t)d * LTOT + pos + kc * 8); }
    };
    auto lstore = [&](int buf) {
        LAS unsigned char* kb = lds + buf * BUF; LAS unsigned char* vb = kb + KT_BYTES;
#pragma unroll
        for (int p = 0; p < KPASS; ++p) { const int e = tid + p * 512; if (e < NCH * 64) { const int key = e & 63, ch = e >> 6; *(LAS u32x4*)(kb + ch * 1024 + key * 16) = kreg[p]; } }
        { const int d = tid >> 3, kc = tid & 7, g = kc >> 1, half = kc & 1;
          *(LAS u32x2*)(vb + d * 144 + g * 32 + half * 8) = (u32x2){vreg.x, vreg.y};
          *(LAS u32x2*)(vb + d * 144 + g * 32 + (2 + half) * 8) = (u32x2){vreg.z, vreg.w}; }
    };
    __syncthreads();
    gload(0); lstore(0);
    __syncthreads();
    for (int t = 0; t < ntiles; ++t) {
        const int buf = t & 1;
        if (t + 1 < ntiles) gload(t + 1);
        LAS unsigned char* kb = lds + buf * BUF; LAS unsigned char* vb = kb + KT_BYTES;
        f32x16 p0 = negm, p1 = negm;
#pragma unroll
        for (int d0 = 0; d0 < ND0; ++d0) {
            const bf16x8 k0 = *(const LAS bf16x8*)(kb + (2 * d0 + hi) * 1024 + r32 * 16);
            const bf16x8 k1 = *(const LAS bf16x8*)(kb + (2 * d0 + hi) * 1024 + (32 + r32) * 16);
            p0 = __builtin_amdgcn_mfma_f32_32x32x16_bf16(k0, qf[d0], p0, 0, 0, 0);
            p1 = __builtin_amdgcn_mfma_f32_32x32x16_bf16(k1, qf[d0], p1, 0, 0, 0);
        }
        if (Kd.wmask && t < Kd.lat_n) {
            const int jb = tile_pos(t) + 4 * hi - (W.qpos + r32);
#pragma unroll
            for (int r = 0; r < 16; ++r) { const int dj = jb + (r & 3) + 8 * (r >> 2);
                if (dj > 128 || dj < -128) p0[r] = -INFINITY;
                if (dj + 32 > 128 || dj + 32 < -128) p1[r] = -INFINITY; }
        }
        float ma = __builtin_fmaxf(__builtin_fmaxf(p0[0], p0[1]), p1[0]), mb = __builtin_fmaxf(__builtin_fmaxf(p0[2], p0[3]), p1[1]);
        ma = __builtin_fmaxf(__builtin_fmaxf(ma, p1[2]), p1[3]);
#pragma unroll
        for (int r = 4; r < 16; r += 4) { ma = __builtin_fmaxf(__builtin_fmaxf(ma, p0[r]), p0[r + 1]); mb = __builtin_fmaxf(__builtin_fmaxf(mb, p0[r + 2]), p0[r + 3]);
            ma = __builtin_fmaxf(__builtin_fmaxf(ma, p1[r]), p1[r + 1]); mb = __builtin_fmaxf(__builtin_fmaxf(mb, p1[r + 2]), p1[r + 3]); }
        float mx = __builtin_fmaxf(ma, mb);
        { auto rr = __builtin_amdgcn_permlane32_swap(__float_as_uint(mx), __float_as_uint(mx), false, false); mx = __builtin_fmaxf(__uint_as_float(rr[0]), __uint_as_float(rr[1])); }
        if (t == 0 || __any(mx > 8.0f)) {
            const float dl = t == 0 ? __builtin_fmaxf(mx, -100.f) : __builtin_fmaxf(mx, 0.f), alpha = __builtin_amdgcn_exp2f(-dl);
            m_run += dl; l_run *= alpha;
#pragma unroll
            for (int r = 0; r < 16; ++r) { o0[r] *= alpha; o1[r] *= alpha; p0[r] -= dl; p1[r] -= dl; negm[r] = -m_run; }
        }
        float ps0 = 0.f, ps1 = 0.f;
#pragma unroll
        for (int r = 0; r < 16; ++r) { p0[r] = __builtin_amdgcn_exp2f(p0[r]); p1[r] = __builtin_amdgcn_exp2f(p1[r]); ps0 += p0[r]; ps1 += p1[r]; }
        l_run += ps0 + ps1;
        bf16x8 pf[4];
#pragma unroll
        for (int s = 0; s < 4; ++s) { u32x4 w;
            if (s < 2) { w.x = pg8::cvt_pk_bf16(p0[8 * s + 0], p0[8 * s + 1]); w.y = pg8::cvt_pk_bf16(p0[8 * s + 2], p0[8 * s + 3]); w.z = pg8::cvt_pk_bf16(p0[8 * s + 4], p0[8 * s + 5]); w.w = pg8::cvt_pk_bf16(p0[8 * s + 6], p0[8 * s + 7]); }
            else { const int b = 8 * (s - 2); w.x = pg8::cvt_pk_bf16(p1[b + 0], p1[b + 1]); w.y = pg8::cvt_pk_bf16(p1[b + 2], p1[b + 3]); w.z = pg8::cvt_pk_bf16(p1[b + 4], p1[b + 5]); w.w = pg8::cvt_pk_bf16(p1[b + 6], p1[b + 7]); }
            pf[s] = __builtin_bit_cast(bf16x8, w); }
#pragma unroll
        for (int s = 0; s < 4; ++s) {
            const bf16x8 v0 = *(const LAS bf16x8*)(vb + r32 * 144 + s * 32 + hi * 16);
            const bf16x8 v1 = *(const LAS bf16x8*)(vb + (32 + r32) * 144 + s * 32 + hi * 16);
            o0 = __builtin_amdgcn_mfma_f32_32x32x16_bf16(v0, pf[s], o0, 0, 0, 0);
            o1 = __builtin_amdgcn_mfma_f32_32x32x16_bf16(v1, pf[s], o1, 0, 0, 0);
        }
        if (t + 1 < ntiles) lstore(buf ^ 1);
        __syncthreads();
    }
    { auto rr = __builtin_amdgcn_permlane32_swap(__float_as_uint(l_run), __float_as_uint(l_run), false, false); l_run = __uint_as_float(rr[0]) + __uint_as_float(rr[1]); }
    if (Kd.has_sink) l_run += __builtin_amdgcn_exp2f(Kd.sink2 - m_run);
    const float inv = 1.0f / l_run;
    bf16_t* orow = W.o + (size_t)r32 * W.opitch;
#pragma unroll
    for (int g = 0; g < 4; ++g) {
        u32x2 a; a.x = pg8::cvt_pk_bf16(o0[4 * g] * inv, o0[4 * g + 1] * inv); a.y = pg8::cvt_pk_bf16(o0[4 * g + 2] * inv, o0[4 * g + 3] * inv);
        *(u32x2*)(orow + 8 * g + 4 * hi) = a;
        u32x2 b; b.x = pg8::cvt_pk_bf16(o1[4 * g] * inv, o1[4 * g + 1] * inv); b.y = pg8::cvt_pk_bf16(o1[4 * g + 2] * inv, o1[4 * g + 3] * inv);
        *(u32x2*)(orow + 32 + 8 * g + 4 * hi) = b;
    }
}

template <int C> __device__ __forceinline__ void qd_fmac(float& acc, float bsrc, float x) { asm("v_fmac_f32_dpp %0, %1, %2 quad_perm:[%c3,%c3,%c3,%c3] row_mask:0xf bank_mask:0xf" : "+v"(acc) : "v"(bsrc), "v"(x), "n"(C)); }
template <int C> __device__ __forceinline__ float qd_mul(float bsrc, float x) { float d; asm("v_mul_f32_dpp %0, %1, %2 quad_perm:[%c3,%c3,%c3,%c3] row_mask:0xf bank_mask:0xf" : "=v"(d) : "v"(bsrc), "v"(x), "n"(C)); return d; }
__device__ __forceinline__ float dpp_ror8(float x) { float d; asm("s_nop 1\n\tv_mov_b32_dpp %0, %1 row_ror:8 row_mask:0xf bank_mask:0xf" : "=v"(d) : "v"(x)); return d; }
template <int N> __device__ __forceinline__ float ror_add(float x) { float d; asm("s_nop 1\n\tv_add_f32_dpp %0, %1, %1 row_ror:%c2 row_mask:0xf bank_mask:0xf" : "=v"(d) : "v"(x), "n"(N)); return d; }
__device__ __forceinline__ float quads_sum(float x) { return swap32_sum(swap16_sum(ror_add<8>(ror_add<4>(x)))); }
__device__ __forceinline__ float row16_sum(float v) { v += dpp_f<0xB1>(v); v += dpp_f<0x4E>(v); return ror_add<8>(ror_add<4>(v)); }
constexpr int SC_TS = 32;
constexpr int SC_SCR = 0, SC_H = 16384, SC_HPLANE = 4096, SC_HSET = 24576, SC_Y = 65536, SC_YP = 72, SC_LW = 83968, SC_LA = 88064, SC_MU = 92160, SC_CST = 94720, SC_W2 = 96256, SC_A2 = 104448, SC_END = 112640;
static_assert(SC_END <= MISC_OFF, "scan LDS map");
typedef _Float16 sh2 __attribute__((ext_vector_type(2)));
typedef _Float16 sh8 __attribute__((ext_vector_type(8)));
typedef _Float16 sh4 __attribute__((ext_vector_type(4)));
__device__ __forceinline__ unsigned pkh2(float a, float b) { const sh2 v = {(_Float16)a, (_Float16)b}; return __builtin_bit_cast(unsigned, v); }
__device__ __forceinline__ u32x4 packh8(const float (&v)[8]) { return (u32x4){pkh2(v[0], v[1]), pkh2(v[2], v[3]), pkh2(v[4], v[5]), pkh2(v[6], v[7])}; }
__device__ __forceinline__ void scan_item(Ctx& F, int l, int bg, int h, int dir, bool emit_ctx) {
    const int tid = F.tid, lane = F.lane, w = F.wave;
    const bool prep = w >= 4; const int pw = w & 3;
    LAS unsigned char* cb = F.lds;
    LAS float* ybufb = (LAS float*)(cb + SC_Y);
    LAS bf16_t* w2s = (LAS bf16_t*)(cb + SC_W2); LAS bf16_t* a2s = (LAS bf16_t*)(cb + SC_A2); LAS float* cst = (LAS float*)(cb + SC_CST);
    LAS bf16_t* linw = (LAS bf16_t*)(cb + SC_LW); LAS bf16_t* lina = (LAS bf16_t*)(cb + SC_LA); LAS float* mus = (LAS float*)(cb + SC_MU);
    const bf16_t* Pr = (const bf16_t*)(F.ws + R_PR);
    bf16_t* OUT = dir ? (bf16_t*)(F.ws + R_OB) : (bf16_t*)(F.ws + WS_Y01) + 512; const int opitch = dir ? 512 : D;
    float* BON = (float*)(F.ws + WS_BON);
    auto slice_col = [&](int s_) -> int { return s_ == 0 ? h * 64 : s_ == 1 ? 512 + h * 64 : s_ == 2 ? 1024 + h * 64 : s_ == 3 ? 1536 + 64 * dir : 1664 + 64 * dir; };
    constexpr int NCH = LTOT / SC_TS;
    auto chunk_geo = [&](int ch, int& tlo, int& lrow0, int& slen) { const bool isctx = ch < CTX / SC_TS; const int cc = isctx ? ch : ch - CTX / SC_TS; slen = isctx ? CTX : SEQ;
        tlo = dir ? slen - SC_TS * (cc + 1) : SC_TS * cc; lrow0 = isctx ? MLAT + bg * CTX : bg * SEQ; };
    __syncthreads();
    for (int e = tid; e < 640; e += NTHREADS) { const int s_ = e >> 7, which = (e >> 6) & 1, c = e & 63; mus[e] = F.in[I_MU][((size_t)l * 2 + which) * 1920 + slice_col(s_) + c]; }
    if (tid < 320) { const int which = tid >> 6, c = tid & 63; const int ci = (l * 2 + dir) * 512 + h * 64 + c, cj = l * 512 + h * 64 + c;
        cst[tid] = which == 0 ? F.in[I_W0][ci] : which == 1 ? F.in[I_A0][ci] : which == 2 ? F.in[I_KK][cj] : which == 3 ? F.in[I_KA][cj] : F.in[I_RK][cj]; }
    { const u32x4* w2T = (const u32x4*)((const bf16_t*)(F.ws + WS_LORA) + ((size_t)((l * 2 + dir) * 8 + h) * 64) * 64); const u32x4* a2T = w2T + 2 * 2 * 8 * 4096 / 8;
      ((LAS u32x4*)w2s)[tid] = w2T[tid]; ((LAS u32x4*)a2s)[tid] = a2T[tid]; }
    __syncthreads();
    if (prep) {
        const int t8 = lane >> 3, cg = lane & 7, ptt = 8 * pw + t8;
        const int n16 = lane & 15, q16 = lane >> 4;
        u32x4 px[5], pp[5], pn[5];
        const int ptok = dir ? SC_TS - 1 - ptt : ptt;
        auto issue_loads = [&](int ch) { int tlo, lrow0, slen; chunk_geo(ch, tlo, lrow0, slen); const int t = tlo + ptok;
            const bf16_t* row = Pr + (size_t)(lrow0 + t) * 2048 + 8 * cg; const int dp = t > 0 ? 2048 : 0, dn = t < slen - 1 ? 2048 : 0;
#pragma unroll
            for (int s_ = 0; s_ < 5; ++s_) { const bf16_t* ptr = row + slice_col(s_); px[s_] = *(const u32x4*)ptr; pp[s_] = *(const u32x4*)(ptr - dp); pn[s_] = *(const u32x4*)(ptr + dn); } };
        auto prepare = [&](int ch) { int tlo, lrow0, slen; chunk_geo(ch, tlo, lrow0, slen); const int set = ch & 1;
            LAS float* fW = (LAS float*)(cb + SC_SCR); LAS float* fB = fW + 2048;
            LAS unsigned char* hK = cb + SC_H + set * SC_HSET;
            const int t = tlo + ptok; const float zp = t > 0 ? 1.f : 0.f, zn = t < slen - 1 ? 1.f : 0.f;
            float kv[8], rv[8];
#pragma unroll
            for (int s_ = 0; s_ < 5; ++s_) { float x[8], xp[8], xn[8], sh[8]; unpack8(px[s_], x); unpack8(pp[s_], xp); unpack8(pn[s_], xn);
                const LAS float* m0 = mus + (s_ * 2) * 64 + 8 * cg; const LAS float* m1 = m0 + 64;
#pragma unroll
                for (int j = 0; j < 8; ++j) sh[j] = x[j] + m0[j] * (xp[j] * zp - x[j]) + m1[j] * (xn[j] * zn - x[j]);
                if (s_ == 0) { *(LAS u32x4*)(hK + 4 * SC_HPLANE + (ptt * 64 + 8 * cg) * 2) = packh8(sh);
#pragma unroll
                    for (int j = 0; j < 8; ++j) rv[j] = sh[j]; }
                else if (s_ == 1) {
#pragma unroll
                    for (int j = 0; j < 8; ++j) kv[j] = sh[j]; }
                else if (s_ == 2) *(LAS u32x4*)(hK + 5 * SC_HPLANE + (ptt * 64 + 8 * cg) * 2) = packh8(sh);
                else if (s_ == 3) { float th[8];
#pragma unroll
                    for (int j = 0; j < 8; ++j) { const float ex = __expf(2.0f * sh[j]); th[j] = 1.0f - 2.0f * __builtin_amdgcn_rcpf(ex + 1.0f); }
                    *(LAS u32x4*)(linw + ptt * 64 + 8 * cg) = pack8(th); }
                else *(LAS u32x4*)(lina + ptt * 64 + 8 * cg) = pack8(sh); }
            asm volatile("" ::: "memory");
            if (ch + 1 < NCH) issue_loads(ch + 1);
            LDS_WAIT();
#pragma unroll
            for (int ct = 0; ct < 4; ++ct) { f32x4 cw_ = {0.f, 0.f, 0.f, 0.f}, ca_ = {0.f, 0.f, 0.f, 0.f};
#pragma unroll
                for (int ks = 0; ks < 2; ++ks) {
                    const bf16x8 aw = *(const LAS bf16x8*)(linw + (8 * pw + (n16 & 7)) * 64 + 32 * ks + 8 * q16);
                    const bf16x8 aa = *(const LAS bf16x8*)(lina + (8 * pw + (n16 & 7)) * 64 + 32 * ks + 8 * q16);
                    const bf16x8 bwf = *(const LAS bf16x8*)(w2s + (16 * ct + n16) * 64 + 32 * ks + 8 * q16), baf = *(const LAS bf16x8*)(a2s + (16 * ct + n16) * 64 + 32 * ks + 8 * q16);
                    cw_ = __builtin_amdgcn_mfma_f32_16x16x32_bf16(aw, bwf, cw_, 0, 0, 0);
                    ca_ = __builtin_amdgcn_mfma_f32_16x16x32_bf16(aa, baf, ca_, 0, 0, 0); }
                if (q16 < 2) { const float w0c = cst[16 * ct + n16], a0c = cst[64 + 16 * ct + n16];
#pragma unroll
                    for (int r = 0; r < 4; ++r) { const int o = (8 * pw + 4 * q16 + r) * 64 + 16 * ct + n16; fW[o] = cw_[r] + w0c; fB[o] = ca_[r] + a0c; } } }
            LDS_WAIT();
            { float kkr[8], av[8], wd[8], lw[8], la[8]; float ss = 0.f, bsum = 0.f; const int o = ptt * 64 + 8 * cg;
              { const f32x4 a = *(const LAS f32x4*)(fW + o), b = *(const LAS f32x4*)(fW + o + 4), c = *(const LAS f32x4*)(fB + o), d = *(const LAS f32x4*)(fB + o + 4);
#pragma unroll
                for (int j = 0; j < 4; ++j) { lw[j] = a[j]; lw[4 + j] = b[j]; la[j] = c[j]; la[4 + j] = d[j]; } }
#pragma unroll
              for (int j = 0; j < 8; ++j) { kkr[j] = kv[j] * cst[128 + 8 * cg + j]; ss += kkr[j] * kkr[j];
                  wd[j] = __expf(-0.6065306597126334f * __builtin_amdgcn_rcpf(1.0f + __expf(-lw[j]))); av[j] = __builtin_amdgcn_rcpf(1.0f + __expf(-la[j])); }
              ss = group8_sum(ss); const float inv = __builtin_amdgcn_rcpf(fmaxf(__builtin_amdgcn_sqrtf(ss), 1e-12f));
              float kk[8], kb[8], kd[8];
#pragma unroll
              for (int j = 0; j < 8; ++j) { kk[j] = kkr[j] * inv; kb[j] = kk[j] * av[j]; kd[j] = kv[j] * (1.0f + (av[j] - 1.0f) * cst[192 + 8 * cg + j]); bsum += rv[j] * kd[j] * cst[256 + 8 * cg + j]; }
              float ew[8];
#pragma unroll
              for (int j = 0; j < 8; ++j) ew[j] = 1.0f - wd[j];
              *(LAS u32x4*)(hK + o * 2) = packh8(kk); *(LAS u32x4*)(hK + SC_HPLANE + o * 2) = packh8(ew); *(LAS u32x4*)(hK + 2 * SC_HPLANE + o * 2) = packh8(kb); *(LAS u32x4*)(hK + 3 * SC_HPLANE + o * 2) = packh8(kd);
              bsum = group8_sum(bsum);
              if (cg == 0) BON[((size_t)(lrow0 + t) * 8 + h) * 2 + dir] = bsum; } };
        auto outp = [&](int ch) { int tlo, lrow0, slen; chunk_geo(ch, tlo, lrow0, slen); const bool isctx = ch < CTX / SC_TS; const LAS float* ybuf = ybufb + (ch & 1) * (32 * SC_YP);
            if (!isctx || emit_ctx) {
                const f32x4 ya = *(const LAS f32x4*)(ybuf + ptt * SC_YP + 8 * cg), yb = *(const LAS f32x4*)(ybuf + ptt * SC_YP + 8 * cg + 4);
                *(u32x4*)(OUT + (size_t)(lrow0 + tlo + ptok) * opitch + h * 64 + 8 * cg) = (u32x4){pk2(ya[0], ya[1]), pk2(ya[2], ya[3]), pk2(yb[0], yb[1]), pk2(yb[2], yb[3])}; } };
        issue_loads(0);
        for (int ch = -1; ch < NCH; ++ch) {
            if (ch > 0) outp(ch - 1);
            if (ch + 1 < NCH) prepare(ch + 1);
            LDS_BARRIER();
        }
        outp(NCH - 1);
    } else {
        sh2 Sa[4], Sb[4];
#pragma unroll
        for (int c = 0; c < 4; ++c) { Sa[c] = (sh2){(_Float16)0.f, (_Float16)0.f}; Sb[c] = Sa[c]; }
        const int g = lane & 7, ra = 16 * pw + (lane >> 3);
        LDS_BARRIER();
        for (int ch = 0; ch < NCH; ++ch) {
            const int set = ch & 1; const LAS sh8* fH = (const LAS sh8*)(cb + SC_H + set * SC_HSET) + g; const LAS _Float16* vbuf = (const LAS _Float16*)(cb + SC_H + set * SC_HSET + 5 * SC_HPLANE) + ra;
            LAS float* ybuf = ybufb + set * (32 * SC_YP) + g * SC_YP + ra;
            asm volatile("" : "+v"(fH), "+v"(vbuf), "+v"(ybuf));
            float yk_a = 0.f, yk_b = 0.f;
#define SC_LOAD(T, K_, E_, B_, D_, R_, VA, VB) do { const LAS sh8* q_ = fH + (T) * 8; K_ = q_[0]; E_ = q_[256]; B_ = q_[512]; D_ = q_[768]; R_ = q_[1024]; VA = vbuf[(T) * 64]; VB = vbuf[(T) * 64 + 8]; } while (0)
            sh8 k4, e4, b4, d4, r4; _Float16 va, vb;
            SC_LOAD(0, k4, e4, b4, d4, r4, va, vb);
#pragma unroll 8
            for (int st = 0; st < SC_TS; ++st) {
                const int tn = (st + 1 < SC_TS) ? st + 1 : st;
                sh8 k4n, e4n, b4n, d4n, r4n; _Float16 van, vbn;
                SC_LOAD(tn, k4n, e4n, b4n, d4n, r4n, van, vbn);
                float sa_ = 0.f, sb_ = 0.f;
#pragma unroll
                for (int c = 0; c < 4; ++c) { const sh2 kc = {k4[2 * c], k4[2 * c + 1]}; sa_ = __builtin_amdgcn_fdot2(Sa[c], kc, sa_, false); sb_ = __builtin_amdgcn_fdot2(Sb[c], kc, sb_, false); }
                const sh2 va2 = {va, va}, vb2 = {vb, vb};
#pragma unroll
                for (int c = 0; c < 4; ++c) { const sh2 ec = {e4[2 * c], e4[2 * c + 1]}, dc = {d4[2 * c], d4[2 * c + 1]};
                    Sa[c] = Sa[c] - Sa[c] * ec; Sb[c] = Sb[c] - Sb[c] * ec; Sa[c] = dc * va2 + Sa[c]; Sb[c] = dc * vb2 + Sb[c]; }
                const float nsa = -group8_sum(sa_), nsb = -group8_sum(sb_);
                const sh2 na2 = {(_Float16)nsa, (_Float16)nsa}, nb2 = {(_Float16)nsb, (_Float16)nsb};
#pragma unroll
                for (int c = 0; c < 4; ++c) { const sh2 bc = {b4[2 * c], b4[2 * c + 1]}; Sa[c] = bc * na2 + Sa[c]; Sb[c] = bc * nb2 + Sb[c]; }
                float ya_ = 0.f, yb_ = 0.f;
#pragma unroll
                for (int c = 0; c < 4; ++c) { const sh2 rc = {r4[2 * c], r4[2 * c + 1]}; ya_ = __builtin_amdgcn_fdot2(Sa[c], rc, ya_, false); yb_ = __builtin_amdgcn_fdot2(Sb[c], rc, yb_, false); }
                const float y_a = group8_sum(ya_), y_b = group8_sum(yb_);
                yk_a = g == (st & 7) ? y_a : yk_a; yk_b = g == (st & 7) ? y_b : yk_b;
                if ((st & 7) == 7) { ybuf[(st - 7) * SC_YP] = yk_a; ybuf[(st - 7) * SC_YP + 8] = yk_b; }
                k4 = k4n; e4 = e4n; b4 = b4n; d4 = d4n; r4 = r4n; va = van; vb = vbn;
            }
#undef SC_LOAD
            LDS_BARRIER();
        }
    }
    __syncthreads();
}

__device__ __forceinline__ void phaseC(Ctx& F0, int l, int hb, int rep = 0) {
    Ctx F = F0;
    volatile LAS unsigned* MISC = (volatile LAS unsigned*)(F.lds + MISC_OFF);
    unsigned* head = (unsigned*)(F.ws + WS_CTL) + CW_QUEUE + 64 * ((l * NHALF + hb) * 4 + rep);
    const bool do_ctx = (l < DEPTH - 1);
    const int N_SCAN = hb == 0 ? BATCH * 8 * 2 : 0;
    constexpr int N_MLA = NB * 8 * 16, N_GQA = NB * 2 * 64, N_WIN = NB * 2 * 64, N_CX = NB * 8 + NB * 2 * 4 + NB * 2 * 4;
    const int total = N_SCAN + N_MLA + N_GQA + N_WIN + (do_ctx ? N_CX : 0);
    const int wave = F.wave;
    for (;;) {
        __syncthreads();
        if (F.tid == 0) MISC[16] = __hip_atomic_fetch_add(head, 1u, __ATOMIC_RELAXED, __HIP_MEMORY_SCOPE_AGENT);
        __syncthreads();
        int it = (int)MISC[16];
        if (it >= total) break;
        { OPAQUE_ZERO(zq); int ln; asm volatile("v_mbcnt_lo_u32_b32 %0, -1, 0\n\tv_mbcnt_hi_u32_b32 %0, -1, %0" : "=v"(ln));
          F.ws = F0.ws + zq; F.in = F0.in + zq; F.lane = ln; F.tid = F0.wave * 64 + ln; }
        bf16_t* Y01 = (bf16_t*)(F.ws + WS_Y01); bf16_t* Y23 = (bf16_t*)(F.ws + WS_Y23);
        if (it < N_SCAN) { if (rep != 1) scan_item(F, l, it >> 4, (it >> 1) & 7, it & 1, do_ctx); continue; } it -= N_SCAN;
        bool mla, win = false, cx = false; int bl, hh, qb;
        if (it < N_MLA) { mla = true; bl = it >> 7; hh = (it >> 4) & 7; qb = it & 15; }
        else if ((it -= N_MLA) < N_GQA + N_WIN) { mla = false; win = it >= N_GQA; if (win) it -= N_GQA; bl = it >> 7; hh = (it >> 6) & 1; qb = it & 63; }
        else if ((it -= N_GQA + N_WIN) < NB * 8) { mla = true; cx = true; bl = it >> 3; hh = it & 7; qb = 0; }
        else { it -= NB * 8; mla = false; cx = true; win = it >= NB * 8; if (win) it -= NB * 8; bl = it >> 3; hh = (it >> 2) & 1; qb = it & 3; }
        if (mla) { const int h = hh, t0 = qb * 256 + wave * 32; const int lr = cx ? MLL + bl * 256 + wave * 32 : bl * 4096 + t0;
            AttnWave W{(const bf16_t*)(F.ws + R_QA) + (size_t)lr * 768 + h * 96, 768, Y01 + (size_t)grow_of(hb, lr) * D + h * 64, D, 0, cx ? nullptr : (const float*)(F.ws + WS_ROPE) + (size_t)t0 * 16};
            AttnKeys K{(const bf16_t*)(F.ws + R_KA) + h * 96, 768, (const bf16_t*)(F.ws + R_VAT) + (size_t)(bl * 8 + h) * 64 * LTOT, 0, cx ? 0 : 64, 4, bl, 0, 0, 0.f};
            attn_unit<96>(F, W, K); }
        else { const int kvh = hh, hq = 4 * kvh + (wave >> 1); const int t0 = qb * 64 + (wave & 1) * 32, lr = cx ? MLL + bl * 256 + t0 : bl * 4096 + t0;
            AttnWave W{(const bf16_t*)(F.ws + (win ? R_QD : R_QC)) + (size_t)lr * 512 + hq * 64, 512, Y23 + (size_t)grow_of(hb, lr) * D + (win ? 512 : 0) + hq * 64, D, t0, nullptr};
            AttnKeys K{(const bf16_t*)(F.ws + (win ? R_KD : R_KC)) + kvh * 64, 128, (const bf16_t*)(F.ws + (win ? R_VDT : R_VCT)) + (size_t)(bl * 2 + kvh) * 64 * LTOT, 0, cx ? 0 : 64, 4, bl, 0, win ? 1 : 0, win ? F.in[I_SINK][l * 8 + hq] * LOG2E : 0.f};
            if (win && !cx) { int p0 = qb * 64 - 128, n = 5; if (p0 < 0) { n -= (-p0) / 64; p0 = 0; } if (p0 + 64 * n > SEQ) n = (SEQ - p0) / 64; K.lat_p0 = p0; K.lat_n = n; K.wmask = 1; }
            attn_unit<64>(F, W, K); }
    }
}

__device__ __forceinline__ void phaseD(Ctx& F, int l) {
    const bool do_ctx = (l < DEPTH - 1); const int nrows = do_ctx ? MROWS : MLAT;
    LAS bf16_t* sgb = (LAS bf16_t*)F.lds;
    LAS float* vs = (LAS float*)(F.lds + 4096);
    LAS float* on = vs + 16 * 512;
    LAS float* bn = on + 16 * 512;
    const bf16_t* Pr = (const bf16_t*)(F.ws + R_PR); const bf16_t* OF = (const bf16_t*)(F.ws + WS_Y01) + 512; const bf16_t* OB = (const bf16_t*)(F.ws + R_OB);
    const float* BON = (const float*)(F.ws + WS_BON); bf16_t* Y01 = (bf16_t*)(F.ws + WS_Y01);
    const float* mu0 = F.in[I_MU] + (size_t)l * 2 * 1920, * mu1 = mu0 + 1920;
    const int lane = F.lane, w = F.wave, n16 = lane & 15, kg = lane >> 4;
    bf16x8 bf[4][4];
    { const bf16_t* g2T = (const bf16_t*)(F.ws + WS_LORA) + 2 * (2 * 2 * 8 * 4096) + (size_t)l * 512 * 128;
#pragma unroll
      for (int ct = 0; ct < 4; ++ct)
#pragma unroll
          for (int ks = 0; ks < 4; ++ks) bf[ct][ks] = *(const bf16x8*)(g2T + (size_t)(64 * w + 16 * ct + n16) * 128 + 32 * ks + 8 * kg); }
    float lg[4], lb[4];
#pragma unroll
    for (int ct = 0; ct < 4; ++ct) { lg[ct] = F.in[I_LNG][l * 512 + 64 * w + 16 * ct + n16]; lb[ct] = F.in[I_LNB][l * 512 + 64 * w + 16 * ct + n16]; }
    for (int r0 = F.bid * 16; r0 < nrows; r0 += F.G * 16) {
        __syncthreads();
#pragma unroll
        for (int rr = 0; rr < 2; ++rr) { const int li = 2 * w + rr, lr = r0 + li; const bool lat = lr < MLAT; const int t = lat ? (lr & 4095) : ((lr - MLAT) & 255), slen = lat ? SEQ : CTX;
          const bf16_t* p = Pr + (size_t)lr * 2048;
          auto shifted = [&](int col, float (&sh)[8]) { float x[8], xp[8], xn[8]; unpack8(*(const u32x4*)(p + col), x);
              unpack8(*(const u32x4*)(p + col - (t > 0 ? 2048 : 0)), xp); unpack8(*(const u32x4*)(p + col + (t < slen - 1 ? 2048 : 0)), xn);
              const float zp = t > 0 ? 1.f : 0.f, zn = t < slen - 1 ? 1.f : 0.f;
#pragma unroll
              for (int j = 0; j < 8; ++j) sh[j] = x[j] + mu0[col + j] * (xp[j] * zp - x[j]) + mu1[col + j] * (xn[j] * zn - x[j]); };
          float sh[8];
          shifted(1024 + lane * 8, sh);
          *(LAS f32x4*)(vs + li * 512 + lane * 8) = (f32x4){sh[0], sh[1], sh[2], sh[3]}; *(LAS f32x4*)(vs + li * 512 + lane * 8 + 4) = (f32x4){sh[4], sh[5], sh[6], sh[7]};
          if (lane < 16) { shifted(1792 + lane * 8, sh);
#pragma unroll
              for (int j = 0; j < 8; ++j) sh[j] = sigmoidf_(sh[j]);
              *(LAS u32x4*)(sgb + li * 128 + lane * 8) = pack8(sh); }
          float a[8], b[8]; unpack8(*(const u32x4*)(OF + (size_t)lr * D + lane * 8), a); unpack8(*(const u32x4*)(OB + (size_t)lr * 512 + lane * 8), b);
          float s_ = 0.f;
#pragma unroll
          for (int j = 0; j < 8; ++j) { a[j] += b[j]; s_ += a[j]; }
          const float mean = group8_sum(s_) * (1.f / 64.f); float q = 0.f;
#pragma unroll
          for (int j = 0; j < 8; ++j) { a[j] -= mean; q += a[j] * a[j]; }
          const float rstd = __builtin_amdgcn_rsqf(group8_sum(q) * (1.f / 64.f) + GN_EPS);
          *(LAS f32x4*)(on + li * 512 + lane * 8) = (f32x4){a[0] * rstd, a[1] * rstd, a[2] * rstd, a[3] * rstd}; *(LAS f32x4*)(on + li * 512 + lane * 8 + 4) = (f32x4){a[4] * rstd, a[5] * rstd, a[6] * rstd, a[7] * rstd};
          if (lane < 8) { const size_t gi = ((size_t)lr * 8 + lane) * 2; bn[li * 8 + lane] = BON[gi] + BON[gi + 1]; } }
        __syncthreads();
        f32x4 acc[4];
#pragma unroll
        for (int ct = 0; ct < 4; ++ct) acc[ct] = (f32x4){0.f, 0.f, 0.f, 0.f};
#pragma unroll
        for (int ks = 0; ks < 4; ++ks) { const bf16x8 af = *(const LAS bf16x8*)(sgb + n16 * 128 + 32 * ks + 8 * kg);
#pragma unroll
            for (int ct = 0; ct < 4; ++ct) acc[ct] = __builtin_amdgcn_mfma_f32_16x16x32_bf16(af, bf[ct][ks], acc[ct], 0, 0, 0); }
#pragma unroll
        for (int ct = 0; ct < 4; ++ct) { const int n = 64 * w + 16 * ct + n16;
#pragma unroll
            for (int r = 0; r < 4; ++r) { const int li = 4 * kg + r;
                const float y = (on[li * 512 + n] * lg[ct] + lb[ct] + bn[li * 8 + w] * vs[li * 512 + n]) * acc[ct][r];
                Y01[(size_t)(r0 + li) * D + 512 + n] = (bf16_t)f2bf(y); } }
    }
    __syncthreads();
}

constexpr size_t WS_PRE = WS_R;
constexpr size_t WS_X1 = WS_R + 68 * MiB;
constexpr size_t R_ACC = WS_R + 100 * MiB;
constexpr size_t R_CTXP = WS_R + 170 * MiB;
struct SchedE {
    pg8::TileOrder T; unsigned char* ws; int ctxjobs, c;
    __device__ __forceinline__ bool next(int i, pg8::Unit& u) const { int tm, tn, sub, br; bool cj = false;
        if (T.tile(i >> 3, tm, tn)) { sub = i & 7; br = sub >> 1; }
        else { if (!ctxjobs || i < 16 || i > 17 || c >= 128) return false; const int tile = c >> 2; br = c & 3; tm = MLAT / 256 + (tile >> 2); tn = tile & 3; sub = 2 * br + (i & 1); cj = true; }
        u.pm = tm; u.pn = tn; u.kind = sub | (cj ? 8 : 0);
        if (!(sub & 1)) { u.a = (const char*)(ws + WS_XMOD) + (size_t)tm * 256 * D * 2; u.b = (const char*)(ws + WS_WIN) + (size_t)(4096 + br * 1024 + tn * 256) * D * 2; u.nt = 16; }
        else { u.a = (const char*)(ws + (br < 2 ? WS_Y01 : WS_Y23)) + (size_t)tm * 256 * D * 2 + (br & 1) * 512 * 2;
               u.b = (const char*)(ws + WS_WBR) + (size_t)(br >> 1) * D * D * 2 + (size_t)tn * 256 * D * 2 + (br & 1) * 512 * 2; u.nt = 8; }
        return true; }
};
__device__ __forceinline__ float sig255(float x) { return __builtin_amdgcn_rcpf(__builtin_fmaf(__expf(-x), 1.0f / 255.0f, 1.0f / 255.0f)); }
struct EpiMerge {
    unsigned char* ws; int bid; int tid0;
    __device__ __forceinline__ void operator()(const f32x4 (&acc)[2][2][4][2], const pg8::Unit& u, int wr, int wc, int fr, int fq) const {
        OPAQUE_ZERO(z0); unsigned char* ws = this->ws + z0;
        int tid = tid0; asm volatile("" : "+v"(tid));
        u32x4* sp = (u32x4*)(ws + R_ESCR + (size_t)bid * ESCR_PER_BLOCK) + tid; u32x4* pp = (u32x4*)(ws + R_ESCR + (size_t)bid * ESCR_PER_BLOCK + 131072) + tid;
        if (!(u.kind & 1)) {
#pragma unroll
            for (int ai = 0; ai < 2; ++ai)
#pragma unroll
                for (int m = 0; m < 4; ++m) { u32x4 w;
#pragma unroll
                    for (int bj = 0; bj < 2; ++bj) { const f32x4 v0 = acc[ai][bj][m][0], v1 = acc[ai][bj][m][1]; unsigned a_ = 0u, b_ = 0u;
#pragma unroll
                        for (int j = 0; j < 4; ++j) { a_ = __builtin_amdgcn_cvt_pk_u8_f32(sig255(v0[j]), j, a_); b_ = __builtin_amdgcn_cvt_pk_u8_f32(sig255(v1[j]), j, b_); }
                        w[2 * bj] = a_; w[2 * bj + 1] = b_; }
                    *sp = w; sp += 512; asm volatile("" : "+v"(sp) :: "memory"); }
        } else {
            const int br = (u.kind & 7) >> 1; const bool cj = (u.kind & 8) != 0;
            float* cp = (float*)(ws + R_CTXP) + ((size_t)br * MCTX + (u.pm * 256 - MLAT) + wr * 64 + fr) * D + u.pn * 256 + wc * 32 + 8 * fq;
            bf16_t* op = (bf16_t*)(ws + R_ACC) + (size_t)(u.pm * 256 + wr * 64 + fr) * D + u.pn * 256 + wc * 32 + 8 * fq;
#pragma unroll
            for (int ai = 0; ai < 2; ++ai)
#pragma unroll
                for (int m = 0; m < 4; ++m) { const u32x4 gs = *sp;
#pragma unroll
                    for (int bj = 0; bj < 2; ++bj) { const unsigned ga = gs[2 * bj], gb = gs[2 * bj + 1];
                        f32x4 v0 = acc[ai][bj][m][0], v1 = acc[ai][bj][m][1];
#pragma unroll
                        for (int j = 0; j < 4; ++j) { v0[j] *= (float)((ga >> (8 * j)) & 0xffu); v1[j] *= (float)((gb >> (8 * j)) & 0xffu); }
                        if (cj) { float* q = cp + (size_t)(ai * 128 + m * 16) * D + bj * 128; *(f32x4*)q = v0 * (1.0f / 255.0f); *(f32x4*)(q + 4) = v1 * (1.0f / 255.0f); }
                        else if (br > 0) { float q_[8]; unpack8(*pp, q_); v0 += (f32x4){q_[0], q_[1], q_[2], q_[3]}; v1 += (f32x4){q_[4], q_[5], q_[6], q_[7]}; }
                        if (cj) {}
                        else if (br < 3) { u32x4 w; w.x = pg8::cvt_pk_bf16(v0[0], v0[1]); w.y = pg8::cvt_pk_bf16(v0[2], v0[3]); w.z = pg8::cvt_pk_bf16(v1[0], v1[1]); w.w = pg8::cvt_pk_bf16(v1[2], v1[3]); *pp = w; }
                        else { v0 = v0 * (1.0f / 255.0f); v1 = v1 * (1.0f / 255.0f);
                            u32x4 w; w.x = pg8::cvt_pk_bf16(v0[0], v0[1]); w.y = pg8::cvt_pk_bf16(v0[2], v0[3]); w.z = pg8::cvt_pk_bf16(v1[0], v1[1]); w.w = pg8::cvt_pk_bf16(v1[2], v1[3]);
                            *(u32x4*)(op + (size_t)(ai * 128 + m * 16) * D + bj * 128) = w; }
                        pp += 512; asm volatile("" : "+v"(pp) :: "memory"); }
                    sp += 512; asm volatile("" : "+v"(sp) :: "memory"); }
        }
    }
};
__device__ __forceinline__ void phaseE(Ctx& F, int l) {
    SchedE S; S.T.init(MLAT / 256, 4, F.G, F.bid); S.ws = F.ws; S.ctxjobs = (l < DEPTH - 1) ? 1 : 0; S.c = F.bid;
    EpiMerge E{F.ws, F.bid, F.tid};
    pg8::gemm_phase<EpiMerge, SchedE>(F.lds, F.wave, D, D, S, E);
}
__device__ __forceinline__ void phaseE2(Ctx& F) {
    const int gt = F.bid * NTHREADS + F.tid, NGT = F.G * NTHREADS;
    const float* cp = (const float*)(F.ws + R_CTXP); bf16_t* acc = (bf16_t*)(F.ws + R_ACC) + (size_t)MLAT * D;
    for (int e = gt; e < MCTX * D / 8; e += NGT) { float v[8];
#pragma unroll
        for (int j = 0; j < 8; ++j) v[j] = 0.f;
#pragma unroll
        for (int br = 0; br < 4; ++br) { const f32x4 a = *(const f32x4*)(cp + (size_t)br * MCTX * D + (size_t)e * 8), b = *(const f32x4*)(cp + (size_t)br * MCTX * D + (size_t)e * 8 + 4);
#pragma unroll
            for (int j = 0; j < 4; ++j) { v[j] += a[j]; v[4 + j] += b[j]; } }
        *(u32x4*)(acc + (size_t)e * 8) = pack8(v); }
}

__device__ __forceinline__ float* stream_row(const Ctx& F, int grow) { return grow < MLAT ? F.out + (size_t)grow * D : (float*)(F.ws + WS_XSC) + (size_t)(grow - MLAT) * D; }
struct SchedF {
    pg8::TileOrder T; const char* A; const char* B; int nt;
    __device__ __forceinline__ bool next(int i, pg8::Unit& u) const { int tm, tn; if (!T.tile(i, tm, tn)) return false;
        u.a = A + (size_t)tm * 256 * D * 2; u.b = B + (size_t)tn * 256 * D * 2; u.nt = nt; u.pm = tm; u.pn = tn; u.kind = 0; return true; }
};
struct EpiOut {
    Ctx F; int l;
    __device__ __forceinline__ void operator()(const f32x4 (&acc)[2][2][4][2], const pg8::Unit& u, int wr, int wc, int fr, int fq) const {
        int row = u.pm * 256 + wr * 64 + fr; const int c0 = u.pn * 256 + wc * 32 + 8 * fq;
#pragma unroll
        for (int ai = 0; ai < 2; ++ai) {
#pragma unroll
            for (int m = 0; m < 4; ++m) { _Float16* po = (_Float16*)(F.ws + WS_PRE) + (size_t)row * D + c0;
                const float* gt = mod_ptr(F, l, mod_slot(row)) + 2048 + c0;
#pragma unroll
                for (int bj = 0; bj < 2; ++bj) { const int c = bj * 128; f32x4 x0, x1;
                    if (l == 0) { const float* xi = (row < MLAT ? F.in[I_X] + (size_t)row * D : F.in[I_CTX] + (size_t)(row - MLAT) * D) + c0 + c; x0 = *(const f32x4*)xi; x1 = *(const f32x4*)(xi + 4); }
                    else { const sh8 h = *(const sh8*)((const _Float16*)F.out + (size_t)row * D + c0 + c); x0 = (f32x4){(float)h[0], (float)h[1], (float)h[2], (float)h[3]}; x1 = (f32x4){(float)h[4], (float)h[5], (float)h[6], (float)h[7]}; }
                    const f32x4 g0 = *(const f32x4*)(gt + c), g1 = *(const f32x4*)(gt + c + 4);
                    const f32x4 r0 = x0 * ALPHA + g0 * acc[ai][bj][m][0], r1 = x1 * ALPHA + g1 * acc[ai][bj][m][1];
                    *(u32x4*)(po + c) = (u32x4){pkh2(r0[0], r0[1]), pkh2(r0[2], r0[3]), pkh2(r1[0], r1[1]), pkh2(r1[2], r1[3])}; }
                row += 16; asm volatile("" : "+v"(row) :: "memory"); }
            row += 64; }
    }
};
__device__ __forceinline__ void phaseF(Ctx& F, int l) {
    SchedF S; S.T.init((l < DEPTH - 1 ? MROWS : MLAT) / 256, 4, F.G, F.bid); S.A = (const char*)(F.ws + R_ACC); S.B = (const char*)(F.ws + WS_WOUT); S.nt = 16;
    EpiOut E{F, l};
    pg8::gemm_phase<EpiOut, SchedF>(F.lds, F.wave, D, D, S, E);
}
__device__ __forceinline__ void ln_row(f32x4 (&v)[4], const float* g, const float* b, int lane) {
    float s = 0.f;
#pragma unroll
    for (int j = 0; j < 4; ++j) s += (v[j].x + v[j].y) + (v[j].z + v[j].w);
    const float mean = wave_sum(s) * (1.f / D); float s2 = 0.f;
#pragma unroll
    for (int j = 0; j < 4; ++j) { v[j] = v[j] - mean; s2 += (v[j].x * v[j].x + v[j].y * v[j].y) + (v[j].z * v[j].z + v[j].w * v[j].w); }
    const float rstd = __builtin_amdgcn_rsqf(wave_sum(s2) * (1.f / D) + LN_EPS);
#pragma unroll
    for (int j = 0; j < 4; ++j) { const int c = j * 256 + lane * 4; v[j] = v[j] * rstd * *(const f32x4*)(g + c) + *(const f32x4*)(b + c); }
}
__device__ __forceinline__ void phaseF2(Ctx& F, int l) {
    const int gw = F.bid * NWAVES + F.wave, NGW = F.G * NWAVES; const int nrows = l < DEPTH - 1 ? MROWS : MLAT;
    bf16_t* hmod = (bf16_t*)(F.ws + WS_XMOD);
    for (int r = gw; r < nrows; r += NGW) {
        const _Float16* pr = (const _Float16*)(F.ws + WS_PRE) + (size_t)r * D; _Float16* x1o = (_Float16*)(F.ws + WS_X1) + (size_t)r * D; const float* md = mod_ptr(F, l, mod_slot(r));
        f32x4 v[4];
#pragma unroll
        for (int j = 0; j < 4; ++j) { const sh4 h = *(const sh4*)(pr + j * 256 + F.lane * 4); v[j] = (f32x4){(float)h[0], (float)h[1], (float)h[2], (float)h[3]}; }
        ln_row(v, F.in[I_LN1G] + l * D, F.in[I_LN1B] + l * D, F.lane);
#pragma unroll
        for (int j = 0; j < 4; ++j) { const int c = j * 256 + F.lane * 4; *(u32x2*)(x1o + c) = (u32x2){pkh2(v[j].x, v[j].y), pkh2(v[j].z, v[j].w)};
            const f32x4 sh = *(const f32x4*)(md + 3072 + c), sc = *(const f32x4*)(md + 4096 + c);
            u32x2 o; o.x = pk2(v[j].x * (1.f + sc.x) + sh.x, v[j].y * (1.f + sc.y) + sh.y); o.y = pk2(v[j].z * (1.f + sc.z) + sh.z, v[j].w * (1.f + sc.w) + sh.w);
            *(u32x2*)(hmod + (size_t)r * D + c) = o; }
    }
}

struct EpiScores {
    _Float16* SC;
    __device__ __forceinline__ void operator()(const f32x4 (&acc)[2][2][4][2], const pg8::Unit& u, int wr, int wc, int fr, int fq) const {
        OPAQUE_ZERO(z0); _Float16* sp = SC + z0 + (size_t)(u.pm * 256 + wr * 64 + fr) * 2048 + u.pn * 256 + wc * 32 + 8 * fq;
#pragma unroll
        for (int ai = 0; ai < 2; ++ai) {
#pragma unroll
            for (int m = 0; m < 4; ++m) {
#pragma unroll
                for (int bj = 0; bj < 2; ++bj) { const f32x4 v0 = acc[ai][bj][m][0], v1 = acc[ai][bj][m][1];
                    *(u32x4*)(sp + bj * 128) = (u32x4){pkh2(v0[0], v0[1]), pkh2(v0[2], v0[3]), pkh2(v1[0], v1[1]), pkh2(v1[2], v1[3])}; }
                sp += 16 * 2048; asm volatile("" : "+v"(sp) :: "memory"); }
            sp += 64 * 2048; }
    }
};
__device__ __forceinline__ void phaseG(Ctx& F, int l) {
    SchedF S; S.T.init((l < DEPTH - 1 ? MROWS : MLAT) / 256, 8, F.G, F.bid); S.A = (const char*)(F.ws + WS_XMOD); S.B = (const char*)(F.ws + WS_WPK); S.nt = 16;
    EpiScores E{(_Float16*)(F.ws + WS_SC)};
    pg8::gemm_phase<EpiScores, SchedF>(F.lds, F.wave, D, D, S, E);
}

__device__ __forceinline__ unsigned fkey(float f) { const unsigned u = __float_as_uint(f); return (u & 0x80000000u) ? ~u : (u | 0x80000000u); }
__device__ __forceinline__ float kval(unsigned k) { const unsigned u = (k & 0x80000000u) ? (k & 0x7fffffffu) : ~k; return __uint_as_float(u); }
__device__ __forceinline__ void ce_desc(unsigned& a, unsigned& b) { const unsigned hi_ = a > b ? a : b, lo_ = a > b ? b : a; a = hi_; b = lo_; }
__device__ __forceinline__ void bitonic_merge16(unsigned (&a)[16]) {
#pragma unroll
    for (int j = 8; j > 0; j >>= 1) {
#pragma unroll
        for (int i = 0; i < 16; ++i) { const int l_ = i ^ j; if (l_ > i) ce_desc(a[i], a[l_]); } }
}
__device__ __forceinline__ void sort16_desc(unsigned (&a)[16]) {
#pragma unroll
    for (int k = 2; k <= 16; k <<= 1) {
#pragma unroll
        for (int j = k >> 1; j > 0; j >>= 1) {
#pragma unroll
            for (int i = 0; i < 16; ++i) { const int l_ = i ^ j; if (l_ > i) { if ((i & k) == 0) ce_desc(a[i], a[l_]); else ce_desc(a[l_], a[i]); } } } }
}
constexpr int ST_I[50] = {0,0,0,0,0,0,0,0,0,0,0,0,0,0,0,0, 1,1,1,1,1,1,1,1, 2,2,2,2,2, 3,3,3,3, 4,4,4, 5,5, 6,6, 7,7, 8, 9, 10, 11, 12, 13, 14, 15};
constexpr int ST_J[50] = {0,1,2,3,4,5,6,7,8,9,10,11,12,13,14,15, 0,1,2,3,4,5,6,7, 0,1,2,3,4, 0,1,2,3, 0,1,2, 0,1, 0,1, 0,1, 0, 0, 0, 0, 0, 0, 0, 0};
__device__ __forceinline__ unsigned fp6_code(float x) {
    const float a = fminf(fabsf(x), 7.5f);
    int e = (int)((__float_as_uint(a) >> 23) & 0xffu) - 127; e = e < 0 ? 0 : e;
    const unsigned q = (unsigned)(int)__builtin_rintf(__builtin_ldexpf(a, 3 - e));
    return (q + ((unsigned)e << 3)) | ((__float_as_uint(x) >> 26) & 32u);
}
__device__ __forceinline__ void phaseH(Ctx& F, int l) {
    const int gt = F.bid * NTHREADS + F.tid, NGT = F.G * NTHREADS; const int nrows = l < DEPTH - 1 ? MROWS : MLAT;
    { const float* pu = F.in[I_PU] + (size_t)l * 16384 * 1024; const float* pv = F.in[I_PV] + (size_t)l * 16384 * 1024; unsigned char* tu = F.ws + WS_TU;
      for (int task = gt; task < 16384 * 64; task += NGT) { const int c8 = task & 7, sl = (task >> 3) & 3, part = (task >> 5) & 1, e = task >> 6;
          const float* s = (part ? pv : pu) + (size_t)e * 1024 + 256 * sl + 4 * c8; const float sc = part ? PEER_SV : PEER_SU;
          unsigned dw[6];
#pragma unroll
          for (int hf = 0; hf < 2; ++hf) { unsigned c[16];
#pragma unroll
              for (int j = 0; j < 4; ++j) { const f32x4 a = *(const f32x4*)(s + 32 * (4 * hf + j)) * sc;
#pragma unroll
                  for (int k = 0; k < 4; ++k) c[4 * j + k] = fp6_code(a[k]); }
              dw[3 * hf] = c[0] | (c[1] << 6) | (c[2] << 12) | (c[3] << 18) | (c[4] << 24) | (c[5] << 30);
              dw[3 * hf + 1] = (c[5] >> 2) | (c[6] << 4) | (c[7] << 10) | (c[8] << 16) | (c[9] << 22) | (c[10] << 28);
              dw[3 * hf + 2] = (c[10] >> 4) | (c[11] << 2) | (c[12] << 8) | (c[13] << 14) | (c[14] << 20) | (c[15] << 26); }
          unsigned char* row = tu + (size_t)part * PEER_TBL + (size_t)sl * PEER_SLICE + (size_t)e * 192;
          *(u32x4*)(row + c8 * 16) = (u32x4){dw[0], dw[1], dw[2], dw[3]};
          *(u32x2*)(row + 128 + c8 * 8) = (u32x2){dw[4], dw[5]}; } }
    const _Float16* SC = (const _Float16*)(F.ws + WS_SC); int* IDX = (int*)(F.ws + WS_IDX); float* WGT = (float*)(F.ws + WS_WGT);
    LAS float* stg = (LAS float*)(F.lds + 65536);
    const int tid = F.tid;
    __syncthreads();
    for (int base = F.bid * NTHREADS; base < nrows * 16; base += NGT) {
        const int task = base + tid, row = task >> 4, g = task & 15;
        const _Float16* src = SC + (size_t)base * 128;
        sh4 pre[4];
#pragma unroll
        for (int i = 0; i < 4; ++i) { const int idx = i * 512 + tid; pre[i] = *(const sh4*)(src + (size_t)(idx >> 2) * 128 + (idx & 3) * 4); }
        unsigned t[16];
#pragma unroll
        for (int ps = 0; ps < 8; ++ps) {
            LAS float* sb = stg + (ps & 1) * (512 * 17);
#pragma unroll
            for (int i = 0; i < 4; ++i) { const int idx = i * 512 + tid; LAS float* d = sb + (idx >> 2) * 17 + (idx & 3) * 4; d[0] = (float)pre[i][0]; d[1] = (float)pre[i][1]; d[2] = (float)pre[i][2]; d[3] = (float)pre[i][3]; }
            if (ps + 1 < 8) {
#pragma unroll
                for (int i = 0; i < 4; ++i) { const int idx = i * 512 + tid; pre[i] = *(const sh4*)(src + (size_t)(idx >> 2) * 128 + (ps + 1) * 16 + (idx & 3) * 4); } }
            LDS_BARRIER();
            unsigned b[16];
#pragma unroll
            for (int k = 0; k < 16; ++k) b[k] = (fkey(sb[tid * 17 + k]) & ~127u) | (unsigned)(127 - (ps * 16 + k));
            sort16_desc(b);
            if (ps == 0) {
#pragma unroll
                for (int k = 0; k < 16; ++k) t[k] = b[k]; }
            else {
#pragma unroll
                for (int k = 0; k < 16; ++k) t[k] = t[k] > b[15 - k] ? t[k] : b[15 - k];
                bitonic_merge16(t); }
        }
        unsigned o[16];
#pragma unroll
        for (int i = 0; i < 16; ++i) o[i] = dpp_u<0xB1>(t[i]);
        const bool odd = g & 1; const unsigned omask = odd ? 0xffffffffu : 0u;
        float v1[16], v2[16];
        LAS int* L1 = (LAS int*)F.lds + F.tid; LAS int* L2 = L1 + 16 * 512;
#pragma unroll
        for (int i = 0; i < 16; ++i) { const unsigned dx = (t[i] ^ o[i]) & omask; const unsigned a = t[i] ^ dx, b = o[i] ^ dx;
            v1[i] = kval(a & ~127u); v2[i] = kval(b & ~127u); L1[i * 512] = 127 - (int)(a & 127u); L2[i * 512] = 127 - (int)(b & 127u); }
        unsigned bk[16];
#define STAIR_KEY(N) ((fkey(v1[ST_I[N]] + v2[ST_J[N]]) & ~255u) | (unsigned)(ST_I[N] * 16 + ST_J[N]))
#pragma unroll
        for (int k = 0; k < 16; ++k) bk[k] = STAIR_KEY(k);
        sort16_desc(bk);
#pragma unroll
        for (int blk = 1; blk < 3; ++blk) { unsigned b[16];
#pragma unroll
            for (int k = 0; k < 16; ++k) b[k] = STAIR_KEY(16 * blk + k);
            sort16_desc(b);
#pragma unroll
            for (int k = 0; k < 16; ++k) bk[k] = bk[k] > b[15 - k] ? bk[k] : b[15 - k];
            bitonic_merge16(bk); }
#pragma unroll
        for (int n = 48; n < 50; ++n) { unsigned x = STAIR_KEY(n);
#pragma unroll
            for (int q = 0; q < 16; ++q) { const unsigned hi_ = bk[q] > x ? bk[q] : x; x = bk[q] > x ? x : bk[q]; bk[q] = hi_; } }
#undef STAIR_KEY
        float den = 0.f; float w[16]; const float smax = kval(bk[0] & ~255u);
#pragma unroll
        for (int q = 0; q < 16; ++q) { w[q] = __expf(kval(bk[q] & ~255u) - smax); den += w[q]; }
        const float inv = 1.0f / den;
        if (!odd) { const int h = g >> 1; int* io = IDX + (size_t)row * 128 + h * 16; float* wo = WGT + (size_t)row * 128 + h * 16;
#pragma unroll
            for (int q4 = 0; q4 < 4; ++q4) { int e[4];
#pragma unroll
                for (int j = 0; j < 4; ++j) { const unsigned k = bk[4 * q4 + j]; e[j] = L1[((k >> 4) & 15u) * 512] * 128 + L2[(k & 15u) * 512]; }
                *(int4*)(io + 4 * q4) = make_int4(e[0], e[1], e[2], e[3]);
                *(f32x4*)(wo + 4 * q4) = (f32x4){w[4 * q4] * inv, w[4 * q4 + 1] * inv, w[4 * q4 + 2] * inv, w[4 * q4 + 3] * inv}; } }
    }
}

__device__ __forceinline__ void unpack16(const u32x4 a, const u32x4 b, float (&v)[16]) {
    v[0] = bflo(a.x); v[1] = bfhi(a.x); v[2] = bflo(a.y); v[3] = bfhi(a.y); v[4] = bflo(a.z); v[5] = bfhi(a.z); v[6] = bflo(a.w); v[7] = bfhi(a.w);
    v[8] = bflo(b.x); v[9] = bfhi(b.x); v[10] = bflo(b.y); v[11] = bfhi(b.y); v[12] = bflo(b.z); v[13] = bfhi(b.z); v[14] = bflo(b.w); v[15] = bfhi(b.w); }
__device__ __forceinline__ f32x2 gelu_pk(f32x2 v) {
    const f32x2 av = __builtin_elementwise_abs(v), d = av * 0.2316418882f + 1.0f;
    f32x2 t; t.x = __builtin_amdgcn_rcpf(d.x); t.y = __builtin_amdgcn_rcpf(d.y);
    f32x2 q = t * 0.5307027145f + (-0.7265760135f); q = q * t + 0.7107068705f; q = q * t + (-0.142248368f); q = q * t + 0.127414796f; q = q * t;
    const f32x2 s = (v * v) * (-0.72134752044f);
    f32x2 e; e.x = __builtin_amdgcn_exp2f(s.x); e.y = __builtin_amdgcn_exp2f(s.y);
    const f32x2 m = v * (q * e), r = v - m;
    f32x2 o; o.x = v.x < 0.f ? m.x : r.x; o.y = v.y < 0.f ? m.y : r.y; return o;
}
typedef unsigned u32x6 __attribute__((ext_vector_type(6)));
typedef unsigned u32x16 __attribute__((ext_vector_type(16)));
typedef float f32x32 __attribute__((ext_vector_type(32)));
typedef __bf16 hbf16x32 __attribute__((ext_vector_type(32)));
typedef __bf16 hbf16x2 __attribute__((ext_vector_type(2)));
__device__ __forceinline__ float gelu1(float v) {
    const float av = fabsf(v), t = __builtin_amdgcn_rcpf(av * 0.2316418882f + 1.0f);
    float q = t * 0.5307027145f + (-0.7265760135f); q = q * t + 0.7107068705f; q = q * t + (-0.142248368f); q = q * t + 0.127414796f; q = q * t;
    const float e = __builtin_amdgcn_exp2f((v * v) * (-0.72134752044f));
    const float m = v * (q * e);
    return v < 0.f ? m : v - m;
}
__device__ __forceinline__ void grid_bar_in_phase(Ctx& F) {
    XcdBarrier b_; b_.bar = (unsigned*)(F.ws + WS_CTL) + CW_BAR; b_.x = xb_xcc_id(); b_.st = (volatile LAS unsigned*)(F.lds + MISC_OFF) + 8; xcd_barrier(b_, F.tid == 0);
}
__device__ __forceinline__ f32x4 ldbf4(const bf16_t* p) { const u32x2 w = *(const u32x2*)p; return (f32x4){bflo(w.x), bfhi(w.x), bflo(w.y), bfhi(w.y)}; }
__device__ __forceinline__ void phaseI(Ctx& F, int l) {
    const int gw = F.bid * NWAVES + F.wave, NGW = F.G * NWAVES, lane = F.lane; const int nrows = l < DEPTH - 1 ? MROWS : MLAT;
    const bf16_t* hmod = (const bf16_t*)(F.ws + WS_XMOD); const unsigned char* TUu = F.ws + WS_TU; const unsigned char* TUv = TUu + PEER_TBL;
    const int* IDX = (const int*)(F.ws + WS_IDX); const float* WGT = (const float*)(F.ws + WS_WGT);
    bf16_t* xmod = (bf16_t*)(F.ws + WS_XMOD); bf16_t* FFNB = (bf16_t*)(F.ws + WS_FFN);
    const int c8 = lane & 7, eg = lane >> 3; const bool lb0 = (lane & 1) != 0, lb1 = (lane & 2) != 0, lb2 = (lane & 4) != 0; const int il = (lb2 ? 4 : 0) + (lb0 ? 2 : 0) + (lb1 ? 1 : 0);
    LAS float* pre = (LAS float*)F.lds + F.wave * (17 * 128);
    const int ntok = (nrows - gw + NGW - 1) / NGW;
#define PI_LOADS(TB, QA, QB, ID) do { unsigned o_[8]; \
            _Pragma("unroll") for (int i = 0; i < 8; ++i) o_[i] = (unsigned)__builtin_amdgcn_ds_bpermute(4 * (8 * i + eg), (int)(ID)); \
            _Pragma("unroll") for (int i = 0; i < 8; ++i) { QA[i] = *(const u32x4*)(TB + (o_[i] + (unsigned)c8 * 16u)); QB[i] = *(const u32x2*)(TB + (o_[i] + (unsigned)c8 * 8u) + 128); } \
            __builtin_amdgcn_sched_barrier(0); } while (0)
    for (int sl = 0; sl < 4; ++sl) {
        const unsigned char* tb = TUu + (size_t)sl * PEER_SLICE;
        unsigned hh[16], hhn[16];
        unsigned id0, id1, id0n = 0u, id1n = 0u;
#define PI_META_U(R, H, I0, I1) do { const bf16_t* hp = hmod + (size_t)(R) * D + 256 * sl + 4 * c8; \
            _Pragma("unroll") for (int j = 0; j < 8; ++j) { const u32x2 w = *(const u32x2*)(hp + 32 * j); H[2 * j] = w.x; H[2 * j + 1] = w.y; } \
            I0 = (unsigned)IDX[(size_t)(R) * 128 + lane] * 192u; I1 = (unsigned)IDX[(size_t)(R) * 128 + 64 + lane] * 192u; } while (0)
#define PI_CONSUME_U(QA, QB, KEEP) do { float t_[8]; \
            _Pragma("unroll") for (int i = 0; i < 8; ++i) { \
                const u32x6 u6 = {QA[i].x, QA[i].y, QA[i].z, QA[i].w, QB[i].x, QB[i].y}; \
                const hbf16x32 ub = __builtin_amdgcn_cvt_scalef32_pk32_bf16_fp6(u6, 1.0f); \
                float q_[4] = {0.f, 0.f, 0.f, 0.f};        \
                _Pragma("unroll") for (int m = 0; m < 16; ++m) { hbf16x2 a_; a_[0] = ub[2 * m]; a_[1] = ub[2 * m + 1]; q_[m & 3] = __builtin_amdgcn_fdot2_f32_bf16(a_, __builtin_bit_cast(hbf16x2, hh[m]), q_[m & 3], false); } \
                t_[i] = (q_[0] + q_[1]) + (q_[2] + q_[3]); __builtin_amdgcn_sched_barrier(0); } \
              \
            float a_[4]; _Pragma("unroll") for (int k = 0; k < 4; ++k) { const float kp = lb2 ? t_[4 + k] : t_[k], sd = lb2 ? t_[k] : t_[4 + k]; a_[k] = kp + dpp_f<0x141>(sd); } \
            float b_[2]; _Pragma("unroll") for (int k = 0; k < 2; ++k) { const float kp = lb0 ? a_[2 + k] : a_[k], sd = lb0 ? a_[k] : a_[2 + k]; b_[k] = kp + dpp_f<0xB1>(sd); } \
            { const float kp = lb1 ? b_[1] : b_[0], sd = lb1 ? b_[0] : b_[1]; KEEP = kp + dpp_f<0x4E>(sd); } } while (0)
        PI_META_U(gw, hh, id0, id1);
        u32x4 qaA[8], qaB[8]; u32x2 qbA[8], qbB[8];
        PI_LOADS(tb, qaA, qbA, id0);
        for (int kt = 0; kt < ntok; ++kt) {
            const bool has_next = kt + 1 < ntok;
            if (has_next) PI_META_U(gw + (kt + 1) * NGW, hhn, id0n, id1n);
            __builtin_amdgcn_sched_barrier(0);
            PI_LOADS(tb, qaB, qbB, id1);
            float ka, kb;
            PI_CONSUME_U(qaA, qbA, ka);
            if (has_next) PI_LOADS(tb, qaA, qbA, id0n);
            PI_CONSUME_U(qaB, qbB, kb);
            LAS float* pp = pre + kt * 128 + 8 * il + eg;
            if (sl == 0) { pp[0] = ka; pp[64] = kb; } else { pp[0] += ka; pp[64] += kb; }
            id0 = id0n; id1 = id1n;
#pragma unroll
            for (int m = 0; m < 16; ++m) hh[m] = hhn[m];
        }
#undef PI_META_U
#undef PI_CONSUME_U
    }
    { int kt = 0;
      for (int r = gw; r < nrows; r += NGW, ++kt) { LAS float* pp = pre + kt * 128 + lane;
          const float w0 = WGT[(size_t)r * 128 + lane], w1 = WGT[(size_t)r * 128 + 64 + lane];
          pp[0] = gelu1(pp[0] * (1.0f / PEER_SU)) * w0 * (1.0f / PEER_SV); pp[64] = gelu1(pp[64] * (1.0f / PEER_SU)) * w1 * (1.0f / PEER_SV); } }
    for (int sl = 0; sl < 4; ++sl) {
        const unsigned char* tb = TUv + (size_t)sl * PEER_SLICE;
        unsigned id0 = (unsigned)IDX[(size_t)gw * 128 + lane] * 192u, id1 = (unsigned)IDX[(size_t)gw * 128 + 64 + lane] * 192u, id0n = 0u, id1n = 0u;
        u32x4 qaA[8], qaB[8]; u32x2 qbA[8], qbB[8];
        PI_LOADS(tb, qaA, qbA, id0);
#define PI_ACC16(X) X(0) X(1) X(2) X(3) X(4) X(5) X(6) X(7) X(8) X(9) X(10) X(11) X(12) X(13) X(14) X(15)
#define PI_FMA(J) asm("v_pk_fma_f32 %0, %1, %2, %0" : "+v"(acc[J]) : "v"(__builtin_shufflevector(vf, vf, 2 * (J), 2 * (J) + 1)), "v"(cf2));
#define PI_CONSUME_V(QA, QB, CF) do { _Pragma("unroll") for (int i = 0; i < 8; ++i) { \
                const float cf = __uint_as_float((unsigned)__builtin_amdgcn_ds_bpermute(4 * (8 * i + eg), (int)__float_as_uint(CF))); \
                const u32x6 v6 = {QA[i].x, QA[i].y, QA[i].z, QA[i].w, QB[i].x, QB[i].y}; \
                const f32x32 vf = __builtin_amdgcn_cvt_scalef32_pk32_f32_fp6(v6, 1.0f); \
                const f32x2 cf2 = {cf, cf}; \
                PI_ACC16(PI_FMA) \
                __builtin_amdgcn_sched_barrier(0); } } while (0)
        for (int kt = 0; kt < ntok; ++kt) {
            const int r = gw + kt * NGW; const bool has_next = kt + 1 < ntok;
            if (has_next) { id0n = (unsigned)IDX[(size_t)(r + NGW) * 128 + lane] * 192u; id1n = (unsigned)IDX[(size_t)(r + NGW) * 128 + 64 + lane] * 192u; }
            const float cfa = pre[kt * 128 + lane], cfb = pre[kt * 128 + 64 + lane];
            __builtin_amdgcn_sched_barrier(0);
            PI_LOADS(tb, qaB, qbB, id1);
            f32x2 acc[16];
#pragma unroll
            for (int j = 0; j < 16; ++j) acc[j] = (f32x2){0.f, 0.f};
            PI_CONSUME_V(qaA, qbA, cfa);
            if (has_next) PI_LOADS(tb, qaA, qbA, id0n);
            PI_CONSUME_V(qaB, qbB, cfb);
            float h16[16];
            { const bool b3 = (lane & 8) != 0;
#pragma unroll
              for (int k = 0; k < 16; ++k) { const float lo_ = acc[k >> 1][k & 1], hi_ = acc[8 + (k >> 1)][k & 1]; const float keep = b3 ? hi_ : lo_, send = b3 ? lo_ : hi_;
                  h16[k] = keep + dpp_ror8(send); } }
            float h8[8];
#pragma unroll
            for (int k = 0; k < 8; ++k) { auto rr = __builtin_amdgcn_permlane16_swap(__float_as_uint(h16[k]), __float_as_uint(h16[8 + k]), false, false); h8[k] = __uint_as_float(rr[0]) + __uint_as_float(rr[1]); }
            float h4[4];
#pragma unroll
            for (int k = 0; k < 4; ++k) { auto rr = __builtin_amdgcn_permlane32_swap(__float_as_uint(h8[k]), __float_as_uint(h8[4 + k]), false, false); h4[k] = __uint_as_float(rr[0]) + __uint_as_float(rr[1]); }
            const int cb = 32 * (((lane >> 3) & 1) * 4 + ((lane >> 4) & 1) * 2 + ((lane >> 5) & 1)) + 4 * c8;
            if (sl < 3) *(u32x2*)(FFNB + (size_t)r * D + 256 * sl + cb) = (u32x2){pk2(h4[0], h4[1]), pk2(h4[2], h4[3])};
            else {
                const _Float16* x1p = (const _Float16*)(F.ws + WS_X1) + (size_t)r * D + cb; const float* md = mod_ptr(F, l, mod_slot(r)) + 5120 + cb; const bf16_t* ff = FFNB + (size_t)r * D + cb;
                float u[16]; float s = 0.f;
#pragma unroll
                for (int q = 0; q < 4; ++q) { const sh4 xh = *(const sh4*)(x1p + 256 * q); const f32x4 x = (f32x4){(float)xh[0], (float)xh[1], (float)xh[2], (float)xh[3]}, g = *(const f32x4*)(md + 256 * q), a = q < 3 ? ldbf4(ff + 256 * q) : (f32x4){h4[0], h4[1], h4[2], h4[3]};
#pragma unroll
                    for (int j = 0; j < 4; ++j) { u[4 * q + j] = ALPHA * x[j] + g[j] * a[j]; s += u[4 * q + j]; } }
                const float mean = wave_sum(s) * (1.f / D); float s2 = 0.f;
#pragma unroll
                for (int j = 0; j < 16; ++j) { u[j] -= mean; s2 += u[j] * u[j]; }
                const float rstd = __builtin_amdgcn_rsqf(wave_sum(s2) * (1.f / D) + LN_EPS);
                const float* g2 = F.in[I_LN2G] + l * D + cb; const float* b2 = F.in[I_LN2B] + l * D + cb;
#pragma unroll
                for (int q = 0; q < 4; ++q) { const f32x4 gg = *(const f32x4*)(g2 + 256 * q), bb = *(const f32x4*)(b2 + 256 * q);
#pragma unroll
                    for (int j = 0; j < 4; ++j) u[4 * q + j] = u[4 * q + j] * rstd * gg[j] + bb[j];
                    if (l < DEPTH - 1) { if (r < MLAT) *(u32x2*)((_Float16*)F.out + (size_t)r * D + cb + 256 * q) = (u32x2){pkh2(u[4 * q], u[4 * q + 1]), pkh2(u[4 * q + 2], u[4 * q + 3])}; }
                    else *(f32x4*)(F.out + (size_t)r * D + cb + 256 * q) = (f32x4){u[4 * q], u[4 * q + 1], u[4 * q + 2], u[4 * q + 3]}; }
                if (l < DEPTH - 1) { const float* mn = mod_ptr(F, l + 1, mod_slot(r)) + cb; bf16_t* xp = xmod + (size_t)r * D + cb;
#pragma unroll
                    for (int q = 0; q < 4; ++q) { const f32x4 sc = *(const f32x4*)(mn + 1024 + 256 * q), sh = *(const f32x4*)(mn + 256 * q);
                        *(u32x2*)(xp + 256 * q) = (u32x2){pk2(u[4 * q] * (1.f + sc[0]) + sh[0], u[4 * q + 1] * (1.f + sc[1]) + sh[1]), pk2(u[4 * q + 2] * (1.f + sc[2]) + sh[2], u[4 * q + 3] * (1.f + sc[3]) + sh[3])}; } }
            }
            id0 = id0n; id1 = id1n;
        }
#undef PI_CONSUME_V
#undef PI_FMA
#undef PI_ACC16
    }
#undef PI_LOADS
}

enum { PH_PRO = 0, PH_PRO2, PH_XMOD0, PH_WCONV, PH_A, PH_B0, PH_B1, PH_C, PH_D, PH_E, PH_F, PH_F2, PH_G, PH_H, PH_I, PH_COUNT };
__device__ __forceinline__ Ctx make_ctx(const Args& a, unsigned char* lds, int wave0) {
    Ctx F; F.lds = (LAS unsigned char*)lds;
    int lane; asm volatile("v_mbcnt_lo_u32_b32 %0, -1, 0\n\tv_mbcnt_hi_u32_b32 %0, -1, %0" : "=v"(lane));
    OPAQUE_ZERO(z);
    F.lane = lane; F.wave = wave0 + (int)z; F.tid = F.wave * 64 + lane; F.G = gridDim.x; F.bid = (int)blockIdx.x + (int)z;
    F.in = a.in + z; F.out = a.out + z; F.ws = a.ws + z; return F;
}
__global__ void __launch_bounds__(NTHREADS, 2) __attribute__((amdgpu_waves_per_eu(2, 2))) k_all(Args a) {
    extern __shared__ __attribute__((aligned(16))) unsigned char lds[];
    const int wave0 = __builtin_amdgcn_readfirstlane((int)threadIdx.x >> 6);
    volatile LAS unsigned* MISC = (volatile LAS unsigned*)((LAS unsigned char*)lds + MISC_OFF);
    if (threadIdx.x < 64) MISC[threadIdx.x] = 0u;
    __syncthreads();
    (void)xcd_barrier_post((unsigned*)(a.ws + WS_CTL) + CW_BAR, MISC + 8);
#define GRID_BAR() do { XcdBarrier b_; b_.bar = (unsigned*)(a.ws + WS_CTL) + CW_BAR; b_.x = xb_xcc_id(); b_.st = (volatile LAS unsigned*)((LAS unsigned char*)lds + MISC_OFF) + 8; int ln_; asm volatile("v_mbcnt_lo_u32_b32 %0, -1, 0\n\tv_mbcnt_hi_u32_b32 %0, -1, %0" : "=v"(ln_)); xcd_barrier(b_, wave0 == 0 && ln_ == 0); } while (0)
#define PH(call) do { Ctx F = make_ctx(a, lds, wave0); call; } while (0)
    PH(pro_phase(F)); PH(wconv_phase(F, 0)); GRID_BAR();
    if (PROBE_REP & 512) { PH(pro_phase(F)); PH(wconv_phase(F, 0)); GRID_BAR(); }
    PH(pro2_phase(F)); GRID_BAR();
    PH(xmod0_phase(F)); GRID_BAR();
#define MIXER(l, hb) \
            PH(phaseA(F, hb)); GRID_BAR(); \
            PH(phaseB0(F, l, hb)); GRID_BAR(); \
            PH(phaseB1q(F, l)); PH(phaseB1k(F, l)); PH(phaseB1v(F, l)); GRID_BAR(); \
            PH(phaseC(F, l, hb, 0)); GRID_BAR(); \
            if (PROBE_REP & 2) { PH(phaseC(F, l, hb, 1)); GRID_BAR(); } \
            if (hb == 0) { PH(phaseD(F, l)); GRID_BAR(); }
#define LAYER(l) \
        MIXER(l, 0) MIXER(l, 1) \
        PH(phaseE(F, l)); GRID_BAR(); \
        if (PROBE_REP & 8) { PH(phaseE(F, l)); GRID_BAR(); } \
        if (l + 1 < DEPTH) { PH(phaseE2(F)); GRID_BAR(); } \
        PH(phaseF(F, l)); GRID_BAR(); \
        PH(phaseF2(F, l)); GRID_BAR(); \
        PH(phaseG(F, l)); GRID_BAR(); \
        if (PROBE_REP & 16) { PH(phaseG(F, l)); GRID_BAR(); } \
        if (PROBE_REP & 64) { PH(phaseH(F, l)); GRID_BAR(); } \
        PH(phaseH(F, l)); __syncthreads(); if (l + 1 < DEPTH) PH(wconv_phase(F, l + 1)); GRID_BAR(); \
        PH(phaseI(F, l)); if (l + 1 < DEPTH) GRID_BAR();
    LAYER(0) LAYER(1)
#undef LAYER
#undef MIXER
#undef PH
#undef GRID_BAR
}

extern "C" void kernel_launch(void* const* d_in, const int* in_sizes, int n_in, void* d_out, int out_size, void* d_ws, size_t ws_size, hipStream_t stream) {
    if (n_in != 35 || ws_size < WS_END) { fprintf(stderr, "kernel_launch: need 35 inputs and >= %zu B of workspace (got %d, %zu)\n", (size_t)WS_END, n_in, ws_size); return; }
    static int grid = 0;
    if (!grid) {
        int dev = 0, cus = 0, per_cu = 0;
        (void)hipGetDevice(&dev); (void)hipDeviceGetAttribute(&cus, hipDeviceAttributeMultiprocessorCount, dev);
        (void)hipFuncSetAttribute((const void*)k_all, hipFuncAttributeMaxDynamicSharedMemorySize, LDS_BYTES);
        if (hipOccupancyMaxActiveBlocksPerMultiprocessor(&per_cu, (const void*)k_all, NTHREADS, LDS_BYTES) != hipSuccess || per_cu < 1) fprintf(stderr, "kernel_launch: occupancy query says %d blocks per CU\n", per_cu);
        (void)hipGetLastError();
        grid = 256;
        if (cus != 256) fprintf(stderr, "kernel_launch: note: built for a 256-CU device, this one reports %d CUs\n", cus);
    }
    (void)hipMemsetAsync((char*)d_ws + WS_CTL, 0, CTL_BYTES, stream);
    Args a{};
    for (int i = 0; i < 35; ++i) a.in[i] = (const float*)d_in[i];
    a.out = (float*)d_out; a.ws = (unsigned char*)d_ws;
    hipLaunchKernelGGL(k_all, dim3(grid), dim3(NTHREADS), LDS_BYTES, stream, a);
}
```
